# Optimizing an MI355X kernel written in HIP

```python
import math
import jax
import jax.numpy as jnp
from jax import lax
import numpy as np

D_MODEL = 1024
BATCH = 2
SEQ = 8192
DEPTH = 2

GRID_W = 64
CTX_LEN = 256
EPS = 1e-6
LB_FLOOR = 1e-30
F32 = jnp.float32
CHUNK = 64
Q_BLOCK = 128

GDN_HEADS = 4
GDN_DK = 128
GDN_DV = 128
GDN_KEY = GDN_HEADS * GDN_DK
GDN_VAL = GDN_HEADS * GDN_DV
CONV_K = 3

MLA_HEADS = 4
MLA_Q_RANK = 384
MLA_KV_RANK = 256
MLA_NOPE = 128
MLA_ROPE = 64
MLA_V = 128
MLA_SCALE = (MLA_NOPE + MLA_ROPE) ** -0.5
ROPE_BASE = 10000.0
ROPE_NF = MLA_ROPE // 4

HG_HEADS = 4
HG_DK = 128
HG_DV = 128
HG_KEY = HG_HEADS * HG_DK
HG_VAL = HG_HEADS * HG_DV

N_BRANCH = 3
BRANCH_W = GDN_VAL
D_FF = 2816
N_MOD = 9

IN_SIZES = (GDN_KEY, GDN_KEY, GDN_VAL, GDN_VAL, 2 * GDN_HEADS, 2 * GDN_HEADS,
            MLA_Q_RANK, MLA_KV_RANK, MLA_ROPE,
            HG_KEY, 2 * HG_KEY, HG_VAL, HG_VAL,
            N_BRANCH * D_MODEL)
IN_COLS = sum(IN_SIZES)

kernel_name = 'hybrid_gdn_mla_hgrn2_diffusion_block'


def rms_norm(x, w):
    xf = x.astype(F32)
    y = xf * lax.rsqrt(jnp.mean(xf * xf, axis=-1, keepdims=True) + EPS)
    return (y * w.astype(F32)).astype(x.dtype)


def l2_normalize(x):
    return x * lax.rsqrt(jnp.sum(x * x, axis=-1, keepdims=True) + EPS)


def modulate(h, shift, scale):
    return h * (1 + scale) + shift


def split_heads(t, n_heads):
    b, s, _ = t.shape
    return t.reshape(b, s, n_heads, -1).transpose(0, 2, 1, 3)


def merge_heads(t):
    b, h, s, d = t.shape
    return t.transpose(0, 2, 1, 3).reshape(b, s, h * d)


def swiglu(h, w_i, w_o):
    gate, up = jnp.split(h @ w_i, 2, axis=-1)
    return (jax.nn.silu(gate) * up) @ w_o


def ffn_sublayer(x, mod, pre_w, post_w, w_i, w_o):
    shift, scale, gate = mod
    h = modulate(rms_norm(x, pre_w), shift, scale)
    return x + 0.5 * gate * rms_norm(swiglu(h, w_i, w_o), post_w)


def short_conv(x, w):
    pad = CONV_K // 2
    t = x.shape[1]
    xp = jnp.pad(x, ((0, 0), (pad, pad), (0, 0)))
    return jax.nn.silu(sum(xp[:, j:j + t] * w[j] for j in range(CONV_K)))


def to_chunks(t):
    b, h, n = t.shape[:3]
    t = t.reshape(b, h, n // CHUNK, CHUNK, *t.shape[3:])
    return jnp.moveaxis(t, 2, 0)


def from_chunks(t):
    t = jnp.moveaxis(t, 0, 2)
    return t.reshape(t.shape[0], t.shape[1], -1, *t.shape[4:])


def masked_decay(diff, mask):
    return jnp.where(mask, jnp.exp(jnp.where(mask, diff, 0.0)), 0.0)


def gdn_chunk_scan(s0, q, k, v, g, beta):
    incl = jnp.tril(jnp.ones((CHUNK, CHUNK), bool))
    strict = jnp.tril(jnp.ones((CHUNK, CHUNK), bool), -1)
    eye = jnp.eye(CHUNK, dtype=F32)

    def step(s, inp):
        qc, kc, vc, gc, bc = inp
        gcum = jnp.cumsum(gc, axis=-1)
        dmask = masked_decay(gcum[..., :, None] - gcum[..., None, :], incl)
        kb = kc * bc[..., None]
        a = jnp.where(strict, jnp.einsum('bhid,bhjd->bhij', kb, kc) * dmask, 0.0)
        m = eye + a
        u = lax.linalg.triangular_solve(m, vc * bc[..., None], left_side=True, lower=True, unit_diagonal=True)
        w = lax.linalg.triangular_solve(m, kb * jnp.exp(gcum)[..., None], left_side=True, lower=True, unit_diagonal=True)
        v_new = u - jnp.einsum('bhck,bhkv->bhcv', w, s)
        attn = jnp.einsum('bhid,bhjd->bhij', qc, kc) * dmask
        o = (jnp.einsum('bhck,bhkv->bhcv', qc * jnp.exp(gcum)[..., None], s)
             + jnp.einsum('bhij,bhjv->bhiv', attn, v_new))
        g_last = gcum[..., -1:]
        s = (s * jnp.exp(g_last)[..., None]
             + jnp.einsum('bhck,bhcv->bhkv', kc * jnp.exp(g_last - gcum)[..., None], v_new))
        return s, o

    s, o = lax.scan(step, s0, tuple(to_chunks(t) for t in (q, k, v, g, beta)))
    return from_chunks(o), s


def gla_chunk_scan(s0, q, k, v, g):
    incl = jnp.tril(jnp.ones((CHUNK, CHUNK), bool))[:, :, None]

    def step(s, inp):
        qc, kc, vc, gc = inp
        gcum = jnp.cumsum(gc, axis=-2)
        rel = masked_decay(gcum[..., :, None, :] - gcum[..., None, :, :], incl)
        attn = jnp.einsum('bhik,bhjk,bhijk->bhij', qc, kc, rel)
        o = (jnp.einsum('bhck,bhkv->bhcv', qc * jnp.exp(gcum), s)
             + jnp.einsum('bhij,bhjv->bhiv', attn, vc))
        g_last = gcum[..., -1:, :]
        s = (s * jnp.exp(g_last)[..., 0, :, None]
             + jnp.einsum('bhck,bhcv->bhkv', kc * jnp.exp(g_last - gcum), vc))
        return s, o

    s, o = lax.scan(step, s0, tuple(to_chunks(t) for t in (q, k, v, g)))
    return from_chunks(o), s


def bidirectional_scan(scan_fn, s0, ctx_fwd, lat_fwd, ctx_bwd, lat_bwd):
    flip = lambda t: jnp.flip(t, axis=2)
    oc_f, sc_f = scan_fn(s0, *ctx_fwd)
    ol_f, _ = scan_fn(sc_f, *lat_fwd)
    oc_b, sc_b = scan_fn(s0, *[flip(t) for t in ctx_bwd])
    ol_b, _ = scan_fn(sc_b, *[flip(t) for t in lat_bwd])
    return oc_f + flip(oc_b), ol_f + flip(ol_b)


def gdn_branch(p_ctx, p_lat, conv_w, a_log, dt_bias, norm_w):
    def prep(q, k, v, a, b):
        bsz, t = q.shape[:2]
        qkv = short_conv(jnp.concatenate([q, k, v], axis=-1), conv_w).astype(F32)
        q, k, v = jnp.split(qkv, [GDN_KEY, 2 * GDN_KEY], axis=-1)
        q = l2_normalize(split_heads(q, GDN_HEADS)) * GDN_DK ** -0.5
        k = l2_normalize(split_heads(k, GDN_HEADS))
        v = split_heads(v, GDN_HEADS)
        a = a.astype(F32).reshape(bsz, t, 2, GDN_HEADS)
        b = b.astype(F32).reshape(bsz, t, 2, GDN_HEADS)
        g = -jnp.exp(a_log.astype(F32)) * jax.nn.softplus(a + dt_bias.astype(F32))
        beta = jax.nn.sigmoid(b)
        g = jnp.transpose(g, (2, 0, 3, 1))
        beta = jnp.transpose(beta, (2, 0, 3, 1))
        return (q, k, v, g[0], beta[0]), (q, k, v, g[1], beta[1])

    c_fwd, c_bwd = prep(p_ctx[0], p_ctx[1], p_ctx[2], p_ctx[4], p_ctx[5])
    l_fwd, l_bwd = prep(p_lat[0], p_lat[1], p_lat[2], p_lat[4], p_lat[5])
    s0 = jnp.zeros((p_lat[0].shape[0], GDN_HEADS, GDN_DK, GDN_DV), F32)
    oc, ol = bidirectional_scan(gdn_chunk_scan, s0, c_fwd, l_fwd, c_bwd, l_bwd)

    def readout(o, gate):
        y = rms_norm(o, norm_w) * jax.nn.silu(split_heads(gate, GDN_HEADS).astype(F32))
        return merge_heads(y).astype(gate.dtype)

    return readout(oc, p_ctx[3]), readout(ol, p_lat[3])


def axial_rope_tables(n):
    rows = n // GRID_W
    row = jnp.repeat(jnp.arange(rows, dtype=F32), GRID_W)
    col = jnp.tile(jnp.arange(GRID_W, dtype=F32), rows)
    inv = ROPE_BASE ** (-jnp.arange(ROPE_NF, dtype=F32) / ROPE_NF)
    ang = jnp.stack([row[:, None] * inv, col[:, None] * inv], axis=1)
    return jnp.cos(ang), jnp.sin(ang)


def apply_axial_rope(x, cos, sin):
    xs = x.astype(F32).reshape(*x.shape[:-1], 2, 2, ROPE_NF)
    x1, x2 = xs[..., 0, :], xs[..., 1, :]
    c, s = cos[:, None], sin[:, None]
    out = jnp.stack([x1 * c - x2 * s, x2 * c + x1 * s], axis=-2)
    return out.reshape(x.shape).astype(x.dtype)


def softmax_attention(q, k, v):
    s = jnp.einsum('bqhd,bkhd->bhqk', q, k).astype(F32) * MLA_SCALE
    p = jax.nn.softmax(s, axis=-1).astype(v.dtype)
    o = jnp.einsum('bhqk,bkhd->bqhd', p, v)
    return o.reshape(o.shape[0], o.shape[1], -1)


def mla_branch(p_ctx, p_lat, q_norm_w, kv_norm_w, w_q_b, w_kv_b, cos, sin):
    def qkv(qa, kva, kr, rotate):
        bsz, t = qa.shape[:2]
        q = (rms_norm(qa, q_norm_w) @ w_q_b).reshape(bsz, t, MLA_HEADS, MLA_NOPE + MLA_ROPE)
        kv = (rms_norm(kva, kv_norm_w) @ w_kv_b).reshape(bsz, t, MLA_HEADS, MLA_NOPE + MLA_V)
        q_nope, q_rope = q[..., :MLA_NOPE], q[..., MLA_NOPE:]
        k_nope, v = kv[..., :MLA_NOPE], kv[..., MLA_NOPE:]
        k_rope = kr[:, :, None, :]
        if rotate:
            q_rope = apply_axial_rope(q_rope, cos, sin)
            k_rope = apply_axial_rope(k_rope, cos, sin)
        q = jnp.concatenate([q_nope, q_rope], axis=-1)
        k = jnp.concatenate([k_nope, jnp.broadcast_to(k_rope, (bsz, t, MLA_HEADS, MLA_ROPE))], axis=-1)
        return q, k, v

    qc, kc, vc = qkv(*p_ctx, False)
    ql, kl, vl = qkv(*p_lat, True)
    y_ctx = softmax_attention(qc, kc, vc)
    k_all = jnp.concatenate([kc, kl], axis=1)
    v_all = jnp.concatenate([vc, vl], axis=1)
    bsz, n = ql.shape[:2]
    qb = jnp.moveaxis(ql.reshape(bsz, n // Q_BLOCK, Q_BLOCK, MLA_HEADS, -1), 1, 0)
    ob = lax.map(lambda qblk: softmax_attention(qblk, k_all, v_all), qb)
    y_lat = jnp.moveaxis(ob, 0, 1).reshape(bsz, n, MLA_HEADS * MLA_V)
    return y_ctx, y_lat


def hgrn2_branch(p_ctx, p_lat, lb, norm_w):
    lb = lb.astype(F32)
    log_lb = jnp.log(jnp.maximum(lb, LB_FLOOR))
    log_1m_lb = jnp.log1p(-lb)

    def prep(q, f, i):
        bsz, t = q.shape[:2]
        f = f.astype(F32).reshape(bsz, t, 2, HG_KEY)
        log_f = jnp.logaddexp(log_lb, log_1m_lb + jax.nn.log_sigmoid(f))
        k = (1 - lb) * jax.nn.sigmoid(-f)
        q = split_heads(q.astype(F32), HG_HEADS) * HG_DK ** -0.5
        v = split_heads(i.astype(F32), HG_HEADS)
        return tuple((q, split_heads(k[:, :, d], HG_HEADS), v, split_heads(log_f[:, :, d], HG_HEADS))
                     for d in range(2))

    c_fwd, c_bwd = prep(p_ctx[0], p_ctx[1], p_ctx[2])
    l_fwd, l_bwd = prep(p_lat[0], p_lat[1], p_lat[2])
    s0 = jnp.zeros((p_lat[0].shape[0], HG_HEADS, HG_DK, HG_DV), F32)
    oc, ol = bidirectional_scan(gla_chunk_scan, s0, c_fwd, l_fwd, c_bwd, l_bwd)

    def readout(o, gate):
        y = rms_norm(o, norm_w) * jax.nn.silu(split_heads(gate, HG_HEADS).astype(F32))
        return merge_heads(y).astype(gate.dtype)

    return readout(oc, p_ctx[3]), readout(ol, p_lat[3])


def merge_branches(ys, gate_logits, w_branch, w_out):
    bsz, t = gate_logits.shape[:2]
    g = jax.nn.sigmoid(gate_logits.reshape(bsz, t, N_BRANCH, D_MODEL))
    m = sum(g[:, :, j] * (ys[j] @ w_branch[j]) for j in range(N_BRANCH))
    return m @ w_out


def setup_inputs(seed: int = 0) -> dict:
    key = jax.random.key(seed)
    ks = jax.random.split(key, 24)

    def dense(k, shape, fan_in):
        return jax.random.normal(k, shape, F32) * fan_in ** -0.5

    def gain(k, shape):
        return 1.0 + 0.02 * jax.random.normal(k, shape, F32)

    dt = jnp.exp(jax.random.uniform(ks[9], (DEPTH, 2, GDN_HEADS), F32, math.log(1e-3), math.log(1e-1)))
    return {
        'x': jax.random.normal(ks[0], (BATCH, SEQ, D_MODEL), F32),
        'c': jax.random.normal(ks[1], (BATCH, D_MODEL), F32),
        'ctx': jax.random.normal(ks[2], (BATCH, CTX_LEN, D_MODEL), F32),
        'c_ctx': jax.random.normal(ks[3], (D_MODEL,), F32),
        'w_ada': dense(ks[4], (DEPTH, D_MODEL, N_MOD * D_MODEL), D_MODEL),
        'b_ada': 0.01 * jax.random.normal(ks[5], (DEPTH, N_MOD * D_MODEL), F32),
        'norm_w': gain(ks[6], (DEPTH, 6, D_MODEL)),
        'ffn_w_in': dense(ks[7], (DEPTH, 2, D_MODEL, 2 * D_FF), D_MODEL),
        'ffn_w_out': dense(ks[8], (DEPTH, 2, D_FF, D_MODEL), D_FF),
        'w_in': dense(ks[10], (DEPTH, D_MODEL, IN_COLS), D_MODEL),
        'gdn_conv': dense(ks[11], (DEPTH, CONV_K, 2 * GDN_KEY + GDN_VAL), CONV_K),
        'gdn_a_log': jnp.log(jax.random.uniform(ks[12], (DEPTH, 2, GDN_HEADS), F32, 1.0, 16.0)),
        'gdn_dt_bias': dt + jnp.log(-jnp.expm1(-dt)),
        'gdn_norm': gain(ks[13], (DEPTH, GDN_DV)),
        'mla_q_norm': gain(ks[14], (DEPTH, MLA_Q_RANK)),
        'mla_kv_norm': gain(ks[15], (DEPTH, MLA_KV_RANK)),
        'mla_w_q_b': dense(ks[16], (DEPTH, MLA_Q_RANK, MLA_HEADS * (MLA_NOPE + MLA_ROPE)), MLA_Q_RANK),
        'mla_w_kv_b': dense(ks[17], (DEPTH, MLA_KV_RANK, MLA_HEADS * (MLA_NOPE + MLA_V)), MLA_KV_RANK),
        'hg_lb_logits': 0.1 * jax.random.normal(ks[18], (DEPTH, 2, HG_KEY), F32),
        'hg_norm': gain(ks[19], (DEPTH, HG_DV)),
        'w_branch': dense(ks[20], (DEPTH, N_BRANCH, BRANCH_W, D_MODEL), BRANCH_W),
        'w_out': dense(ks[21], (DEPTH, D_MODEL, D_MODEL), D_MODEL),
    }


def reference(x, c, ctx, c_ctx, w_ada, b_ada, norm_w, ffn_w_in, ffn_w_out, w_in,
              gdn_conv, gdn_a_log, gdn_dt_bias, gdn_norm,
              mla_q_norm, mla_kv_norm, mla_w_q_b, mla_w_kv_b,
              hg_lb_logits, hg_norm, w_branch, w_out):
    n = x.shape[1]
    cos, sin = axial_rope_tables(n)
    sm = jax.nn.softmax(hg_lb_logits.astype(F32), axis=0)
    lower_bounds = jnp.cumsum(sm, axis=0) - sm[0:1]
    split_pts = np.cumsum(IN_SIZES)[:-1].tolist()
    s_lat = jax.nn.silu(c)
    s_ctx = jax.nn.silu(c_ctx)
    h_lat, h_ctx = x, ctx
    for l in range(DEPTH):
        last = l == DEPTH - 1
        m_lat = jnp.split((s_lat @ w_ada[l] + b_ada[l])[:, None, :], N_MOD, axis=-1)
        m_ctx = jnp.split((s_ctx @ w_ada[l] + b_ada[l])[None, None, :], N_MOD, axis=-1)
        nw = norm_w[l]
        h_lat = ffn_sublayer(h_lat, m_lat[0:3], nw[0], nw[1], ffn_w_in[l, 0], ffn_w_out[l, 0])
        h_ctx = ffn_sublayer(h_ctx, m_ctx[0:3], nw[0], nw[1], ffn_w_in[l, 0], ffn_w_out[l, 0])
        u_lat = modulate(rms_norm(h_lat, nw[2]), m_lat[3], m_lat[4])
        u_ctx = modulate(rms_norm(h_ctx, nw[2]), m_ctx[3], m_ctx[4])
        p_lat = jnp.split(u_lat @ w_in[l], split_pts, axis=-1)
        p_ctx = jnp.split(u_ctx @ w_in[l], split_pts, axis=-1)
        ya_c, ya_l = gdn_branch(p_ctx[0:6], p_lat[0:6], gdn_conv[l], gdn_a_log[l], gdn_dt_bias[l], gdn_norm[l])
        yb_c, yb_l = mla_branch(p_ctx[6:9], p_lat[6:9], mla_q_norm[l], mla_kv_norm[l],
                                mla_w_q_b[l], mla_w_kv_b[l], cos, sin)
        yc_c, yc_l = hgrn2_branch(p_ctx[9:13], p_lat[9:13], lower_bounds[l], hg_norm[l])
        y_lat = merge_branches((ya_l, yb_l, yc_l), p_lat[13], w_branch[l], w_out[l])
        h_lat = h_lat + m_lat[5] * rms_norm(y_lat, nw[3])
        h_lat = ffn_sublayer(h_lat, m_lat[6:9], nw[4], nw[5], ffn_w_in[l, 1], ffn_w_out[l, 1])
        if not last:
            y_ctx = merge_branches((ya_c, yb_c, yc_c), p_ctx[13], w_branch[l], w_out[l])
            h_ctx = h_ctx + m_ctx[5] * rms_norm(y_ctx, nw[3])
            h_ctx = ffn_sublayer(h_ctx, m_ctx[6:9], nw[4], nw[5], ffn_w_in[l, 1], ffn_w_out[l, 1])
    return h_lat
```

```cpp
#include <hip/hip_runtime.h>
#include <hip/hip_cooperative_groups.h>
#include <cstdint>
#include <cstdio>
namespace cg = cooperative_groups;

typedef unsigned short bf16_t;
typedef short bf16x8 __attribute__((ext_vector_type(8)));
typedef float f32x16 __attribute__((ext_vector_type(16)));
typedef float f32x4 __attribute__((ext_vector_type(4)));
typedef float f32x2 __attribute__((ext_vector_type(2)));
typedef unsigned u32x4 __attribute__((ext_vector_type(4)));
typedef unsigned u32x2 __attribute__((ext_vector_type(2)));
#define DEV __device__ __forceinline__

#ifndef COOP
#define COOP 1
#endif
#ifndef PROBE_SCAN_ONLY
#define PROBE_SCAN_ONLY 0
#endif
#ifndef PROBE_DUP_S
#define PROBE_DUP_S -1
#define PROBE_DUP_S2 -1
#endif

constexpr int T = 16896, TL = 16384, NLAT = 8192, NCTX = 256, D = 1024, DFF = 2816;
constexpr int KSP = 8448;
constexpr float EPS = 1e-6f;
constexpr int WIN_LD = 8400;
constexpr int NWIN = 5504;

constexpr size_t SZ(size_t cols, size_t b) { return (size_t)T * cols * b; }
constexpr size_t OFF_BAR = 0, BAR_BYTES = 16384;
constexpr size_t OFF_MODP = BAR_BYTES;
constexpr size_t OFF_MOD  = OFF_MODP + 4ull * 2 * 3 * 9216 * 4;
constexpr size_t OFF_HCTX = OFF_MOD + 2ull * 3 * 9216 * 4;
constexpr size_t OFF_WT   = OFF_HCTX + 512ull * 1024 * 4;
constexpr size_t WT_BYTES = 24ull << 20;
constexpr size_t OFF_A    = OFF_WT + WT_BYTES;
constexpr size_t OFF_U    = OFF_A + SZ(1024, 2);
constexpr size_t U_GQR  = 0;
constexpr size_t U_MQA  = U_GQR + SZ(1536, 2);
constexpr size_t U_MKVA = U_MQA + SZ(384, 2);
constexpr size_t U_GG   = U_MKVA + SZ(256, 2);
constexpr size_t U_GAB  = U_GG + SZ(512, 2);
constexpr size_t U_MKR  = U_GAB + SZ(16, 4);
constexpr size_t U_HQ   = U_MKR + SZ(64, 2);
constexpr size_t U_HK   = U_HQ + SZ(512, 2);
constexpr size_t U_HI   = U_HK + SZ(1024, 2);
constexpr size_t U_HG   = U_HI + SZ(512, 2);
constexpr size_t U_GQ2  = U_HG + SZ(512, 2);
constexpr size_t U_MQ   = U_GQ2 + SZ(1536, 2);
constexpr size_t U_MKN  = U_MQ + SZ(768, 2);
constexpr size_t U_MVT  = U_MKN + SZ(512, 2);
constexpr size_t U_END  = U_MVT + SZ(512, 2);
constexpr size_t U_OGF = U_GQR, U_OGB = U_GQR + SZ(512, 2), U_OHF = U_GQR + SZ(1024, 2), U_OHB = U_MQA;
constexpr size_t U_YB = 0;
constexpr size_t U_ARE = U_HK, U_YA = U_GQ2, U_YC = U_GQ2 + SZ(512, 2), U_M = U_MQ;
constexpr size_t U_HFF = 0;
constexpr size_t U_Y   = SZ(2816, 2);
constexpr size_t WS_NEED = OFF_U + U_END;
static_assert(U_Y + SZ(1024, 4) <= U_M, "Y overlaps M");
constexpr size_t WT_WI = 0, WT_WO = 5632ull * 1024 * 2;
constexpr size_t WT_WIN = 0, WT_WG = (size_t)NWIN * 1024 * 2, WT_WQB = WT_WG + 3072ull * 1024 * 2, WT_WKVB = WT_WQB + 768ull * 384 * 2,
                 WT_WBR = WT_WKVB + 1024ull * 256 * 2, WT_WOUT = WT_WBR + 3ull * 1024 * 512 * 2, WT_MIX_END = WT_WOUT + 1024ull * 1024 * 2;
static_assert(WT_MIX_END <= WT_BYTES, "WT too small");
static_assert(WT_WO + 1024ull * 2816 * 2 <= WT_BYTES, "WT too small");

struct P {
  const float *x, *c, *ctx, *c_ctx, *w_ada, *b_ada, *norm_w, *ffn_w_in, *ffn_w_out, *w_in, *gdn_conv, *gdn_a_log, *gdn_dt_bias, *gdn_norm,
      *mla_q_norm, *mla_kv_norm, *mla_w_q_b, *mla_w_kv_b, *hg_lb, *hg_norm, *w_branch, *w_out;
  float* out; char* ws;
};

DEV unsigned pk2(float lo, float hi) {
  typedef __bf16 bf2 __attribute__((ext_vector_type(2)));
  f32x2 v = {lo, hi};
  bf2 b = __builtin_convertvector(v, bf2);
  return __builtin_bit_cast(unsigned, b);
}
DEV bf16_t f2bf(float x) { return (bf16_t)(pk2(x, 0.f) & 0xffffu); }
DEV float bflo(unsigned w) { return __uint_as_float(w << 16); }
DEV float bfhi(unsigned w) { return __uint_as_float(w & 0xffff0000u); }
DEV float bf2f(bf16_t h) { return __uint_as_float((unsigned)h << 16); }
DEV void st4bf(bf16_t* dst, float a, float b, float c, float d) { u32x2 w = {pk2(a, b), pk2(c, d)}; *(u32x2*)dst = w; }
DEV float sigmoidf_(float x) { return 1.f / (1.f + __expf(-x)); }
DEV float siluf_(float x) { return x / (1.f + __expf(-x)); }
DEV float wave_sum(float v) {
#pragma unroll
  for (int o = 32; o > 0; o >>= 1) v += __shfl_xor(v, o);
  return v;
}
DEV float sum16(float v) {
#pragma unroll
  for (int o = 8; o > 0; o >>= 1) v += __shfl_xor(v, o);
  return v;
}
DEV float rowsum16(float x) {
  x += __int_as_float(__builtin_amdgcn_update_dpp(0, __float_as_int(x), 0xB1, 0xf, 0xf, true));
  x += __int_as_float(__builtin_amdgcn_update_dpp(0, __float_as_int(x), 0x4E, 0xf, 0xf, true));
  x += __int_as_float(__builtin_amdgcn_update_dpp(0, __float_as_int(x), 0x141, 0xf, 0xf, true));
  x += __int_as_float(__builtin_amdgcn_update_dpp(0, __float_as_int(x), 0x140, 0xf, 0xf, true));
  return x;
}
DEV int TIDX() { int t = __builtin_amdgcn_workitem_id_x(); asm volatile("" : "+v"(t)); return t; }
DEV int sel_of(int r) { return r < TL ? (r >> 13) : 2; }
DEV int kx_of(int r) { return r < TL ? (r & 8191) : 8192 + ((r - TL) & 255); }
DEV int batch_of(int r) { return r < TL ? (r >> 13) : ((r - TL) >> 8); }
DEV int swz(int row, int ch) { return row * 128 + (((ch ^ (row >> 1)) & 7) << 4); }


DEV int vblock() { const int G = gridDim.x, j = blockIdx.x; return (G & 7) ? j : (j & 7) * (G >> 3) + (j >> 3); }
DEV void tile_map(int idx, int MT, int NT, int& mt, int& nt) {
  const int nig = 8 * NT, g = idx / nig, fm = g * 8, gsz = (MT - fm) < 8 ? (MT - fm) : 8, r = idx - g * nig;
  mt = fm + r % gsz; nt = r / gsz;
}


#define XB_TMO      128
#define XB_XCNT(j)  (256  + 64 * (j))
#define XB_XSUB(j)  (1280 + 64 * (j))
#define XB_XGEN(j)  (2304 + 64 * (j))
#define XB_TOP      3328
#define XB_TOPGEN   3392
#define XCD_BAR_WORDS 3456
#define XB_SPIN_CAP (1u << 22)
#define LAS __attribute__((address_space(3)))
static_assert(XCD_BAR_WORDS * 4 <= BAR_BYTES, "barrier words");
DEV unsigned xb_ld(unsigned* p) { return __hip_atomic_load(p, __ATOMIC_RELAXED, __HIP_MEMORY_SCOPE_AGENT); }
DEV unsigned xb_add(unsigned* p, unsigned v) { return __hip_atomic_fetch_add(p, v, __ATOMIC_RELAXED, __HIP_MEMORY_SCOPE_AGENT); }
DEV unsigned xb_xcc_id() { return (unsigned)__builtin_amdgcn_s_getreg((3 << 11) | 20) & 0xFu; }
#define XB_SPIN(cond, bar) do { unsigned _sp = 0; while (cond) { __builtin_amdgcn_s_sleep(1); \
    if ((++_sp & 255u) == 0u) { if (xb_ld(&(bar)[XB_TMO])) break; if (_sp > XB_SPIN_CAP) { atomicAdd(&(bar)[XB_TMO], 1u); break; } } } } while (0)
struct XcdBarrier { unsigned* bar; unsigned x; volatile LAS unsigned* st; };
DEV XcdBarrier xcd_barrier_post(unsigned* bar, volatile LAS unsigned* st) {
  XcdBarrier b; b.bar = bar; b.x = xb_xcc_id(); b.st = st;
  if (__builtin_amdgcn_workitem_id_x() == 0) (void)xb_add(&bar[XB_XCNT(b.x)], 1u);
  return b;
}
DEV void xcd_barrier_complete(unsigned* bar, unsigned x, unsigned& nloc, unsigned& nx) {
  const unsigned G = gridDim.x;
  unsigned sum, cnt, mine, sp = 0u;
  for (;;) {
    sum = 0u; cnt = 0u; mine = 0u;
#pragma unroll
    for (unsigned j = 0; j < 16; ++j) { const unsigned c = xb_ld(&bar[XB_XCNT(j)]); sum += c; cnt += (c > 0u) ? 1u : 0u; mine = (j == x) ? c : mine; }
    if (sum == G) break;
    __builtin_amdgcn_s_sleep(1);
    if ((++sp & 255u) == 0u) { if (xb_ld(&bar[XB_TMO])) break; if (sp > XB_SPIN_CAP) { atomicAdd(&bar[XB_TMO], 1u); break; } }
  }
  nloc = mine > 0u ? mine : 1u; nx = cnt > 0u ? cnt : 1u;
}
DEV void xcd_barrier(const XcdBarrier& b) {
  asm volatile("s_waitcnt vmcnt(0)" ::: "memory");
  __syncthreads();
  if (__builtin_amdgcn_workitem_id_x() == 0) {
    unsigned* bar = b.bar;
    __builtin_amdgcn_s_waitcnt(0);
    unsigned nloc = b.st[0], nx = b.st[1];
    if (nloc == 0u) { xcd_barrier_complete(bar, b.x, nloc, nx); b.st[0] = nloc; b.st[1] = nx; }
    const unsigned old = xb_add(&bar[XB_XSUB(b.x)], 1u);
    const unsigned gen = old / nloc;
    if (old + 1u == (gen + 1u) * nloc) {
      __builtin_amdgcn_fence(__ATOMIC_RELEASE, "agent");
      asm volatile("s_waitcnt vmcnt(0)" ::: "memory");
      const unsigned og = xb_add(&bar[XB_TOP], 1u);
      const unsigned tg = og / nx;
      if (og + 1u == (tg + 1u) * nx) xb_add(&bar[XB_TOPGEN], 1u);
      else XB_SPIN(xb_ld(&bar[XB_TOPGEN]) == tg, bar);
      __builtin_amdgcn_fence(__ATOMIC_ACQUIRE, "agent");
      xb_add(&bar[XB_XGEN(b.x)], 1u);
      asm volatile("s_waitcnt vmcnt(0)" ::: "memory");
    } else {
      XB_SPIN(xb_ld(&bar[XB_XGEN(b.x)]) == gen, bar);
      __builtin_amdgcn_fence(__ATOMIC_ACQUIRE, "agent");
      asm volatile("s_waitcnt vmcnt(0)" ::: "memory");
    }
  }
  __syncthreads();
}

#if COOP
#define GRID_SYNC() xcd_barrier(xb)
#else
#define GRID_SYNC()
#endif

template <int BN>
DEV void gemm_core_reg(const bf16_t* __restrict__ A, int lda, const bf16_t* __restrict__ B, int ldb, int K, f32x16 (&acc)[2][BN / 64], char* lds) {
  constexpr int NB = BN / 64, NBL = BN / 32;
  constexpr int A_BYTES = 128 * 128, ST = A_BYTES + BN * 128;
  const int tid = TIDX(), lane = tid & 63, wid = tid >> 6, wr = wid >> 1, wc = wid & 1;
  const int lrow = tid >> 3, lch = tid & 7;
  u32x4 ra[2][4], rb[2][NBL];
  const bf16_t* ap = A + (size_t)lrow * lda + lch * 8;
  const bf16_t* bp = B + (size_t)lrow * ldb + lch * 8;
  const int nk = K >> 6;
#define GC_LOAD(set, k0) do { _Pragma("unroll") for (int i = 0; i < 4; ++i) ra[set][i] = *(const u32x4*)(ap + (size_t)(32 * i) * lda + (k0)); \
    _Pragma("unroll") for (int i = 0; i < NBL; ++i) rb[set][i] = *(const u32x4*)(bp + (size_t)(32 * i) * ldb + (k0)); } while (0)
#define GC_STORE(stage, set) do { char* st_ = lds + (stage) * ST; _Pragma("unroll") for (int i = 0; i < 4; ++i) *(u32x4*)(st_ + swz(lrow + 32 * i, lch)) = ra[set][i]; \
    _Pragma("unroll") for (int i = 0; i < NBL; ++i) *(u32x4*)(st_ + A_BYTES + swz(lrow + 32 * i, lch)) = rb[set][i]; } while (0)
#define GC_COMPUTE(stage) do { const char* cur = lds + (stage) * ST; _Pragma("unroll") for (int ks = 0; ks < 4; ++ks) { const int ch = ks * 2 + (lane >> 5); bf16x8 af[2], bfr[NB]; \
    _Pragma("unroll") for (int mi = 0; mi < 2; ++mi) af[mi] = *(const bf16x8*)(cur + swz(wr * 64 + mi * 32 + (lane & 31), ch)); \
    _Pragma("unroll") for (int ni = 0; ni < NB; ++ni) bfr[ni] = *(const bf16x8*)(cur + A_BYTES + swz(wc * (BN / 2) + ni * 32 + (lane & 31), ch)); \
    _Pragma("unroll") for (int mi = 0; mi < 2; ++mi) _Pragma("unroll") for (int ni = 0; ni < NB; ++ni) acc[mi][ni] = __builtin_amdgcn_mfma_f32_32x32x16_bf16(bfr[ni], af[mi], acc[mi][ni], 0, 0, 0); } } while (0)
  GC_LOAD(0, 0);
  GC_STORE(0, 0);
  if (nk > 1) GC_LOAD(1, 64);
  __syncthreads();
  for (int kt = 0; kt < nk; kt += 2) {
    if (kt + 2 < nk) GC_LOAD(0, (kt + 2) * 64);
    __builtin_amdgcn_sched_barrier(0);
    GC_COMPUTE(0);
    __builtin_amdgcn_sched_barrier(0);
    if (kt + 1 < nk) GC_STORE(1, 1);
    __syncthreads();
    if (kt + 1 >= nk) break;
    if (kt + 3 < nk) GC_LOAD(1, (kt + 3) * 64);
    __builtin_amdgcn_sched_barrier(0);
    GC_COMPUTE(1);
    __builtin_amdgcn_sched_barrier(0);
    if (kt + 2 < nk) GC_STORE(0, 0);
    __syncthreads();
  }
#undef GC_LOAD
#undef GC_STORE
#undef GC_COMPUTE
}
#define LDSAS __attribute__((address_space(3)))
template <int N> DEV void wait_vmcnt() { asm volatile("s_waitcnt vmcnt(%0)" ::"n"(N) : "memory"); }
template <int BN>
DEV void gemm_core(const bf16_t* __restrict__ A, int lda, const bf16_t* __restrict__ B, int ldb, int K, f32x16 (&acc)[2][BN / 64], char* lds) {
  constexpr int NB = BN / 64, NPB = BN / 32;
  constexpr int NP = 4 + NPB;
  constexpr int A_BYTES = 128 * 128, ST = A_BYTES + BN * 128;
  const int tid = TIDX(), lane = tid & 63, wid = __builtin_amdgcn_readfirstlane(tid >> 6), wr = wid >> 1, wc = wid & 1;
  LDSAS char* l3 = (LDSAS char*)lds;
  unsigned offA[4], offB[NPB];
#pragma unroll
  for (int i = 0; i < 4; ++i) { const int row = (wid * 4 + i) * 8 + (lane >> 3); offA[i] = (unsigned)(row * lda + (((lane & 7) ^ ((row >> 1) & 7)) << 3)) * 2u; }
#pragma unroll
  for (int i = 0; i < NPB; ++i) { const int row = (wid * NPB + i) * 8 + (lane >> 3); offB[i] = (unsigned)(row * ldb + (((lane & 7) ^ ((row >> 1) & 7)) << 3)) * 2u; }
  const int nk = K >> 6;
#define GD_ISSUE(stage, kt_) do { const char* ga_ = (const char*)A + (size_t)(kt_) * 128; const char* gb_ = (const char*)B + (size_t)(kt_) * 128; \
    _Pragma("unroll") for (int i = 0; i < 4; ++i) __builtin_amdgcn_global_load_lds((const unsigned*)(ga_ + offA[i]), (LDSAS unsigned*)(l3 + (stage) * ST + (wid * 4 + i) * 1024), 16, 0, 0); \
    _Pragma("unroll") for (int i = 0; i < NPB; ++i) __builtin_amdgcn_global_load_lds((const unsigned*)(gb_ + offB[i]), (LDSAS unsigned*)(l3 + (stage) * ST + A_BYTES + (wid * NPB + i) * 1024), 16, 0, 0); } while (0)
  wait_vmcnt<0>();
  GD_ISSUE(0, 0);
  if (nk > 1) { GD_ISSUE(1, 1); wait_vmcnt<NP>(); } else wait_vmcnt<0>();
  __builtin_amdgcn_s_barrier(); asm volatile("" ::: "memory");
  for (int kt = 0; kt < nk; ++kt) {
    const char* cur = lds + (kt & 1) * ST;
    bf16x8 af[2][2], bfr[2][NB];
#define GD_FRAGS(set, ks_) do { const int ch_ = (ks_) * 2 + (lane >> 5); \
      _Pragma("unroll") for (int mi = 0; mi < 2; ++mi) af[set][mi] = *(const bf16x8*)(cur + swz(wr * 64 + mi * 32 + (lane & 31), ch_)); \
      _Pragma("unroll") for (int ni = 0; ni < NB; ++ni) bfr[set][ni] = *(const bf16x8*)(cur + A_BYTES + swz(wc * (BN / 2) + ni * 32 + (lane & 31), ch_)); } while (0)
#define GD_MMA(set) do { _Pragma("unroll") for (int mi = 0; mi < 2; ++mi) _Pragma("unroll") for (int ni = 0; ni < NB; ++ni) \
      acc[mi][ni] = __builtin_amdgcn_mfma_f32_32x32x16_bf16(bfr[set][ni], af[set][mi], acc[mi][ni], 0, 0, 0); } while (0)
    GD_FRAGS(0, 0);
    __builtin_amdgcn_sched_barrier(0);
    GD_FRAGS(1, 1);
    __builtin_amdgcn_sched_barrier(0);
    GD_MMA(0);
    __builtin_amdgcn_sched_barrier(0);
    GD_FRAGS(0, 2);
    __builtin_amdgcn_sched_barrier(0);
    GD_MMA(1);
    __builtin_amdgcn_sched_barrier(0);
    GD_FRAGS(1, 3);
    __builtin_amdgcn_sched_barrier(0);
    GD_MMA(0);
    __builtin_amdgcn_sched_barrier(0);
    GD_MMA(1);
#undef GD_FRAGS
#undef GD_MMA
    asm volatile("s_waitcnt lgkmcnt(0)" ::: "memory");
    __builtin_amdgcn_s_barrier(); asm volatile("" ::: "memory");
    if (kt + 2 < nk) { GD_ISSUE(kt & 1, kt + 2); wait_vmcnt<NP>(); }
    else wait_vmcnt<0>();
    __builtin_amdgcn_s_barrier(); asm volatile("" ::: "memory");
  }
#undef GD_ISSUE
}
template <int NB>
DEV void zero_acc(f32x16 (&acc)[2][NB]) {
#pragma unroll
  for (int a = 0; a < 2; ++a)
#pragma unroll
    for (int b = 0; b < NB; ++b)
#pragma unroll
      for (int i = 0; i < 16; ++i) acc[a][b][i] = 0.f;
}

struct Cv { const float* src; int ld; int K; int Np; int kind; const float* ks; bf16_t* dst; };
DEV int cv_map(int kind, int n) {
  if (kind == 0) return n;
  if (kind == 1) { const int g = n >> 6, r = n & 63; return r < 32 ? g * 32 + r : 2816 + g * 32 + (r - 32); }
  if (kind == 2) {
    if (n < 2064) return n;
    if (n < 2176) return -1;
    if (n < 2880) return 2064 + (n - 2176);
    if (n < 2944) return -1;
    return 2768 + (n - 2944);
  }
  return 5328 + n;
}
DEV void cv_run(const Cv c, char* lds) {
  float* tile = (float*)lds;
  const int tid = TIDX();
  const int nkt = c.K >> 6, ntile = nkt * (c.Np >> 6);
  for (int t = blockIdx.x; t < ntile; t += gridDim.x) {
    const int k0 = (t % nkt) * 64, n0 = (t / nkt) * 64;
    const int nn = tid & 63, src_n = cv_map(c.kind, n0 + nn);
#pragma unroll 4
    for (int i = 0; i < 16; ++i) {
      const int k = i * 4 + (tid >> 6);
      float v = 0.f;
      if (src_n >= 0) { v = c.src[(size_t)(k0 + k) * c.ld + src_n]; if (c.ks) v *= c.ks[k0 + k]; }
      tile[k * 65 + nn] = v;
    }
    __syncthreads();
#pragma unroll 4
    for (int i = 0; i < 16; ++i) {
      const int n = i * 4 + (tid >> 6), k = tid & 63;
      c.dst[(size_t)(n0 + n) * c.K + k0 + k] = f2bf(tile[k * 65 + n]);
    }
    __syncthreads();
  }
}
DEV void conv_ffn(const P& p, int l, int f, char* lds) {
  bf16_t* wt = (bf16_t*)(p.ws + OFF_WT);
  Cv a = {p.ffn_w_in + (size_t)(l * 2 + f) * 1024 * 5632, 5632, 1024, 5632, 1, nullptr, (bf16_t*)((char*)wt + WT_WI)};
  cv_run(a, lds);
  Cv b = {p.ffn_w_out + (size_t)(l * 2 + f) * 2816 * 1024, 1024, 2816, 1024, 0, nullptr, (bf16_t*)((char*)wt + WT_WO)};
  cv_run(b, lds);
}
DEV void conv_mixer(const P& p, int l, char* lds) {
  char* wt = p.ws + OFF_WT;
  const float* win = p.w_in + (size_t)l * 1024 * WIN_LD;
  Cv a = {win, WIN_LD, 1024, NWIN, 2, nullptr, (bf16_t*)(wt + WT_WIN)}; cv_run(a, lds);
  Cv b = {win, WIN_LD, 1024, 3072, 3, nullptr, (bf16_t*)(wt + WT_WG)}; cv_run(b, lds);
  Cv c = {p.mla_w_q_b + (size_t)l * 384 * 768, 768, 384, 768, 0, p.mla_q_norm + l * 384, (bf16_t*)(wt + WT_WQB)}; cv_run(c, lds);
  Cv d = {p.mla_w_kv_b + (size_t)l * 256 * 1024, 1024, 256, 1024, 0, p.mla_kv_norm + l * 256, (bf16_t*)(wt + WT_WKVB)}; cv_run(d, lds);
#pragma unroll 1
  for (int j = 0; j < 3; ++j) {
    Cv e = {p.w_branch + (size_t)(l * 3 + j) * 512 * 1024, 1024, 512, 1024, 0, nullptr, (bf16_t*)(wt + WT_WBR) + (size_t)j * 1024 * 512};
    cv_run(e, lds);
  }
  Cv f = {p.w_out + (size_t)l * 1024 * 1024, 1024, 1024, 1024, 0, nullptr, (bf16_t*)(wt + WT_WOUT)}; cv_run(f, lds);
}

DEV void phase0(const P& p, char* lds) {
  const int tid = TIDX();
  {
    const f32x4* s = (const f32x4*)p.x; f32x4* d = (f32x4*)p.out;
    const size_t n = (size_t)TL * D / 4;
    for (size_t i = (size_t)blockIdx.x * 256 + tid; i < n; i += (size_t)gridDim.x * 256) d[i] = s[i];
    const f32x4* s2 = (const f32x4*)p.ctx; f32x4* d2 = (f32x4*)(p.ws + OFF_HCTX);
    const size_t n2 = 512ull * D / 4;
    for (size_t i = (size_t)blockIdx.x * 256 + tid; i < n2; i += (size_t)gridDim.x * 256) d2[i] = s2[i];
  }
  {
    float* sv = (float*)lds;
    float* modp = (float*)(p.ws + OFF_MODP);
    for (int t = blockIdx.x; t < 2 * 36 * 4; t += gridDim.x) {
      const int ks = t & 3, cb = (t >> 2) % 36, l = t / 144;
      __syncthreads();
      {
        const int k = ks * 256 + tid;
        sv[tid] = siluf_(p.c[k]); sv[256 + tid] = siluf_(p.c[1024 + k]); sv[512 + tid] = siluf_(p.c_ctx[k]);
      }
      __syncthreads();
      const int col = cb * 256 + tid;
      const float* w = p.w_ada + ((size_t)l * 1024 + ks * 256) * 9216 + col;
      float a0 = 0.f, a1 = 0.f, a2 = 0.f;
#pragma unroll 8
      for (int k = 0; k < 256; ++k) { const float wv = w[(size_t)k * 9216]; a0 += sv[k] * wv; a1 += sv[256 + k] * wv; a2 += sv[512 + k] * wv; }
      float* o = modp + ((size_t)(ks * 2 + l) * 3) * 9216 + col;
      o[0] = a0; o[9216] = a1; o[2 * 9216] = a2;
    }
    __syncthreads();
  }
  conv_ffn(p, 0, 0, lds);
}
DEV void phase0b(const P& p) {
  const float* modp = (const float*)(p.ws + OFF_MODP);
  float* mod = (float*)(p.ws + OFF_MOD);
  for (int i = blockIdx.x * 256 + TIDX(); i < 2 * 3 * 9216; i += gridDim.x * 256) {
    const int col = i % 9216, l = i / (3 * 9216);
    float v = p.b_ada[l * 9216 + col];
#pragma unroll
    for (int ks = 0; ks < 4; ++ks) v += modp[(size_t)ks * 2 * 3 * 9216 + i];
    mod[i] = v;
  }
}

DEV void row_phase(const P& p, bool do_post, int l_post, const bf16_t* __restrict__ Y, int gate_idx, float gate_mul, int postw_idx,
                   bool do_pre, int l_pre, int prew_idx, int shift_idx, bf16_t* __restrict__ Aout, int nrows = T) {
  const float* mod = (const float*)(p.ws + OFF_MOD);
  float* hctx = (float*)(p.ws + OFF_HCTX);
  const int lane = TIDX() & 63, wid = TIDX() >> 6;
  for (int r = blockIdx.x * 4 + wid; r < nrows; r += gridDim.x * 4) {
    float* hrow = r < TL ? p.out + (size_t)r * D : hctx + (size_t)(r - TL) * D;
    const int sel = sel_of(r);
    f32x4 h[4];
#pragma unroll
    for (int i = 0; i < 4; ++i) h[i] = *(const f32x4*)(hrow + i * 256 + lane * 4);
    if (do_post) {
      f32x4 y[4]; float ss = 0.f;
#pragma unroll
      for (int i = 0; i < 4; ++i) { const u32x2 yw = *(const u32x2*)(Y + (size_t)r * D + i * 256 + lane * 4); y[i] = (f32x4){bflo(yw[0]), bfhi(yw[0]), bflo(yw[1]), bfhi(yw[1])}; ss += y[i][0] * y[i][0] + y[i][1] * y[i][1] + y[i][2] * y[i][2] + y[i][3] * y[i][3]; }
      ss = wave_sum(ss);
      const float rs = rsqrtf(ss * (1.f / 1024.f) + EPS);
      const float* pw = p.norm_w + (size_t)(l_post * 6 + postw_idx) * 1024;
      const float* gt = mod + ((size_t)(l_post * 3 + sel) * 9 + gate_idx) * 1024;
#pragma unroll
      for (int i = 0; i < 4; ++i) {
        const f32x4 w4 = *(const f32x4*)(pw + i * 256 + lane * 4), g4 = *(const f32x4*)(gt + i * 256 + lane * 4);
        h[i] += gate_mul * g4 * (y[i] * rs * w4);
        *(f32x4*)(hrow + i * 256 + lane * 4) = h[i];
      }
    }
    if (do_pre) {
      float ss = 0.f;
#pragma unroll
      for (int i = 0; i < 4; ++i) ss += h[i][0] * h[i][0] + h[i][1] * h[i][1] + h[i][2] * h[i][2] + h[i][3] * h[i][3];
      ss = wave_sum(ss);
      const float rs = rsqrtf(ss * (1.f / 1024.f) + EPS);
      const float* nw = p.norm_w + (size_t)(l_pre * 6 + prew_idx) * 1024;
      const float* sh = mod + ((size_t)(l_pre * 3 + sel) * 9 + shift_idx) * 1024;
      const float* sc = sh + 1024;
#pragma unroll
      for (int i = 0; i < 4; ++i) {
        const f32x4 w4 = *(const f32x4*)(nw + i * 256 + lane * 4), s4 = *(const f32x4*)(sh + i * 256 + lane * 4), c4 = *(const f32x4*)(sc + i * 256 + lane * 4);
        const f32x4 v = (h[i] * rs * w4) * (1.f + c4) + s4;
        st4bf(Aout + (size_t)r * D + i * 256 + lane * 4, v[0], v[1], v[2], v[3]);
      }
    }
  }
}

DEV void ffn_gemm1(const P& p, char* lds, int MT) {
  const bf16_t* A = (const bf16_t*)(p.ws + OFF_A);
  const bf16_t* W = (const bf16_t*)(p.ws + OFF_WT + WT_WI);
  bf16_t* H = (bf16_t*)(p.ws + OFF_U + U_HFF);
  const int lane = TIDX() & 63, wid = TIDX() >> 6, wr = wid >> 1, wc = wid & 1, h2 = lane >> 5;
  constexpr int NT = 5632 / 128;
  for (int t = vblock(); t < MT * NT; t += gridDim.x) {
    int mt, nt; tile_map(t, MT, NT, mt, nt);
    f32x16 acc[2][2]; zero_acc<2>(acc);
    gemm_core<128>(A + (size_t)mt * 128 * 1024, 1024, W + (size_t)nt * 128 * 1024, 1024, 1024, acc, lds);
#pragma unroll
    for (int mi = 0; mi < 2; ++mi) {
      const int row = mt * 128 + wr * 64 + mi * 32 + (lane & 31);
      bf16_t* dst = H + (size_t)row * DFF + (nt * 2 + wc) * 32 + 4 * h2;
#pragma unroll
      for (int q = 0; q < 4; ++q) {
        float v[4];
#pragma unroll
        for (int j = 0; j < 4; ++j) v[j] = siluf_(acc[mi][0][q * 4 + j]) * acc[mi][1][q * 4 + j];
        st4bf(dst + 8 * q, v[0], v[1], v[2], v[3]);
      }
    }
  }
}
DEV void gemm_f32out(const bf16_t* A, int K, const bf16_t* W, bf16_t* Y, char* lds, int MT) {
  const int lane = TIDX() & 63, wid = TIDX() >> 6, wr = wid >> 1, wc = wid & 1, h2 = lane >> 5;
  constexpr int NT = 1024 / 128;
  for (int t = vblock(); t < MT * NT; t += gridDim.x) {
    int mt, nt; tile_map(t, MT, NT, mt, nt);
    f32x16 acc[2][2]; zero_acc<2>(acc);
    gemm_core<128>(A + (size_t)mt * 128 * K, K, W + (size_t)nt * 128 * K, K, K, acc, lds);
#pragma unroll
    for (int mi = 0; mi < 2; ++mi) {
      const int row = mt * 128 + wr * 64 + mi * 32 + (lane & 31);
#pragma unroll
      for (int ni = 0; ni < 2; ++ni) {
        bf16_t* dst = Y + (size_t)row * D + nt * 128 + wc * 64 + ni * 32 + 4 * h2;
#pragma unroll
        for (int q = 0; q < 4; ++q) st4bf(dst + 8 * q, acc[mi][ni][q * 4], acc[mi][ni][q * 4 + 1], acc[mi][ni][q * 4 + 2], acc[mi][ni][q * 4 + 3]);
      }
    }
  }
}

DEV void rope32(f32x16& v, int a, int r, int h2) {
  if (r >= TL) return;
  const int n = r & 8191;
  const float pos = (float)(a == 0 ? (n >> 6) : (n & 63));
#pragma unroll
  for (int reg = 0; reg < 8; ++reg) {
    const int f = (reg & 3) + 8 * (reg >> 2) + 4 * h2;
    const float inv = __builtin_amdgcn_exp2f(-(float)f * (13.287712379549449f / 16.f));
    const float ang = pos * inv;
    const float c = __cosf(ang), s = __sinf(ang);
    const float x1 = v[reg], x2 = v[reg + 8];
    v[reg] = x1 * c - x2 * s;
    v[reg + 8] = x2 * c + x1 * s;
  }
}

DEV void win_gemm(const P& p, int l, char* lds) {
  const bf16_t* A = (const bf16_t*)(p.ws + OFF_A);
  const bf16_t* W = (const bf16_t*)(p.ws + OFF_WT + WT_WIN);
  char* U = p.ws + OFF_U;
  bf16_t *GQR = (bf16_t*)(U + U_GQR), *GG = (bf16_t*)(U + U_GG), *MQA = (bf16_t*)(U + U_MQA), *MKVA = (bf16_t*)(U + U_MKVA), *MKR = (bf16_t*)(U + U_MKR),
         *HQ = (bf16_t*)(U + U_HQ), *HK = (bf16_t*)(U + U_HK), *HI = (bf16_t*)(U + U_HI), *HG = (bf16_t*)(U + U_HG);
  float* GAB = (float*)(U + U_GAB);
  const int lane = TIDX() & 63, wid = TIDX() >> 6, wr = wid >> 1, wc = wid & 1, h2 = lane >> 5;
  constexpr int MT = T / 128, NT = NWIN / 128;
  for (int t = vblock(); t < MT * NT; t += gridDim.x) {
    int mt, nt; tile_map(t, MT, NT, mt, nt);
    f32x16 acc[2][2]; zero_acc<2>(acc);
    gemm_core<128>(A + (size_t)mt * 128 * 1024, 1024, W + (size_t)nt * 128 * 1024, 1024, 1024, acc, lds);
#pragma unroll
    for (int ni = 0; ni < 2; ++ni) {
      const int nb = nt * 128 + wc * 64 + ni * 32;
#pragma unroll
      for (int mi = 0; mi < 2; ++mi) {
        const int row = mt * 128 + wr * 64 + mi * 32 + (lane & 31);
        f32x16 v = acc[mi][ni];
        bf16_t* dst = nullptr;
        if (nb < 1536) dst = GQR + (size_t)row * 1536 + nb;
        else if (nb < 2048) dst = GG + (size_t)row * 512 + (nb - 1536);
        else if (nb == 2048) {
#pragma unroll
          for (int reg = 0; reg < 16; ++reg) {
            const int c = (reg & 3) + 8 * (reg >> 2) + 4 * h2;
            if (c < 8) {
              const float al = p.gdn_a_log[l * 8 + c], dtb = p.gdn_dt_bias[l * 8 + c];
              const float xx = v[reg] + dtb;
              const float sp = xx > 20.f ? xx : log1pf(__expf(xx));
              GAB[(size_t)row * 16 + c] = -__expf(al) * sp;
            } else if (c < 16) {
              GAB[(size_t)row * 16 + c] = sigmoidf_(v[reg]);
            }
          }
        }
        else if (nb < 2176) {}
        else if (nb < 2560) dst = MQA + (size_t)row * 384 + (nb - 2176);
        else if (nb < 2816) dst = MKVA + (size_t)row * 256 + (nb - 2560);
        else if (nb < 2880) { rope32(v, (nb - 2816) >> 5, row, h2); dst = MKR + (size_t)row * 64 + (nb - 2816); }
        else if (nb < 2944) {}
        else if (nb < 3456) { v = v * 0.08838834764831845f; dst = HQ + (size_t)row * 512 + (nb - 2944); }
        else if (nb < 4480) {
          const int cb = nb - 3456;
#pragma unroll
          for (int reg = 0; reg < 16; ++reg) {
            const int c = cb + (reg & 3) + 8 * (reg >> 2) + 4 * h2;
            float lb = 0.f;
            if (l == 1) lb = sigmoidf_(p.hg_lb[1024 + c] - p.hg_lb[c]);
            v[reg] = (1.f - lb) * sigmoidf_(-v[reg]);
          }
          dst = HK + (size_t)row * 1024 + cb;
        }
        else if (nb < 4992) dst = HI + (size_t)row * 512 + (nb - 4480);
        else dst = HG + (size_t)row * 512 + (nb - 4992);
        if (dst) {
          dst += 4 * h2;
#pragma unroll
          for (int q = 0; q < 4; ++q) st4bf(dst + 8 * q, v[q * 4], v[q * 4 + 1], v[q * 4 + 2], v[q * 4 + 3]);
        }
      }
    }
  }
}

DEV void gdn_prep_rows(const P& p, int l) {
  char* U = p.ws + OFF_U;
  const bf16_t* GQR = (const bf16_t*)(U + U_GQR);
  bf16_t* GQ2 = (bf16_t*)(U + U_GQ2);
  const float* cw = p.gdn_conv + (size_t)l * 3 * 1536;
  const int lane = TIDX() & 63, wid = TIDX() >> 6;
  for (int r = blockIdx.x * 4 + wid; r < T; r += gridDim.x * 4) {
    bool hp, hn;
    if (r < TL) { const int n = r & 8191; hp = n > 0; hn = n < 8191; } else { const int tt = (r - TL) & 255; hp = tt > 0; hn = tt < 255; }
#pragma unroll
    for (int j = 0; j < 3; ++j) {
      const int c0 = j * 512 + lane * 8;
      const u32x4 z = {0u, 0u, 0u, 0u};
      const u32x4 xc = *(const u32x4*)(GQR + (size_t)r * 1536 + c0);
      const u32x4 xp = hp ? *(const u32x4*)(GQR + (size_t)(r - 1) * 1536 + c0) : z;
      const u32x4 xn = hn ? *(const u32x4*)(GQR + (size_t)(r + 1) * 1536 + c0) : z;
      float val[8]; float ss = 0.f;
#pragma unroll
      for (int i = 0; i < 8; ++i) {
        const unsigned wp = xp[i >> 1], wcur = xc[i >> 1], wn = xn[i >> 1];
        const float fp = (i & 1) ? bfhi(wp) : bflo(wp), fc = (i & 1) ? bfhi(wcur) : bflo(wcur), fn = (i & 1) ? bfhi(wn) : bflo(wn);
        const float s = fp * cw[c0 + i] + fc * cw[1536 + c0 + i] + fn * cw[3072 + c0 + i];
        val[i] = siluf_(s); ss += val[i] * val[i];
      }
      if (j < 2) {
        ss = sum16(ss);
        float sc = rsqrtf(ss + EPS);
        if (j == 0) sc *= 0.08838834764831845f;
#pragma unroll
        for (int i = 0; i < 8; ++i) val[i] *= sc;
      }
      u32x4 o = {pk2(val[0], val[1]), pk2(val[2], val[3]), pk2(val[4], val[5]), pk2(val[6], val[7])};
      *(u32x4*)(GQ2 + (size_t)r * 1536 + c0) = o;
    }
  }
}
DEV void row_scales(const bf16_t* A, int K, float* rs) {
  const int tid = TIDX(), row = tid >> 1, half = tid & 1;
  const bf16_t* a = A + (size_t)row * K + half * (K / 2);
  float ss = 0.f;
  for (int k = 0; k < K / 2; k += 8) {
    const u32x4 w = *(const u32x4*)(a + k);
#pragma unroll
    for (int i = 0; i < 4; ++i) { const float lo = bflo(w[i]), hi = bfhi(w[i]); ss += lo * lo + hi * hi; }
  }
  ss += __shfl_xor(ss, 1);
  if (half == 0) rs[row] = rsqrtf(ss / (float)K + EPS);
}
DEV void mla_prep_gemms(const P& p, char* lds) {
  char* U = p.ws + OFF_U;
  const bf16_t *MQA = (const bf16_t*)(U + U_MQA), *MKVA = (const bf16_t*)(U + U_MKVA);
  const bf16_t *WQ = (const bf16_t*)(p.ws + OFF_WT + WT_WQB), *WKV = (const bf16_t*)(p.ws + OFF_WT + WT_WKVB);
  bf16_t *MQ = (bf16_t*)(U + U_MQ), *MKN = (bf16_t*)(U + U_MKN), *MVT = (bf16_t*)(U + U_MVT);
  const int lane = TIDX() & 63, wid = TIDX() >> 6, wr = wid >> 1, wc = wid & 1, h2 = lane >> 5;
  constexpr int MT = T / 128;
  constexpr float QSCALE = 0.07216878364870322f * 1.4426950408889634f;
  for (int t = vblock(); t < MT * 14; t += gridDim.x) {
    int mt, nt; tile_map(t, MT, 14, mt, nt);
    const bool isq = nt < 6;
    const bf16_t* Ab = isq ? MQA + (size_t)mt * 128 * 384 : MKVA + (size_t)mt * 128 * 256;
    const int K = isq ? 384 : 256;
    float* rsl = (float*)lds;
    __syncthreads();
    row_scales(Ab, K, rsl);
    __syncthreads();
    float rsv[2];
#pragma unroll
    for (int mi = 0; mi < 2; ++mi) rsv[mi] = rsl[wr * 64 + mi * 32 + (lane & 31)];
    __syncthreads();
    f32x16 acc[2][2]; zero_acc<2>(acc);
    if (isq) gemm_core<128>(Ab, 384, WQ + (size_t)nt * 128 * 384, 384, 384, acc, lds);
    else gemm_core<128>(Ab, 256, WKV + (size_t)(nt - 6) * 128 * 256, 256, 256, acc, lds);
#pragma unroll
    for (int mi = 0; mi < 2; ++mi) {
      const int row = mt * 128 + wr * 64 + mi * 32 + (lane & 31);
#pragma unroll
      for (int ni = 0; ni < 2; ++ni) {
        f32x16 v = acc[mi][ni] * rsv[mi];
        if (isq) {
          const int nb = nt * 128 + wc * 64 + ni * 32, jb = nb % 192;
          if (jb >= 128) rope32(v, (jb - 128) >> 5, row, h2);
          v = v * QSCALE;
          bf16_t* dst = MQ + (size_t)row * 768 + nb + 4 * h2;
#pragma unroll
          for (int q = 0; q < 4; ++q) st4bf(dst + 8 * q, v[q * 4], v[q * 4 + 1], v[q * 4 + 2], v[q * 4 + 3]);
        } else {
          const int nb = (nt - 6) * 128 + wc * 64 + ni * 32, head = nb >> 8, jb = nb & 255;
          if (jb < 128) {
            bf16_t* dst = MKN + (size_t)row * 512 + head * 128 + jb + 4 * h2;
#pragma unroll
            for (int q = 0; q < 4; ++q) st4bf(dst + 8 * q, v[q * 4], v[q * 4 + 1], v[q * 4 + 2], v[q * 4 + 3]);
          } else {
            const int b = batch_of(row), kx = kx_of(row);
            bf16_t* dst = MVT + ((size_t)(b * 4 + head) * 128 + (jb - 128) + 4 * h2) * KSP + kx;
#pragma unroll
            for (int reg = 0; reg < 16; ++reg) dst[(size_t)((reg & 3) + 8 * (reg >> 2)) * KSP] = f2bf(v[reg]);
          }
        }
      }
    }
  }
}

template <int BR>
DEV void scan_task(const P& p, int b, int h, int dir, int cgp, char* lds) {
  char* U = p.ws + OFF_U;
  const int tid = TIDX(), lane = tid & 63, w = tid >> 6, kg = lane & 15, ci = lane >> 4;
  const bf16_t *Qs, *Ks, *Vs; int ldq, ldk, ldv;
  if (BR == 0) { const bf16_t* g = (const bf16_t*)(U + U_GQ2); Qs = g + h * 128; Ks = g + 512 + h * 128; Vs = g + 1024 + h * 128 + cgp * 16; ldq = ldk = ldv = 1536; }
  else { Qs = (const bf16_t*)(U + U_HQ) + h * 128; ldq = 512; Ks = (const bf16_t*)(U + U_HK) + dir * 512 + h * 128; ldk = 1024; Vs = (const bf16_t*)(U + U_HI) + h * 128 + cgp * 16; ldv = 512; }
  const float* AB = (const float*)(U + U_GAB);
  bf16_t* O = (bf16_t*)(U + (BR == 0 ? (dir ? U_OGB : U_OGF) : (dir ? U_OHB : U_OHF))) + h * 128 + cgp * 16 + w * 4 + ci;
  constexpr int BUF = 16384 + 1024 + 128 + 128;
  const int sg = 1 - 2 * dir;
  auto rowbase = [&](int s0) -> int {
    const int rb = s0 < 256 ? TL + b * 256 + (dir ? 255 - s0 : s0) : b * 8192 + (dir ? 8191 - (s0 - 256) : (s0 - 256));
    return __builtin_amdgcn_readfirstlane(rb);
  };
  f32x2 S2[4];
#pragma unroll
  for (int i = 0; i < 4; ++i) S2[i] = (f32x2){0.f, 0.f};
  u32x4 g0, g1; bf16_t gv; float gs = 0.f;
  const int st0 = tid >> 5, cc0 = tid & 31;
  auto gload = [&](int bt) {
    const int rb = rowbase(bt * 16);
    const int r0 = rb + sg * st0, r1 = rb + sg * (st0 + 8);
    g0 = cc0 < 16 ? *(const u32x4*)(Ks + (size_t)r0 * ldk + cc0 * 8) : *(const u32x4*)(Qs + (size_t)r0 * ldq + (cc0 - 16) * 8);
    g1 = cc0 < 16 ? *(const u32x4*)(Ks + (size_t)r1 * ldk + cc0 * 8) : *(const u32x4*)(Qs + (size_t)r1 * ldq + (cc0 - 16) * 8);
    gv = Vs[(size_t)(rb + sg * (tid >> 4)) * ldv + (tid & 15)];
    if (BR == 0 && tid < 32) {
      const int rr = rb + sg * (tid & 15);
      gs = AB[(size_t)rr * 16 + (tid < 16 ? 0 : 8) + dir * 4 + h];
    }
  };
  auto lwrite = [&](char* buf) {
    float* kq = (float*)buf;
    f32x4 a = {bflo(g0[0]), bfhi(g0[0]), bflo(g0[1]), bfhi(g0[1])}, bq = {bflo(g0[2]), bfhi(g0[2]), bflo(g0[3]), bfhi(g0[3])};
    *(f32x4*)(kq + st0 * 256 + cc0 * 8) = a; *(f32x4*)(kq + st0 * 256 + cc0 * 8 + 4) = bq;
    f32x4 c = {bflo(g1[0]), bfhi(g1[0]), bflo(g1[1]), bfhi(g1[1])}, d = {bflo(g1[2]), bfhi(g1[2]), bflo(g1[3]), bfhi(g1[3])};
    *(f32x4*)(kq + (st0 + 8) * 256 + cc0 * 8) = c; *(f32x4*)(kq + (st0 + 8) * 256 + cc0 * 8 + 4) = d;
    ((float*)(buf + 16384))[tid] = bf2f(gv);
    if (BR == 0 && tid < 32) ((float*)(buf + 16384 + 1024))[(tid & 15) * 2 + (tid >> 4)] = tid < 16 ? __expf(gs) : gs;
  };
  auto gram = [&](char* buf) {
    const float* kq = (const float*)buf;
    const int di = tid >> 3, sub = tid & 7, pp = di >> 2, wh = di & 3;
    const float* xv = kq + (2 * pp + (wh == 1 ? 0 : 1)) * 256 + (wh == 0 ? 0 : 128) + sub * 16;
    const float* yv = kq + (2 * pp + (wh == 3 ? 1 : 0)) * 256 + sub * 16;
    float acc = 0.f;
#pragma unroll
    for (int i = 0; i < 4; ++i) { const f32x4 x = *(const f32x4*)(xv + 4 * i), y = *(const f32x4*)(yv + 4 * i); acc += (x[0] * y[0] + x[1] * y[1]) + (x[2] * y[2] + x[3] * y[3]); }
    acc += __int_as_float(__builtin_amdgcn_update_dpp(0, __float_as_int(acc), 0xB1, 0xf, 0xf, true));
    acc += __int_as_float(__builtin_amdgcn_update_dpp(0, __float_as_int(acc), 0x4E, 0xf, 0xf, true));
    acc += __int_as_float(__builtin_amdgcn_update_dpp(0, __float_as_int(acc), 0x141, 0xf, 0xf, true));
    if (sub == 0) ((float*)(buf + 16384 + 1024 + 128))[di] = acc;
  };
  constexpr int NBT = KSP / 16;
  __syncthreads();
  gload(0); lwrite(lds);
  gload(1);
  __syncthreads();
  if (BR == 0) gram(lds);
  lwrite(lds + BUF);
  gload(2);
  __syncthreads();
  int ic = 0;
  for (int bt = 0; bt < NBT; ++bt) {
    char* cur = lds + ic * BUF;
    const int i1 = ic == 2 ? 0 : ic + 1, i2 = i1 == 2 ? 0 : i1 + 1;
    if (bt + 2 < NBT) lwrite(lds + i2 * BUF);
    if (bt + 3 < NBT) gload(bt + 3);
    const float* kq = (const float*)cur;
    const float* vv = (const float*)(cur + 16384);
    const float* ab = (const float*)(cur + 16384 + 1024);
    const float* gm = (const float*)(cur + 16384 + 1024 + 128);
    float osel = 0.f;
    if (BR == 0) {
      f32x4 nk00 = *(const f32x4*)(kq + kg * 4), nk01 = *(const f32x4*)(kq + 64 + kg * 4), nq00 = *(const f32x4*)(kq + 128 + kg * 4), nq01 = *(const f32x4*)(kq + 192 + kg * 4);
      f32x4 nk10 = *(const f32x4*)(kq + 256 + kg * 4), nk11 = *(const f32x4*)(kq + 320 + kg * 4), nq10 = *(const f32x4*)(kq + 384 + kg * 4), nq11 = *(const f32x4*)(kq + 448 + kg * 4);
      float nv0 = vv[w * 4 + ci], nv1 = vv[16 + w * 4 + ci];
      f32x4 nabv = *(const f32x4*)(ab), ngr = *(const f32x4*)(gm);
#pragma unroll
      for (int pp = 0; pp < 8; ++pp) {
        const f32x4 k00 = nk00, k01 = nk01, q00 = nq00, q01 = nq01, k10 = nk10, k11 = nk11, q10 = nq10, q11 = nq11;
        const float v0 = nv0, v1 = nv1;
        const f32x4 abv = nabv;
        const f32x4 gr = ngr;
        if (pp + 1 < 8) {
          const float* kq0 = kq + (2 * pp + 2) * 256; const float* kq1 = kq0 + 256;
          nk00 = *(const f32x4*)(kq0 + kg * 4); nk01 = *(const f32x4*)(kq0 + 64 + kg * 4); nq00 = *(const f32x4*)(kq0 + 128 + kg * 4); nq01 = *(const f32x4*)(kq0 + 192 + kg * 4);
          nk10 = *(const f32x4*)(kq1 + kg * 4); nk11 = *(const f32x4*)(kq1 + 64 + kg * 4); nq10 = *(const f32x4*)(kq1 + 128 + kg * 4); nq11 = *(const f32x4*)(kq1 + 192 + kg * 4);
          nv0 = vv[(2 * pp + 2) * 16 + w * 4 + ci]; nv1 = vv[(2 * pp + 3) * 16 + w * 4 + ci];
          nabv = *(const f32x4*)(ab + (pp + 1) * 4); ngr = *(const f32x4*)(gm + (pp + 1) * 4);
        }
        __builtin_amdgcn_sched_barrier(0);
        const f32x2 k0a = {k00[0], k00[1]}, k0b = {k00[2], k00[3]}, k0c = {k01[0], k01[1]}, k0d = {k01[2], k01[3]};
        const f32x2 k1a = {k10[0], k10[1]}, k1b = {k10[2], k10[3]}, k1c = {k11[0], k11[1]}, k1d = {k11[2], k11[3]};
        const f32x2 q0a = {q00[0], q00[1]}, q0b = {q00[2], q00[3]}, q0c = {q01[0], q01[1]}, q0d = {q01[2], q01[3]};
        const f32x2 q1a = {q10[0], q10[1]}, q1b = {q10[2], q10[3]}, q1c = {q11[0], q11[1]}, q1d = {q11[2], q11[3]};
        const f32x2 t0 = (k0a * S2[0] + k0b * S2[1]) + (k0c * S2[2] + k0d * S2[3]);
        const f32x2 t1 = (k1a * S2[0] + k1b * S2[1]) + (k1c * S2[2] + k1d * S2[3]);
        const f32x2 t2 = (q0a * S2[0] + q0b * S2[1]) + (q0c * S2[2] + q0d * S2[3]);
        const f32x2 t3 = (q1a * S2[0] + q1b * S2[1]) + (q1c * S2[2] + q1d * S2[3]);
        const float kS0 = rowsum16(t0[0] + t0[1]), kS1 = rowsum16(t1[0] + t1[1]), qS0 = rowsum16(t2[0] + t2[1]), qS1 = rowsum16(t3[0] + t3[1]);
        const float a0 = abv[0], b0 = abv[1], a1 = abv[2], b1 = abv[3];
        const float c0 = b0 * (v0 - a0 * kS0);
        const float d1 = a0 * kS1 + gr[0] * c0;
        const float c1 = b1 * (v1 - a1 * d1);
        const float o0 = a0 * qS0 + gr[1] * c0;
        const float o1 = a1 * (a0 * qS1 + gr[2] * c0) + gr[3] * c1;
        const float aa = a1 * a0, e0 = a1 * c0;
        const f32x2 aav = {aa, aa}, e0v = {e0, e0}, c1v = {c1, c1};
        S2[0] = (aav * S2[0] + k0a * e0v) + k1a * c1v; S2[1] = (aav * S2[1] + k0b * e0v) + k1b * c1v;
        S2[2] = (aav * S2[2] + k0c * e0v) + k1c * c1v; S2[3] = (aav * S2[3] + k0d * e0v) + k1d * c1v;
        osel = (kg == 2 * pp) ? o0 : osel;
        osel = (kg == 2 * pp + 1) ? o1 : osel;
      }
    } else {
      f32x4 nk0 = *(const f32x4*)(kq + kg * 4), nk1 = *(const f32x4*)(kq + 64 + kg * 4), nq0 = *(const f32x4*)(kq + 128 + kg * 4), nq1 = *(const f32x4*)(kq + 192 + kg * 4);
      float nv = vv[w * 4 + ci];
#pragma unroll
      for (int st = 0; st < 16; ++st) {
        const f32x4 k0 = nk0, k1 = nk1, q0 = nq0, q1 = nq1;
        const float v = nv;
        if (st + 1 < 16) {
          nk0 = *(const f32x4*)(kq + (st + 1) * 256 + kg * 4); nk1 = *(const f32x4*)(kq + (st + 1) * 256 + 64 + kg * 4);
          nq0 = *(const f32x4*)(kq + (st + 1) * 256 + 128 + kg * 4); nq1 = *(const f32x4*)(kq + (st + 1) * 256 + 192 + kg * 4);
          nv = vv[(st + 1) * 16 + w * 4 + ci];
        }
        __builtin_amdgcn_sched_barrier(0);
        const f32x2 ka = {k0[0], k0[1]}, kb = {k0[2], k0[3]}, kc = {k1[0], k1[1]}, kd = {k1[2], k1[3]};
        const f32x2 qa = {q0[0], q0[1]}, qb = {q0[2], q0[3]}, qc = {q1[0], q1[1]}, qd = {q1[2], q1[3]};
        const f32x2 v2 = {v, v};
        S2[0] = S2[0] + ka * (v2 - S2[0]); S2[1] = S2[1] + kb * (v2 - S2[1]); S2[2] = S2[2] + kc * (v2 - S2[2]); S2[3] = S2[3] + kd * (v2 - S2[3]);
        const f32x2 u = (qa * S2[0] + qb * S2[1]) + (qc * S2[2] + qd * S2[3]);
        const float o = rowsum16(u[0] + u[1]);
        osel = (kg == st) ? o : osel;
      }
    }
    O[(size_t)(rowbase(bt * 16) + sg * kg) * 512] = f2bf(osel);
    if (BR == 0 && bt + 1 < NBT) gram(lds + i1 * BUF);
    __syncthreads();
    ic = i1;
  }
}

DEV void attn_task(const P& p, int b, int h, int r0, int kx_begin, int nkt, char* lds) {
  char* U = p.ws + OFF_U;
  const bf16_t *MQ = (const bf16_t*)(U + U_MQ), *MKN = (const bf16_t*)(U + U_MKN), *MKR = (const bf16_t*)(U + U_MKR), *MVT = (const bf16_t*)(U + U_MVT);
  bf16_t* YB = (bf16_t*)(p.ws + OFF_A);
  const int tid = TIDX(), lane = tid & 63, w = tid >> 6, h2 = lane >> 5, l31 = lane & 31;
  const int qrow = r0 + w * 32 + l31;
  bf16x8 qf[12];
#pragma unroll
  for (int s = 0; s < 12; ++s) qf[s] = *(const bf16x8*)(MQ + (size_t)qrow * 768 + h * 192 + s * 16 + h2 * 8);
  f32x16 oacc[4];
#pragma unroll
  for (int d = 0; d < 4; ++d)
#pragma unroll
    for (int i = 0; i < 16; ++i) oacc[d][i] = 0.f;
  float m = -1e30f, lsum = 0.f;
  char* Kl = lds;
  char* Vl = lds + 64 * 384;
  const int pi = (l31 & 19) | ((l31 & 4) << 1) | ((l31 & 8) >> 1);
  const bf16_t* vbase = MVT + (size_t)(b * 4 + h) * 128 * KSP;
  for (int kt = 0; kt < nkt; ++kt) {
    const int kx0 = kx_begin + kt * 64;
    const int rb = kx0 < 8192 ? b * 8192 + kx0 : TL + b * 256 + (kx0 - 8192);
    u32x4 kr[6], vr[4];
#pragma unroll
    for (int i = 0; i < 6; ++i) {
      const int c = tid + 256 * i, row = c / 24, ch = c % 24;
      kr[i] = ch < 16 ? *(const u32x4*)(MKN + (size_t)(rb + row) * 512 + h * 128 + ch * 8) : *(const u32x4*)(MKR + (size_t)(rb + row) * 64 + (ch - 16) * 8);
    }
#pragma unroll
    for (int i = 0; i < 4; ++i) {
      const int c = tid + 256 * i, row = c >> 3, ch = c & 7;
      vr[i] = *(const u32x4*)(vbase + (size_t)row * KSP + kx0 + ch * 8);
    }
    __syncthreads();
#pragma unroll
    for (int i = 0; i < 6; ++i) {
      const int c = tid + 256 * i, row = c / 24, ch = c % 24;
      *(u32x4*)(Kl + row * 384 + (((ch & 24) | ((ch ^ (row >> 1)) & 7)) << 4)) = kr[i];
    }
#pragma unroll
    for (int i = 0; i < 4; ++i) {
      const int c = tid + 256 * i, row = c >> 3, ch = c & 7;
      *(u32x4*)(Vl + swz(row, ch)) = vr[i];
    }
    __syncthreads();
    f32x16 sacc[2];
#pragma unroll
    for (int i = 0; i < 16; ++i) { sacc[0][i] = 0.f; sacc[1][i] = 0.f; }
#pragma unroll
    for (int s = 0; s < 12; ++s) {
      const int ch = s * 2 + h2;
#pragma unroll
      for (int kb = 0; kb < 2; ++kb) {
        const int row = kb * 32 + pi;
        const bf16x8 kf = *(const bf16x8*)(Kl + row * 384 + (((ch & 24) | ((ch ^ (row >> 1)) & 7)) << 4));
        sacc[kb] = __builtin_amdgcn_mfma_f32_32x32x16_bf16(kf, qf[s], sacc[kb], 0, 0, 0);
      }
      if (s & 1) __builtin_amdgcn_sched_barrier(0);
    }
    float mx = sacc[0][0];
#pragma unroll
    for (int i = 1; i < 16; ++i) mx = fmaxf(mx, sacc[0][i]);
#pragma unroll
    for (int i = 0; i < 16; ++i) mx = fmaxf(mx, sacc[1][i]);
    mx = fmaxf(mx, __shfl_xor(mx, 32));
    const float mn = fmaxf(m, mx);
    const float alpha = __builtin_amdgcn_exp2f(m - mn);
    m = mn;
    float ps = 0.f;
#pragma unroll
    for (int kb = 0; kb < 2; ++kb)
#pragma unroll
      for (int i = 0; i < 16; ++i) { const float e = __builtin_amdgcn_exp2f(sacc[kb][i] - mn); sacc[kb][i] = e; ps += e; }
    lsum = lsum * alpha + ps;
#pragma unroll
    for (int d = 0; d < 4; ++d) oacc[d] = oacc[d] * alpha;
    bf16x8 pf[4];
#pragma unroll
    for (int kb = 0; kb < 2; ++kb)
#pragma unroll
      for (int s2 = 0; s2 < 2; ++s2) {
        u32x4 pw = {pk2(sacc[kb][8 * s2 + 0], sacc[kb][8 * s2 + 1]), pk2(sacc[kb][8 * s2 + 2], sacc[kb][8 * s2 + 3]),
                    pk2(sacc[kb][8 * s2 + 4], sacc[kb][8 * s2 + 5]), pk2(sacc[kb][8 * s2 + 6], sacc[kb][8 * s2 + 7])};
        pf[kb * 2 + s2] = __builtin_bit_cast(bf16x8, pw);
      }
    __builtin_amdgcn_sched_barrier(0);
#pragma unroll
    for (int s = 0; s < 4; ++s) {
#pragma unroll
      for (int d = 0; d < 4; ++d) {
        const bf16x8 vf = *(const bf16x8*)(Vl + swz(d * 32 + l31, s * 2 + h2));
        oacc[d] = __builtin_amdgcn_mfma_f32_32x32x16_bf16(vf, pf[s], oacc[d], 0, 0, 0);
      }
      __builtin_amdgcn_sched_barrier(0);
    }
  }
  lsum += __shfl_xor(lsum, 32);
  const float inv = 1.f / lsum;
  bf16_t* dst = YB + (size_t)qrow * 512 + h * 128 + 4 * h2;
#pragma unroll
  for (int d = 0; d < 4; ++d)
#pragma unroll
    for (int q = 0; q < 4; ++q) st4bf(dst + d * 32 + 8 * q, oacc[d][q * 4] * inv, oacc[d][q * 4 + 1] * inv, oacc[d][q * 4 + 2] * inv, oacc[d][q * 4 + 3] * inv);
  __syncthreads();
}

DEV void mixer_item(const P& p, int it, char* lds) {
  if (it < 256) {
    const int br = it >> 7, rem = it & 127, cgp = rem & 7, dir = (rem >> 3) & 1, h = (rem >> 4) & 3, b = rem >> 6;
    if (br == 0) scan_task<0>(p, b, h, dir, cgp, lds); else scan_task<1>(p, b, h, dir, cgp, lds);
  } else {
    const int a = it - 256;
    if (a < 512) { const int qt = a & 63, h = (a >> 6) & 3, b = a >> 8; attn_task(p, b, h, b * 8192 + qt * 128, 0, 132, lds); }
    else { const int c = a - 512, qt = c & 1, h = (c >> 1) & 3, b = c >> 3; attn_task(p, b, h, TL + b * 256 + qt * 128, 8192, 4, lds); }
  }
}
DEV void mixer_phase(const P& p, int l, char* lds) {
  __shared__ int sh_task;
  unsigned* ctr = (unsigned*)(p.ws + OFF_BAR) + 3600 + l * 64;
  const int G = gridDim.x;
  for (int it = blockIdx.x; it < 256; it += G) mixer_item(p, it, lds);
  for (;;) {
    __syncthreads();
    if (TIDX() == 0) sh_task = (int)atomicAdd(ctr, 1u);
    __syncthreads();
    const int a = sh_task;
    if (a >= 528) break;
    mixer_item(p, 256 + a, lds);
  }
}

DEV void readout_phase(const P& p, int l) {
  char* U = p.ws + OFF_U;
  const bf16_t *OGF = (const bf16_t*)(U + U_OGF), *OGB = (const bf16_t*)(U + U_OGB), *OHF = (const bf16_t*)(U + U_OHF), *OHB = (const bf16_t*)(U + U_OHB);
  const bf16_t *GG = (const bf16_t*)(U + U_GG), *HG = (const bf16_t*)(U + U_HG);
  bf16_t *YA = (bf16_t*)(U + U_YA), *YC = (bf16_t*)(U + U_YC);
  const int lane = TIDX() & 63, wid = TIDX() >> 6;
  for (int r = blockIdx.x * 4 + wid; r < T; r += gridDim.x * 4) {
#pragma unroll
    for (int br = 0; br < 2; ++br) {
      const bf16_t* of = br ? OHF : OGF; const bf16_t* ob = br ? OHB : OGB; const bf16_t* gt = br ? HG : GG;
      const float* nw = (br ? p.hg_norm : p.gdn_norm) + l * 128 + (lane & 15) * 8;
      const size_t off = (size_t)r * 512 + lane * 8;
      const u32x4 a = *(const u32x4*)(of + off), b2 = *(const u32x4*)(ob + off), g = *(const u32x4*)(gt + off);
      float o[8]; float ss = 0.f;
#pragma unroll
      for (int i = 0; i < 4; ++i) { o[2 * i] = bflo(a[i]) + bflo(b2[i]); o[2 * i + 1] = bfhi(a[i]) + bfhi(b2[i]); }
#pragma unroll
      for (int i = 0; i < 8; ++i) ss += o[i] * o[i];
      ss = sum16(ss);
      const float rs = rsqrtf(ss * (1.f / 128.f) + EPS);
      float y[8];
#pragma unroll
      for (int i = 0; i < 8; ++i) { const float gv = (i & 1) ? bfhi(g[i >> 1]) : bflo(g[i >> 1]); y[i] = o[i] * rs * nw[i] * siluf_(gv); }
      u32x4 w = {pk2(y[0], y[1]), pk2(y[2], y[3]), pk2(y[4], y[5]), pk2(y[6], y[7])};
      *(u32x4*)((br ? YC : YA) + off) = w;
    }
  }
}

DEV void merge_gemm(const P& p, char* lds, int MT) {
  char* U = p.ws + OFF_U;
  const bf16_t* ARE = (const bf16_t*)(U + U_ARE);
  const bf16_t* WG = (const bf16_t*)(p.ws + OFF_WT + WT_WG);
  const bf16_t* WBR = (const bf16_t*)(p.ws + OFF_WT + WT_WBR);
  bf16_t* M = (bf16_t*)(U + U_M);
  const int lane = TIDX() & 63, wid = TIDX() >> 6, wr = wid >> 1, wc = wid & 1, h2 = lane >> 5;
  constexpr int NT = 1024 / 64;
  for (int t = vblock(); t < MT * NT; t += gridDim.x) {
    int mt, nt; tile_map(t, MT, NT, mt, nt);
    f32x16 macc[2][1]; zero_acc<1>(macc);
#pragma unroll 1
    for (int j = 0; j < 3; ++j) {
      const bf16_t* Yj = j == 0 ? (const bf16_t*)(U + U_YA) : (j == 1 ? (const bf16_t*)(p.ws + OFF_A) : (const bf16_t*)(U + U_YC));
      f32x16 ag[2][1]; zero_acc<1>(ag);
      gemm_core<64>(ARE + (size_t)mt * 128 * 1024, 1024, WG + ((size_t)j * 1024 + nt * 64) * 1024, 1024, 1024, ag, lds);
      f32x16 ab[2][1]; zero_acc<1>(ab);
      gemm_core<64>(Yj + (size_t)mt * 128 * 512, 512, WBR + ((size_t)j * 1024 + nt * 64) * 512, 512, 512, ab, lds);
#pragma unroll
      for (int mi = 0; mi < 2; ++mi)
#pragma unroll
        for (int i = 0; i < 16; ++i) macc[mi][0][i] += sigmoidf_(ag[mi][0][i]) * ab[mi][0][i];
    }
#pragma unroll
    for (int mi = 0; mi < 2; ++mi) {
      const int row = mt * 128 + wr * 64 + mi * 32 + (lane & 31);
      bf16_t* dst = M + (size_t)row * D + nt * 64 + wc * 32 + 4 * h2;
#pragma unroll
      for (int q = 0; q < 4; ++q) st4bf(dst + 8 * q, macc[mi][0][q * 4], macc[mi][0][q * 4 + 1], macc[mi][0][q * 4 + 2], macc[mi][0][q * 4 + 3]);
    }
  }
}

DEV void run_phase(const P& p, int ph, char* lds) {
  char* U = p.ws + OFF_U;
  bf16_t* Abuf = (bf16_t*)(p.ws + OFF_A);
  bf16_t* Y = (bf16_t*)(U + U_Y);
  if (ph == 0) { phase0(p, lds); return; }
  if (ph == 1) { phase0b(p); return; }
  if (ph == 2) { row_phase(p, false, 0, nullptr, 0, 0.f, 0, true, 0, 0, 0, Abuf); return; }
  const int l = (ph - 3) / 13, s = (ph - 3) % 13;
  const int MTall = T / 128, MTpost = (l == 1) ? TL / 128 : T / 128, rows_post = (l == 1) ? TL : T;
  switch (s) {
    case 0: ffn_gemm1(p, lds, MTall); break;
    case 1: gemm_f32out((const bf16_t*)(U + U_HFF), DFF, (const bf16_t*)(p.ws + OFF_WT + WT_WO), Y, lds, MTall); break;
    case 2: row_phase(p, true, l, Y, 2, 0.5f, 1, true, l, 2, 3, Abuf); conv_mixer(p, l, lds); break;
    case 3: win_gemm(p, l, lds); break;
    case 4: gdn_prep_rows(p, l); mla_prep_gemms(p, lds); break;
    case 5: mixer_phase(p, l, lds); break;
    case 6: readout_phase(p, l); row_phase(p, false, 0, nullptr, 0, 0.f, 0, true, l, 2, 3, (bf16_t*)(U + U_ARE)); break;
    case 7: merge_gemm(p, lds, MTpost); break;
    case 8: gemm_f32out((const bf16_t*)(U + U_M), 1024, (const bf16_t*)(p.ws + OFF_WT + WT_WOUT), Y, lds, MTpost); break;
    case 9: row_phase(p, true, l, Y, 5, 1.0f, 3, true, l, 4, 6, Abuf, rows_post); conv_ffn(p, l, 1, lds); break;
    case 10: ffn_gemm1(p, lds, MTpost); break;
    case 11: gemm_f32out((const bf16_t*)(U + U_HFF), DFF, (const bf16_t*)(p.ws + OFF_WT + WT_WO), Y, lds, MTpost); break;
    case 12:
      if (l == 0) { row_phase(p, true, 0, Y, 8, 0.5f, 5, true, 1, 0, 0, Abuf); conv_ffn(p, 1, 0, lds); }
      else row_phase(p, true, 1, Y, 8, 0.5f, 5, false, 0, 0, 0, Abuf, TL);
      break;
    default: break;
  }
}
constexpr int NPHASE = 3 + 2 * 13;

template <int PH>
DEV void run_all(const P& p, char* lds, const XcdBarrier& xb) {
  run_phase(p, PH, lds);
  if constexpr (PROBE_SCAN_ONLY != 0 && PH >= 3 && (PH - 3) % 13 == 5) { GRID_SYNC(); if (PROBE_SCAN_ONLY == 1) { if (blockIdx.x < 256) mixer_item(p, blockIdx.x, lds); } else { for (int a = (int)blockIdx.x - 256; a >= 0 && a < 528; a += gridDim.x - 256) mixer_item(p, 256 + a, lds); } }
  if constexpr (PROBE_DUP_S >= 0 && PH >= 3 && ((PH - 3) % 13 == PROBE_DUP_S || (PH - 3) % 13 == PROBE_DUP_S2)) { GRID_SYNC(); run_phase(p, PH, lds); }
  if constexpr (PH + 1 < NPHASE) { GRID_SYNC(); run_all<PH + 1>(p, lds, xb); }
}
#if COOP
__global__ void __launch_bounds__(256, 2) mega(P p) {
  __shared__ __attribute__((aligned(16))) char lds[65536];
  __shared__ uint4 xb_words;
  if (__builtin_amdgcn_workitem_id_x() == 0) xb_words = make_uint4(0u, 0u, 0u, 0u);
  __syncthreads();
  XcdBarrier xb = xcd_barrier_post((unsigned*)(p.ws + OFF_BAR), (volatile LAS unsigned*)&xb_words);
  if (p.ws == nullptr) cg::this_grid().sync();
  run_all<0>(p, lds, xb);
}
#else
template <int PH>
__global__ void __launch_bounds__(256, 2) mega(P p) {
  __shared__ __attribute__((aligned(16))) char lds[65536];
  run_phase(p, PH, lds);
}
template <int PH> void launch_all(const P& p, int grid, hipStream_t stream) {
  hipLaunchKernelGGL(mega<PH>, dim3(grid), dim3(256), 0, stream, p);
  if constexpr (PH + 1 < NPHASE) launch_all<PH + 1>(p, grid, stream);
}
#endif

extern "C" void kernel_launch(void* const* d_in, const int* in_sizes, int n_in, void* d_out, int out_size, void* d_ws, size_t ws_size, hipStream_t stream) {
  if (ws_size < WS_NEED) { fprintf(stderr, "workspace too small: %zu < %zu\n", ws_size, (size_t)WS_NEED); return; }
  P p{};
  const float** pp = (const float**)&p;
  for (int i = 0; i < 22; ++i) pp[i] = (const float*)d_in[i];
  p.out = (float*)d_out; p.ws = (char*)d_ws;
  static int grid_blocks = 0;
  if (!grid_blocks) {
    int dev = 0, cus = 0, per_cu = 0;
    (void)hipGetDevice(&dev);
    (void)hipDeviceGetAttribute(&cus, hipDeviceAttributeMultiprocessorCount, dev);
#if COOP
    (void)hipOccupancyMaxActiveBlocksPerMultiprocessor(&per_cu, mega, 256, 0);
#else
    per_cu = 2;
#endif
    if (per_cu > 2) per_cu = 2;
    if (per_cu < 1) per_cu = 1;
    grid_blocks = cus * per_cu;
  }
#if COOP
  (void)hipMemsetAsync((char*)d_ws + OFF_BAR, 0, BAR_BYTES, stream);
  void* args[] = {&p};
  hipError_t e = hipLaunchCooperativeKernel((void*)mega, dim3(grid_blocks), dim3(256), args, 0, stream);
  if (e != hipSuccess) fprintf(stderr, "cooperative launch failed: %s (grid %d)\n", hipGetErrorString(e), grid_blocks);
#else
  launch_all<0>(p, grid_blocks, stream);
#endif
}
```

```cpp
#include <hip/hip_runtime.h>
#include <hip/hip_cooperative_groups.h>
#include <cstdint>
#include <cstdio>
namespace cg = cooperative_groups;

typedef unsigned short bf16_t;
typedef short bf16x8 __attribute__((ext_vector_type(8)));
typedef float f32x16 __attribute__((ext_vector_type(16)));
typedef float f32x4 __attribute__((ext_vector_type(4)));
typedef float f32x2 __attribute__((ext_vector_type(2)));
typedef unsigned u32x4 __attribute__((ext_vector_type(4)));
typedef unsigned u32x2 __attribute__((ext_vector_type(2)));
#define DEV __device__ __forceinline__

#ifndef COOP
#define COOP 1
#endif
#ifndef PROBE_SCAN_ONLY
#define PROBE_SCAN_ONLY 0
#endif
#ifndef PROBE_DUP_S
#define PROBE_DUP_S -1
#define PROBE_DUP_S2 -1
#endif

constexpr int T = 16896, TL = 16384, NLAT = 8192, NCTX = 256, D = 1024, DFF = 2816;
constexpr int KSP = 8448;
constexpr float EPS = 1e-6f;
constexpr int WIN_LD = 8400;
constexpr int NWIN = 5504;

constexpr size_t SZ(size_t cols, size_t b) { return (size_t)T * cols * b; }
constexpr size_t OFF_BAR = 0, BAR_BYTES = 16384;
constexpr size_t OFF_MODP = BAR_BYTES;
constexpr size_t OFF_MOD  = OFF_MODP + 4ull * 2 * 3 * 9216 * 4;
constexpr size_t OFF_HCTX = OFF_MOD + 2ull * 3 * 9216 * 4;
constexpr size_t OFF_WT   = OFF_HCTX + 512ull * 1024 * 4;
constexpr size_t WT_BYTES = 24ull << 20;
constexpr size_t OFF_A    = OFF_WT + WT_BYTES;
constexpr size_t OFF_U    = OFF_A + SZ(1024, 2);
constexpr size_t U_GQR  = 0;
constexpr size_t U_MQA  = U_GQR + SZ(1536, 2);
constexpr size_t U_MKVA = U_MQA + SZ(384, 2);
constexpr size_t U_GG   = U_MKVA + SZ(256, 2);
constexpr size_t U_GAB  = U_GG + SZ(512, 2);
constexpr size_t U_MKR  = U_GAB + SZ(16, 4);
constexpr size_t U_HQ   = U_MKR + SZ(64, 2);
constexpr size_t U_HK   = U_HQ + SZ(512, 2);
constexpr size_t U_HI   = U_HK + SZ(1024, 2);
constexpr size_t U_HG   = U_HI + SZ(512, 2);
constexpr size_t U_GQ2  = U_HG + SZ(512, 2);
constexpr size_t U_MQ   = U_GQ2 + SZ(1536, 2);
constexpr size_t U_MKN  = U_MQ + SZ(768, 2);
constexpr size_t U_MVT  = U_MKN + SZ(512, 2);
constexpr size_t U_END  = U_MVT + SZ(512, 2);
constexpr size_t U_OGF = U_GQR, U_OGB = U_GQR + SZ(512, 2), U_OHF = U_GQR + SZ(1024, 2), U_OHB = U_MQA;
constexpr size_t U_YB = 0;
constexpr size_t U_ARE = U_HK, U_YA = U_GQ2, U_YC = U_GQ2 + SZ(512, 2), U_M = U_MQ;
constexpr size_t U_HFF = 0;
constexpr size_t U_Y   = SZ(2816, 2);
constexpr size_t WS_NEED = OFF_U + U_END;
static_assert(U_Y + SZ(1024, 4) <= U_M, "Y overlaps M");
constexpr size_t WT_WI = 0, WT_WO = 5632ull * 1024 * 2;
constexpr size_t WT_WIN = 0, WT_WG = (size_t)NWIN * 1024 * 2, WT_WQB = WT_WG + 3072ull * 1024 * 2, WT_WKVB = WT_WQB + 768ull * 384 * 2,
                 WT_WBR = WT_WKVB + 1024ull * 256 * 2, WT_WOUT = WT_WBR + 3ull * 1024 * 512 * 2, WT_MIX_END = WT_WOUT + 1024ull * 1024 * 2;
static_assert(WT_MIX_END <= WT_BYTES, "WT too small");
static_assert(WT_WO + 1024ull * 2816 * 2 <= WT_BYTES, "WT too small");

struct P {
  const float *x, *c, *ctx, *c_ctx, *w_ada, *b_ada, *norm_w, *ffn_w_in, *ffn_w_out, *w_in, *gdn_conv, *gdn_a_log, *gdn_dt_bias, *gdn_norm,
      *mla_q_norm, *mla_kv_norm, *mla_w_q_b, *mla_w_kv_b, *hg_lb, *hg_norm, *w_branch, *w_out;
  float* out; char* ws;
};

DEV unsigned pk2(float lo, float hi) {
  typedef __bf16 bf2 __attribute__((ext_vector_type(2)));
  f32x2 v = {lo, hi};
  bf2 b = __builtin_convertvector(v, bf2);
  return __builtin_bit_cast(unsigned, b);
}
DEV bf16_t f2bf(float x) { return (bf16_t)(pk2(x, 0.f) & 0xffffu); }
DEV float bflo(unsigned w) { return __uint_as_float(w << 16); }
DEV float bfhi(unsigned w) { return __uint_as_float(w & 0xffff0000u); }
DEV float bf2f(bf16_t h) { return __uint_as_float((unsigned)h << 16); }
DEV void st4bf(bf16_t* dst, float a, float b, float c, float d) { u32x2 w = {pk2(a, b), pk2(c, d)}; *(u32x2*)dst = w; }
DEV float sigmoidf_(float x) { return 1.f / (1.f + __expf(-x)); }
DEV float siluf_(float x) { return x / (1.f + __expf(-x)); }
DEV float wave_sum(float v) {
#pragma unroll
  for (int o = 32; o > 0; o >>= 1) v += __shfl_xor(v, o);
  return v;
}
DEV float sum16(float v) {
#pragma unroll
  for (int o = 8; o > 0; o >>= 1) v += __shfl_xor(v, o);
  return v;
}
DEV float rowsum16(float x) {
  x += __int_as_float(__builtin_amdgcn_update_dpp(0, __float_as_int(x), 0xB1, 0xf, 0xf, true));
  x += __int_as_float(__builtin_amdgcn_update_dpp(0, __float_as_int(x), 0x4E, 0xf, 0xf, true));
  x += __int_as_float(__builtin_amdgcn_update_dpp(0, __float_as_int(x), 0x141, 0xf, 0xf, true));
  x += __int_as_float(__builtin_amdgcn_update_dpp(0, __float_as_int(x), 0x140, 0xf, 0xf, true));
  return x;
}
DEV int TIDX() { int t = __builtin_amdgcn_workitem_id_x(); asm volatile("" : "+v"(t)); return t; }
DEV int sel_of(int r) { return r < TL ? (r >> 13) : 2; }
DEV int kx_of(int r) { return r < TL ? (r & 8191) : 8192 + ((r - TL) & 255); }
DEV int batch_of(int r) { return r < TL ? (r >> 13) : ((r - TL) >> 8); }
DEV int swz(int row, int ch) { return row * 128 + (((ch ^ (row >> 1)) & 7) << 4); }


DEV int vblock() { const int G = gridDim.x, j = blockIdx.x; return (G & 7) ? j : (j & 7) * (G >> 3) + (j >> 3); }
DEV void tile_map(int idx, int MT, int NT, int& mt, int& nt) {
  const int nig = 8 * NT, g = idx / nig, fm = g * 8, gsz = (MT - fm) < 8 ? (MT - fm) : 8, r = idx - g * nig;
  mt = fm + r % gsz; nt = r / gsz;
}


#define XB_TMO      128
#define XB_XCNT(j)  (256  + 64 * (j))
#define XB_XSUB(j)  (1280 + 64 * (j))
#define XB_XGEN(j)  (2304 + 64 * (j))
#define XB_TOP      3328
#define XB_TOPGEN   3392
#define XCD_BAR_WORDS 3456
#define XB_SPIN_CAP (1u << 22)
#define LAS __attribute__((address_space(3)))
static_assert(XCD_BAR_WORDS * 4 <= BAR_BYTES, "barrier words");
DEV unsigned xb_ld(unsigned* p) { return __hip_atomic_load(p, __ATOMIC_RELAXED, __HIP_MEMORY_SCOPE_AGENT); }
DEV unsigned xb_add(unsigned* p, unsigned v) { return __hip_atomic_fetch_add(p, v, __ATOMIC_RELAXED, __HIP_MEMORY_SCOPE_AGENT); }
DEV unsigned xb_xcc_id() { return (unsigned)__builtin_amdgcn_s_getreg((3 << 11) | 20) & 0xFu; }
#define XB_SPIN(cond, bar) do { unsigned _sp = 0; while (cond) { __builtin_amdgcn_s_sleep(1); \
    if ((++_sp & 255u) == 0u) { if (xb_ld(&(bar)[XB_TMO])) break; if (_sp > XB_SPIN_CAP) { atomicAdd(&(bar)[XB_TMO], 1u); break; } } } } while (0)
struct XcdBarrier { unsigned* bar; unsigned x; volatile LAS unsigned* st; };
DEV XcdBarrier xcd_barrier_post(unsigned* bar, volatile LAS unsigned* st) {
  XcdBarrier b; b.bar = bar; b.x = xb_xcc_id(); b.st = st;
  if (__builtin_amdgcn_workitem_id_x() == 0) (void)xb_add(&bar[XB_XCNT(b.x)], 1u);
  return b;
}
DEV void xcd_barrier_complete(unsigned* bar, unsigned x, unsigned& nloc, unsigned& nx) {
  const unsigned G = gridDim.x;
  unsigned sum, cnt, mine, sp = 0u;
  for (;;) {
    sum = 0u; cnt = 0u; mine = 0u;
#pragma unroll
    for (unsigned j = 0; j < 16; ++j) { const unsigned c = xb_ld(&bar[XB_XCNT(j)]); sum += c; cnt += (c > 0u) ? 1u : 0u; mine = (j == x) ? c : mine; }
    if (sum == G) break;
    __builtin_amdgcn_s_sleep(1);
    if ((++sp & 255u) == 0u) { if (xb_ld(&bar[XB_TMO])) break; if (sp > XB_SPIN_CAP) { atomicAdd(&bar[XB_TMO], 1u); break; } }
  }
  nloc = mine > 0u ? mine : 1u; nx = cnt > 0u ? cnt : 1u;
}
DEV void xcd_barrier(const XcdBarrier& b) {
  asm volatile("s_waitcnt vmcnt(0)" ::: "memory");
  __syncthreads();
  if (__builtin_amdgcn_workitem_id_x() == 0) {
    unsigned* bar = b.bar;
    __builtin_amdgcn_s_waitcnt(0);
    unsigned nloc = b.st[0], nx = b.st[1];
    if (nloc == 0u) { xcd_barrier_complete(bar, b.x, nloc, nx); b.st[0] = nloc; b.st[1] = nx; }
    const unsigned old = xb_add(&bar[XB_XSUB(b.x)], 1u);
    const unsigned gen = old / nloc;
    if (old + 1u == (gen + 1u) * nloc) {
      __builtin_amdgcn_fence(__ATOMIC_RELEASE, "agent");
      asm volatile("s_waitcnt vmcnt(0)" ::: "memory");
      const unsigned og = xb_add(&bar[XB_TOP], 1u);
      const unsigned tg = og / nx;
      if (og + 1u == (tg + 1u) * nx) xb_add(&bar[XB_TOPGEN], 1u);
      else XB_SPIN(xb_ld(&bar[XB_TOPGEN]) == tg, bar);
      __builtin_amdgcn_fence(__ATOMIC_ACQUIRE, "agent");
      xb_add(&bar[XB_XGEN(b.x)], 1u);
      asm volatile("s_waitcnt vmcnt(0)" ::: "memory");
    } else {
      XB_SPIN(xb_ld(&bar[XB_XGEN(b.x)]) == gen, bar);
      __builtin_amdgcn_fence(__ATOMIC_ACQUIRE, "agent");
      asm volatile("s_waitcnt vmcnt(0)" ::: "memory");
    }
  }
  __syncthreads();
}

#if COOP
#define GRID_SYNC() xcd_barrier(xb)
#else
#define GRID_SYNC()
#endif

template <int BN>
DEV void gemm_core_reg(const bf16_t* __restrict__ A, int lda, const bf16_t* __restrict__ B, int ldb, int K, f32x16 (&acc)[2][BN / 64], char* lds) {
  constexpr int NB = BN / 64, NBL = BN / 32;
  constexpr int A_BYTES = 128 * 128, ST = A_BYTES + BN * 128;
  const int tid = TIDX(), lane = tid & 63, wid = tid >> 6, wr = wid >> 1, wc = wid & 1;
  const int lrow = tid >> 3, lch = tid & 7;
  u32x4 ra[2][4], rb[2][NBL];
  const bf16_t* ap = A + (size_t)lrow * lda + lch * 8;
  const bf16_t* bp = B + (size_t)lrow * ldb + lch * 8;
  const int nk = K >> 6;
#define GC_LOAD(set, k0) do { _Pragma("unroll") for (int i = 0; i < 4; ++i) ra[set][i] = *(const u32x4*)(ap + (size_t)(32 * i) * lda + (k0)); \
    _Pragma("unroll") for (int i = 0; i < NBL; ++i) rb[set][i] = *(const u32x4*)(bp + (size_t)(32 * i) * ldb + (k0)); } while (0)
#define GC_STORE(stage, set) do { char* st_ = lds + (stage) * ST; _Pragma("unroll") for (int i = 0; i < 4; ++i) *(u32x4*)(st_ + swz(lrow + 32 * i, lch)) = ra[set][i]; \
    _Pragma("unroll") for (int i = 0; i < NBL; ++i) *(u32x4*)(st_ + A_BYTES + swz(lrow + 32 * i, lch)) = rb[set][i]; } while (0)
#define GC_COMPUTE(stage) do { const char* cur = lds + (stage) * ST; _Pragma("unroll") for (int ks = 0; ks < 4; ++ks) { const int ch = ks * 2 + (lane >> 5); bf16x8 af[2], bfr[NB]; \
    _Pragma("unroll") for (int mi = 0; mi < 2; ++mi) af[mi] = *(const bf16x8*)(cur + swz(wr * 64 + mi * 32 + (lane & 31), ch)); \
    _Pragma("unroll") for (int ni = 0; ni < NB; ++ni) bfr[ni] = *(const bf16x8*)(cur + A_BYTES + swz(wc * (BN / 2) + ni * 32 + (lane & 31), ch)); \
    _Pragma("unroll") for (int mi = 0; mi < 2; ++mi) _Pragma("unroll") for (int ni = 0; ni < NB; ++ni) acc[mi][ni] = __builtin_amdgcn_mfma_f32_32x32x16_bf16(bfr[ni], af[mi], acc[mi][ni], 0, 0, 0); } } while (0)
  GC_LOAD(0, 0);
  GC_STORE(0, 0);
  if (nk > 1) GC_LOAD(1, 64);
  __syncthreads();
  for (int kt = 0; kt < nk; kt += 2) {
    if (kt + 2 < nk) GC_LOAD(0, (kt + 2) * 64);
    __builtin_amdgcn_sched_barrier(0);
    GC_COMPUTE(0);
    __builtin_amdgcn_sched_barrier(0);
    if (kt + 1 < nk) GC_STORE(1, 1);
    __syncthreads();
    if (kt + 1 >= nk) break;
    if (kt + 3 < nk) GC_LOAD(1, (kt + 3) * 64);
    __builtin_amdgcn_sched_barrier(0);
    GC_COMPUTE(1);
    __builtin_amdgcn_sched_barrier(0);
    if (kt + 2 < nk) GC_STORE(0, 0);
    __syncthreads();
  }
#undef GC_LOAD
#undef GC_STORE
#undef GC_COMPUTE
}
#define LDSAS __attribute__((address_space(3)))
template <int N> DEV void wait_vmcnt() { asm volatile("s_waitcnt vmcnt(%0)" ::"n"(N) : "memory"); }
template <int BN>
DEV void gemm_core(const bf16_t* __restrict__ A, int lda, const bf16_t* __restrict__ B, int ldb, int K, f32x16 (&acc)[2][BN / 64], char* lds) {
  constexpr int NB = BN / 64, NPB = BN / 32;
  constexpr int NP = 4 + NPB;
  constexpr int A_BYTES = 128 * 128, ST = A_BYTES + BN * 128;
  const int tid = TIDX(), lane = tid & 63, wid = __builtin_amdgcn_readfirstlane(tid >> 6), wr = wid >> 1, wc = wid & 1;
  LDSAS char* l3 = (LDSAS char*)lds;
  unsigned offA[4], offB[NPB];
#pragma unroll
  for (int i = 0; i < 4; ++i) { const int row = (wid * 4 + i) * 8 + (lane >> 3); offA[i] = (unsigned)(row * lda + (((lane & 7) ^ ((row >> 1) & 7)) << 3)) * 2u; }
#pragma unroll
  for (int i = 0; i < NPB; ++i) { const int row = (wid * NPB + i) * 8 + (lane >> 3); offB[i] = (unsigned)(row * ldb + (((lane & 7) ^ ((row >> 1) & 7)) << 3)) * 2u; }
  const int nk = K >> 6;
#define GD_ISSUE(stage, kt_) do { const char* ga_ = (const char*)A + (size_t)(kt_) * 128; const char* gb_ = (const char*)B + (size_t)(kt_) * 128; \
    _Pragma("unroll") for (int i = 0; i < 4; ++i) __builtin_amdgcn_global_load_lds((const unsigned*)(ga_ + offA[i]), (LDSAS unsigned*)(l3 + (stage) * ST + (wid * 4 + i) * 1024), 16, 0, 0); \
    _Pragma("unroll") for (int i = 0; i < NPB; ++i) __builtin_amdgcn_global_load_lds((const unsigned*)(gb_ + offB[i]), (LDSAS unsigned*)(l3 + (stage) * ST + A_BYTES + (wid * NPB + i) * 1024), 16, 0, 0); } while (0)
  wait_vmcnt<0>();
  GD_ISSUE(0, 0);
  if (nk > 1) { GD_ISSUE(1, 1); wait_vmcnt<NP>(); } else wait_vmcnt<0>();
  __builtin_amdgcn_s_barrier(); asm volatile("" ::: "memory");
  for (int kt = 0; kt < nk; ++kt) {
    const char* cur = lds + (kt & 1) * ST;
#pragma unroll
    for (int ks = 0; ks < 4; ++ks) {
      const int ch = ks * 2 + (lane >> 5);
      bf16x8 af[2], bfr[NB];
#pragma unroll
      for (int mi = 0; mi < 2; ++mi) af[mi] = *(const bf16x8*)(cur + swz(wr * 64 + mi * 32 + (lane & 31), ch));
#pragma unroll
      for (int ni = 0; ni < NB; ++ni) bfr[ni] = *(const bf16x8*)(cur + A_BYTES + swz(wc * (BN / 2) + ni * 32 + (lane & 31), ch));
#pragma unroll
      for (int mi = 0; mi < 2; ++mi)
#pragma unroll
        for (int ni = 0; ni < NB; ++ni) acc[mi][ni] = __builtin_amdgcn_mfma_f32_32x32x16_bf16(bfr[ni], af[mi], acc[mi][ni], 0, 0, 0);
    }
    asm volatile("s_waitcnt lgkmcnt(0)" ::: "memory");
    __builtin_amdgcn_s_barrier(); asm volatile("" ::: "memory");
    if (kt + 2 < nk) { GD_ISSUE(kt & 1, kt + 2); wait_vmcnt<NP>(); }
    else wait_vmcnt<0>();
    __builtin_amdgcn_s_barrier(); asm volatile("" ::: "memory");
  }
#undef GD_ISSUE
}
template <int NB>
DEV void zero_acc(f32x16 (&acc)[2][NB]) {
#pragma unroll
  for (int a = 0; a < 2; ++a)
#pragma unroll
    for (int b = 0; b < NB; ++b)
#pragma unroll
      for (int i = 0; i < 16; ++i) acc[a][b][i] = 0.f;
}

struct Cv { const float* src; int ld; int K; int Np; int kind; const float* ks; bf16_t* dst; };
DEV int cv_map(int kind, int n) {
  if (kind == 0) return n;
  if (kind == 1) { const int g = n >> 6, r = n & 63; return r < 32 ? g * 32 + r : 2816 + g * 32 + (r - 32); }
  if (kind == 2) {
    if (n < 2064) return n;
    if (n < 2176) return -1;
    if (n < 2880) return 2064 + (n - 2176);
    if (n < 2944) return -1;
    return 2768 + (n - 2944);
  }
  return 5328 + n;
}
DEV void cv_run(const Cv c, char* lds) {
  float* tile = (float*)lds;
  const int tid = TIDX();
  const int nkt = c.K >> 6, ntile = nkt * (c.Np >> 6);
  for (int t = blockIdx.x; t < ntile; t += gridDim.x) {
    const int k0 = (t % nkt) * 64, n0 = (t / nkt) * 64;
    const int nn = tid & 63, src_n = cv_map(c.kind, n0 + nn);
#pragma unroll 4
    for (int i = 0; i < 16; ++i) {
      const int k = i * 4 + (tid >> 6);
      float v = 0.f;
      if (src_n >= 0) { v = c.src[(size_t)(k0 + k) * c.ld + src_n]; if (c.ks) v *= c.ks[k0 + k]; }
      tile[k * 65 + nn] = v;
    }
    __syncthreads();
#pragma unroll 4
    for (int i = 0; i < 16; ++i) {
      const int n = i * 4 + (tid >> 6), k = tid & 63;
      c.dst[(size_t)(n0 + n) * c.K + k0 + k] = f2bf(tile[k * 65 + n]);
    }
    __syncthreads();
  }
}
DEV void conv_ffn(const P& p, int l, int f, char* lds) {
  bf16_t* wt = (bf16_t*)(p.ws + OFF_WT);
  Cv a = {p.ffn_w_in + (size_t)(l * 2 + f) * 1024 * 5632, 5632, 1024, 5632, 1, nullptr, (bf16_t*)((char*)wt + WT_WI)};
  cv_run(a, lds);
  Cv b = {p.ffn_w_out + (size_t)(l * 2 + f) * 2816 * 1024, 1024, 2816, 1024, 0, nullptr, (bf16_t*)((char*)wt + WT_WO)};
  cv_run(b, lds);
}
DEV void conv_mixer(const P& p, int l, char* lds) {
  char* wt = p.ws + OFF_WT;
  const float* win = p.w_in + (size_t)l * 1024 * WIN_LD;
  Cv a = {win, WIN_LD, 1024, NWIN, 2, nullptr, (bf16_t*)(wt + WT_WIN)}; cv_run(a, lds);
  Cv b = {win, WIN_LD, 1024, 3072, 3, nullptr, (bf16_t*)(wt + WT_WG)}; cv_run(b, lds);
  Cv c = {p.mla_w_q_b + (size_t)l * 384 * 768, 768, 384, 768, 0, p.mla_q_norm + l * 384, (bf16_t*)(wt + WT_WQB)}; cv_run(c, lds);
  Cv d = {p.mla_w_kv_b + (size_t)l * 256 * 1024, 1024, 256, 1024, 0, p.mla_kv_norm + l * 256, (bf16_t*)(wt + WT_WKVB)}; cv_run(d, lds);
#pragma unroll 1
  for (int j = 0; j < 3; ++j) {
    Cv e = {p.w_branch + (size_t)(l * 3 + j) * 512 * 1024, 1024, 512, 1024, 0, nullptr, (bf16_t*)(wt + WT_WBR) + (size_t)j * 1024 * 512};
    cv_run(e, lds);
  }
  Cv f = {p.w_out + (size_t)l * 1024 * 1024, 1024, 1024, 1024, 0, nullptr, (bf16_t*)(wt + WT_WOUT)}; cv_run(f, lds);
}

DEV void phase0(const P& p, char* lds) {
  const int tid = TIDX();
  {
    const f32x4* s = (const f32x4*)p.x; f32x4* d = (f32x4*)p.out;
    const size_t n = (size_t)TL * D / 4;
    for (size_t i = (size_t)blockIdx.x * 256 + tid; i < n; i += (size_t)gridDim.x * 256) d[i] = s[i];
    const f32x4* s2 = (const f32x4*)p.ctx; f32x4* d2 = (f32x4*)(p.ws + OFF_HCTX);
    const size_t n2 = 512ull * D / 4;
    for (size_t i = (size_t)blockIdx.x * 256 + tid; i < n2; i += (size_t)gridDim.x * 256) d2[i] = s2[i];
  }
  {
    float* sv = (float*)lds;
    float* modp = (float*)(p.ws + OFF_MODP);
    for (int t = blockIdx.x; t < 2 * 36 * 4; t += gridDim.x) {
      const int ks = t & 3, cb = (t >> 2) % 36, l = t / 144;
      __syncthreads();
      {
        const int k = ks * 256 + tid;
        sv[tid] = siluf_(p.c[k]); sv[256 + tid] = siluf_(p.c[1024 + k]); sv[512 + tid] = siluf_(p.c_ctx[k]);
      }
      __syncthreads();
      const int col = cb * 256 + tid;
      const float* w = p.w_ada + ((size_t)l * 1024 + ks * 256) * 9216 + col;
      float a0 = 0.f, a1 = 0.f, a2 = 0.f;
#pragma unroll 8
      for (int k = 0; k < 256; ++k) { const float wv = w[(size_t)k * 9216]; a0 += sv[k] * wv; a1 += sv[256 + k] * wv; a2 += sv[512 + k] * wv; }
      float* o = modp + ((size_t)(ks * 2 + l) * 3) * 9216 + col;
      o[0] = a0; o[9216] = a1; o[2 * 9216] = a2;
    }
    __syncthreads();
  }
  conv_ffn(p, 0, 0, lds);
}
DEV void phase0b(const P& p) {
  const float* modp = (const float*)(p.ws + OFF_MODP);
  float* mod = (float*)(p.ws + OFF_MOD);
  for (int i = blockIdx.x * 256 + TIDX(); i < 2 * 3 * 9216; i += gridDim.x * 256) {
    const int col = i % 9216, l = i / (3 * 9216);
    float v = p.b_ada[l * 9216 + col];
#pragma unroll
    for (int ks = 0; ks < 4; ++ks) v += modp[(size_t)ks * 2 * 3 * 9216 + i];
    mod[i] = v;
  }
}

DEV void row_phase(const P& p, bool do_post, int l_post, const bf16_t* __restrict__ Y, int gate_idx, float gate_mul, int postw_idx,
                   bool do_pre, int l_pre, int prew_idx, int shift_idx, bf16_t* __restrict__ Aout, int nrows = T) {
  const float* mod = (const float*)(p.ws + OFF_MOD);
  float* hctx = (float*)(p.ws + OFF_HCTX);
  const int lane = TIDX() & 63, wid = TIDX() >> 6;
  for (int r = blockIdx.x * 4 + wid; r < nrows; r += gridDim.x * 4) {
    float* hrow = r < TL ? p.out + (size_t)r * D : hctx + (size_t)(r - TL) * D;
    const int sel = sel_of(r);
    f32x4 h[4];
#pragma unroll
    for (int i = 0; i < 4; ++i) h[i] = *(const f32x4*)(hrow + i * 256 + lane * 4);
    if (do_post) {
      f32x4 y[4]; float ss = 0.f;
#pragma unroll
      for (int i = 0; i < 4; ++i) { const u32x2 yw = *(const u32x2*)(Y + (size_t)r * D + i * 256 + lane * 4); y[i] = (f32x4){bflo(yw[0]), bfhi(yw[0]), bflo(yw[1]), bfhi(yw[1])}; ss += y[i][0] * y[i][0] + y[i][1] * y[i][1] + y[i][2] * y[i][2] + y[i][3] * y[i][3]; }
      ss = wave_sum(ss);
      const float rs = rsqrtf(ss * (1.f / 1024.f) + EPS);
      const float* pw = p.norm_w + (size_t)(l_post * 6 + postw_idx) * 1024;
      const float* gt = mod + ((size_t)(l_post * 3 + sel) * 9 + gate_idx) * 1024;
#pragma unroll
      for (int i = 0; i < 4; ++i) {
        const f32x4 w4 = *(const f32x4*)(pw + i * 256 + lane * 4), g4 = *(const f32x4*)(gt + i * 256 + lane * 4);
        h[i] += gate_mul * g4 * (y[i] * rs * w4);
        *(f32x4*)(hrow + i * 256 + lane * 4) = h[i];
      }
    }
    if (do_pre) {
      float ss = 0.f;
#pragma unroll
      for (int i = 0; i < 4; ++i) ss += h[i][0] * h[i][0] + h[i][1] * h[i][1] + h[i][2] * h[i][2] + h[i][3] * h[i][3];
      ss = wave_sum(ss);
      const float rs = rsqrtf(ss * (1.f / 1024.f) + EPS);
      const float* nw = p.norm_w + (size_t)(l_pre * 6 + prew_idx) * 1024;
      const float* sh = mod + ((size_t)(l_pre * 3 + sel) * 9 + shift_idx) * 1024;
      const float* sc = sh + 1024;
#pragma unroll
      for (int i = 0; i < 4; ++i) {
        const f32x4 w4 = *(const f32x4*)(nw + i * 256 + lane * 4), s4 = *(const f32x4*)(sh + i * 256 + lane * 4), c4 = *(const f32x4*)(sc + i * 256 + lane * 4);
        const f32x4 v = (h[i] * rs * w4) * (1.f + c4) + s4;
        st4bf(Aout + (size_t)r * D + i * 256 + lane * 4, v[0], v[1], v[2], v[3]);
      }
    }
  }
}

DEV void ffn_gemm1(const P& p, char* lds, int MT) {
  const bf16_t* A = (const bf16_t*)(p.ws + OFF_A);
  const bf16_t* W = (const bf16_t*)(p.ws + OFF_WT + WT_WI);
  bf16_t* H = (bf16_t*)(p.ws + OFF_U + U_HFF);
  const int lane = TIDX() & 63, wid = TIDX() >> 6, wr = wid >> 1, wc = wid & 1, h2 = lane >> 5;
  constexpr int NT = 5632 / 128;
  for (int t = vblock(); t < MT * NT; t += gridDim.x) {
    int mt, nt; tile_map(t, MT, NT, mt, nt);
    f32x16 acc[2][2]; zero_acc<2>(acc);
    gemm_core<128>(A + (size_t)mt * 128 * 1024, 1024, W + (size_t)nt * 128 * 1024, 1024, 1024, acc, lds);
#pragma unroll
    for (int mi = 0; mi < 2; ++mi) {
      const int row = mt * 128 + wr * 64 + mi * 32 + (lane & 31);
      bf16_t* dst = H + (size_t)row * DFF + (nt * 2 + wc) * 32 + 4 * h2;
#pragma unroll
      for (int q = 0; q < 4; ++q) {
        float v[4];
#pragma unroll
        for (int j = 0; j < 4; ++j) v[j] = siluf_(acc[mi][0][q * 4 + j]) * acc[mi][1][q * 4 + j];
        st4bf(dst + 8 * q, v[0], v[1], v[2], v[3]);
      }
    }
  }
}
DEV void gemm_f32out(const bf16_t* A, int K, const bf16_t* W, bf16_t* Y, char* lds, int MT) {
  const int lane = TIDX() & 63, wid = TIDX() >> 6, wr = wid >> 1, wc = wid & 1, h2 = lane >> 5;
  constexpr int NT = 1024 / 128;
  for (int t = vblock(); t < MT * NT; t += gridDim.x) {
    int mt, nt; tile_map(t, MT, NT, mt, nt);
    f32x16 acc[2][2]; zero_acc<2>(acc);
    gemm_core<128>(A + (size_t)mt * 128 * K, K, W + (size_t)nt * 128 * K, K, K, acc, lds);
#pragma unroll
    for (int mi = 0; mi < 2; ++mi) {
      const int row = mt * 128 + wr * 64 + mi * 32 + (lane & 31);
#pragma unroll
      for (int ni = 0; ni < 2; ++ni) {
        bf16_t* dst = Y + (size_t)row * D + nt * 128 + wc * 64 + ni * 32 + 4 * h2;
#pragma unroll
        for (int q = 0; q < 4; ++q) st4bf(dst + 8 * q, acc[mi][ni][q * 4], acc[mi][ni][q * 4 + 1], acc[mi][ni][q * 4 + 2], acc[mi][ni][q * 4 + 3]);
      }
    }
  }
}

DEV void rope32(f32x16& v, int a, int r, int h2) {
  if (r >= TL) return;
  const int n = r & 8191;
  const float pos = (float)(a == 0 ? (n >> 6) : (n & 63));
#pragma unroll
  for (int reg = 0; reg < 8; ++reg) {
    const int f = (reg & 3) + 8 * (reg >> 2) + 4 * h2;
    const float inv = __builtin_amdgcn_exp2f(-(float)f * (13.287712379549449f / 16.f));
    const float ang = pos * inv;
    const float c = __cosf(ang), s = __sinf(ang);
    const float x1 = v[reg], x2 = v[reg + 8];
    v[reg] = x1 * c - x2 * s;
    v[reg + 8] = x2 * c + x1 * s;
  }
}

DEV void win_gemm(const P& p, int l, char* lds) {
  const bf16_t* A = (const bf16_t*)(p.ws + OFF_A);
  const bf16_t* W = (const bf16_t*)(p.ws + OFF_WT + WT_WIN);
  char* U = p.ws + OFF_U;
  bf16_t *GQR = (bf16_t*)(U + U_GQR), *GG = (bf16_t*)(U + U_GG), *MQA = (bf16_t*)(U + U_MQA), *MKVA = (bf16_t*)(U + U_MKVA), *MKR = (bf16_t*)(U + U_MKR),
         *HQ = (bf16_t*)(U + U_HQ), *HK = (bf16_t*)(U + U_HK), *HI = (bf16_t*)(U + U_HI), *HG = (bf16_t*)(U + U_HG);
  float* GAB = (float*)(U + U_GAB);
  const int lane = TIDX() & 63, wid = TIDX() >> 6, wr = wid >> 1, wc = wid & 1, h2 = lane >> 5;
  constexpr int MT = T / 128, NT = NWIN / 128;
  for (int t = vblock(); t < MT * NT; t += gridDim.x) {
    int mt, nt; tile_map(t, MT, NT, mt, nt);
    f32x16 acc[2][2]; zero_acc<2>(acc);
    gemm_core<128>(A + (size_t)mt * 128 * 1024, 1024, W + (size_t)nt * 128 * 1024, 1024, 1024, acc, lds);
#pragma unroll
    for (int ni = 0; ni < 2; ++ni) {
      const int nb = nt * 128 + wc * 64 + ni * 32;
#pragma unroll
      for (int mi = 0; mi < 2; ++mi) {
        const int row = mt * 128 + wr * 64 + mi * 32 + (lane & 31);
        f32x16 v = acc[mi][ni];
        bf16_t* dst = nullptr;
        if (nb < 1536) dst = GQR + (size_t)row * 1536 + nb;
        else if (nb < 2048) dst = GG + (size_t)row * 512 + (nb - 1536);
        else if (nb == 2048) {
#pragma unroll
          for (int reg = 0; reg < 16; ++reg) {
            const int c = (reg & 3) + 8 * (reg >> 2) + 4 * h2;
            if (c < 8) {
              const float al = p.gdn_a_log[l * 8 + c], dtb = p.gdn_dt_bias[l * 8 + c];
              const float xx = v[reg] + dtb;
              const float sp = xx > 20.f ? xx : log1pf(__expf(xx));
              GAB[(size_t)row * 16 + c] = -__expf(al) * sp;
            } else if (c < 16) {
              GAB[(size_t)row * 16 + c] = sigmoidf_(v[reg]);
            }
          }
        }
        else if (nb < 2176) {}
        else if (nb < 2560) dst = MQA + (size_t)row * 384 + (nb - 2176);
        else if (nb < 2816) dst = MKVA + (size_t)row * 256 + (nb - 2560);
        else if (nb < 2880) { rope32(v, (nb - 2816) >> 5, row, h2); dst = MKR + (size_t)row * 64 + (nb - 2816); }
        else if (nb < 2944) {}
        else if (nb < 3456) { v = v * 0.08838834764831845f; dst = HQ + (size_t)row * 512 + (nb - 2944); }
        else if (nb < 4480) {
          const int cb = nb - 3456;
#pragma unroll
          for (int reg = 0; reg < 16; ++reg) {
            const int c = cb + (reg & 3) + 8 * (reg >> 2) + 4 * h2;
            float lb = 0.f;
            if (l == 1) lb = sigmoidf_(p.hg_lb[1024 + c] - p.hg_lb[c]);
            v[reg] = (1.f - lb) * sigmoidf_(-v[reg]);
          }
          dst = HK + (size_t)row * 1024 + cb;
        }
        else if (nb < 4992) dst = HI + (size_t)row * 512 + (nb - 4480);
        else dst = HG + (size_t)row * 512 + (nb - 4992);
        if (dst) {
          dst += 4 * h2;
#pragma unroll
          for (int q = 0; q < 4; ++q) st4bf(dst + 8 * q, v[q * 4], v[q * 4 + 1], v[q * 4 + 2], v[q * 4 + 3]);
        }
      }
    }
  }
}

DEV void gdn_prep_rows(const P& p, int l) {
  char* U = p.ws + OFF_U;
  const bf16_t* GQR = (const bf16_t*)(U + U_GQR);
  bf16_t* GQ2 = (bf16_t*)(U + U_GQ2);
  const float* cw = p.gdn_conv + (size_t)l * 3 * 1536;
  const int lane = TIDX() & 63, wid = TIDX() >> 6;
  for (int r = blockIdx.x * 4 + wid; r < T; r += gridDim.x * 4) {
    bool hp, hn;
    if (r < TL) { const int n = r & 8191; hp = n > 0; hn = n < 8191; } else { const int tt = (r - TL) & 255; hp = tt > 0; hn = tt < 255; }
#pragma unroll
    for (int j = 0; j < 3; ++j) {
      const int c0 = j * 512 + lane * 8;
      const u32x4 z = {0u, 0u, 0u, 0u};
      const u32x4 xc = *(const u32x4*)(GQR + (size_t)r * 1536 + c0);
      const u32x4 xp = hp ? *(const u32x4*)(GQR + (size_t)(r - 1) * 1536 + c0) : z;
      const u32x4 xn = hn ? *(const u32x4*)(GQR + (size_t)(r + 1) * 1536 + c0) : z;
      float val[8]; float ss = 0.f;
#pragma unroll
      for (int i = 0; i < 8; ++i) {
        const unsigned wp = xp[i >> 1], wcur = xc[i >> 1], wn = xn[i >> 1];
        const float fp = (i & 1) ? bfhi(wp) : bflo(wp), fc = (i & 1) ? bfhi(wcur) : bflo(wcur), fn = (i & 1) ? bfhi(wn) : bflo(wn);
        const float s = fp * cw[c0 + i] + fc * cw[1536 + c0 + i] + fn * cw[3072 + c0 + i];
        val[i] = siluf_(s); ss += val[i] * val[i];
      }
      if (j < 2) {
        ss = sum16(ss);
        float sc = rsqrtf(ss + EPS);
        if (j == 0) sc *= 0.08838834764831845f;
#pragma unroll
        for (int i = 0; i < 8; ++i) val[i] *= sc;
      }
      u32x4 o = {pk2(val[0], val[1]), pk2(val[2], val[3]), pk2(val[4], val[5]), pk2(val[6], val[7])};
      *(u32x4*)(GQ2 + (size_t)r * 1536 + c0) = o;
    }
  }
}
DEV void row_scales(const bf16_t* A, int K, float* rs) {
  const int tid = TIDX(), row = tid >> 1, half = tid & 1;
  const bf16_t* a = A + (size_t)row * K + half * (K / 2);
  float ss = 0.f;
  for (int k = 0; k < K / 2; k += 8) {
    const u32x4 w = *(const u32x4*)(a + k);
#pragma unroll
    for (int i = 0; i < 4; ++i) { const float lo = bflo(w[i]), hi = bfhi(w[i]); ss += lo * lo + hi * hi; }
  }
  ss += __shfl_xor(ss, 1);
  if (half == 0) rs[row] = rsqrtf(ss / (float)K + EPS);
}
DEV void mla_prep_gemms(const P& p, char* lds) {
  char* U = p.ws + OFF_U;
  const bf16_t *MQA = (const bf16_t*)(U + U_MQA), *MKVA = (const bf16_t*)(U + U_MKVA);
  const bf16_t *WQ = (const bf16_t*)(p.ws + OFF_WT + WT_WQB), *WKV = (const bf16_t*)(p.ws + OFF_WT + WT_WKVB);
  bf16_t *MQ = (bf16_t*)(U + U_MQ), *MKN = (bf16_t*)(U + U_MKN), *MVT = (bf16_t*)(U + U_MVT);
  const int lane = TIDX() & 63, wid = TIDX() >> 6, wr = wid >> 1, wc = wid & 1, h2 = lane >> 5;
  constexpr int MT = T / 128;
  constexpr float QSCALE = 0.07216878364870322f * 1.4426950408889634f;
  for (int t = vblock(); t < MT * 14; t += gridDim.x) {
    int mt, nt; tile_map(t, MT, 14, mt, nt);
    const bool isq = nt < 6;
    const bf16_t* Ab = isq ? MQA + (size_t)mt * 128 * 384 : MKVA + (size_t)mt * 128 * 256;
    const int K = isq ? 384 : 256;
    float* rsl = (float*)lds;
    __syncthreads();
    row_scales(Ab, K, rsl);
    __syncthreads();
    float rsv[2];
#pragma unroll
    for (int mi = 0; mi < 2; ++mi) rsv[mi] = rsl[wr * 64 + mi * 32 + (lane & 31)];
    __syncthreads();
    f32x16 acc[2][2]; zero_acc<2>(acc);
    if (isq) gemm_core<128>(Ab, 384, WQ + (size_t)nt * 128 * 384, 384, 384, acc, lds);
    else gemm_core<128>(Ab, 256, WKV + (size_t)(nt - 6) * 128 * 256, 256, 256, acc, lds);
#pragma unroll
    for (int mi = 0; mi < 2; ++mi) {
      const int row = mt * 128 + wr * 64 + mi * 32 + (lane & 31);
#pragma unroll
      for (int ni = 0; ni < 2; ++ni) {
        f32x16 v = acc[mi][ni] * rsv[mi];
        if (isq) {
          const int nb = nt * 128 + wc * 64 + ni * 32, jb = nb % 192;
          if (jb >= 128) rope32(v, (jb - 128) >> 5, row, h2);
          v = v * QSCALE;
          bf16_t* dst = MQ + (size_t)row * 768 + nb + 4 * h2;
#pragma unroll
          for (int q = 0; q < 4; ++q) st4bf(dst + 8 * q, v[q * 4], v[q * 4 + 1], v[q * 4 + 2], v[q * 4 + 3]);
        } else {
          const int nb = (nt - 6) * 128 + wc * 64 + ni * 32, head = nb >> 8, jb = nb & 255;
          if (jb < 128) {
            bf16_t* dst = MKN + (size_t)row * 512 + head * 128 + jb + 4 * h2;
#pragma unroll
            for (int q = 0; q < 4; ++q) st4bf(dst + 8 * q, v[q * 4], v[q * 4 + 1], v[q * 4 + 2], v[q * 4 + 3]);
          } else {
            const int b = batch_of(row), kx = kx_of(row);
            bf16_t* dst = MVT + ((size_t)(b * 4 + head) * 128 + (jb - 128) + 4 * h2) * KSP + kx;
#pragma unroll
            for (int reg = 0; reg < 16; ++reg) dst[(size_t)((reg & 3) + 8 * (reg >> 2)) * KSP] = f2bf(v[reg]);
          }
        }
      }
    }
  }
}

template <int BR>
DEV void scan_task(const P& p, int b, int h, int dir, int cgp, char* lds) {
  char* U = p.ws + OFF_U;
  const int tid = TIDX(), lane = tid & 63, w = tid >> 6, kg = lane & 15, ci = lane >> 4;
  const bf16_t *Qs, *Ks, *Vs; int ldq, ldk, ldv;
  if (BR == 0) { const bf16_t* g = (const bf16_t*)(U + U_GQ2); Qs = g + h * 128; Ks = g + 512 + h * 128; Vs = g + 1024 + h * 128 + cgp * 16; ldq = ldk = ldv = 1536; }
  else { Qs = (const bf16_t*)(U + U_HQ) + h * 128; ldq = 512; Ks = (const bf16_t*)(U + U_HK) + dir * 512 + h * 128; ldk = 1024; Vs = (const bf16_t*)(U + U_HI) + h * 128 + cgp * 16; ldv = 512; }
  const float* AB = (const float*)(U + U_GAB);
  bf16_t* O = (bf16_t*)(U + (BR == 0 ? (dir ? U_OGB : U_OGF) : (dir ? U_OHB : U_OHF))) + h * 128 + cgp * 16 + w * 4 + ci;
  constexpr int BUF = 16384 + 1024 + 128 + 128;
  const int sg = 1 - 2 * dir;
  auto rowbase = [&](int s0) -> int {
    const int rb = s0 < 256 ? TL + b * 256 + (dir ? 255 - s0 : s0) : b * 8192 + (dir ? 8191 - (s0 - 256) : (s0 - 256));
    return __builtin_amdgcn_readfirstlane(rb);
  };
  f32x2 S2[4];
#pragma unroll
  for (int i = 0; i < 4; ++i) S2[i] = (f32x2){0.f, 0.f};
  u32x4 g0, g1; bf16_t gv; float gs = 0.f;
  const int st0 = tid >> 5, cc0 = tid & 31;
  auto gload = [&](int bt) {
    const int rb = rowbase(bt * 16);
    const int r0 = rb + sg * st0, r1 = rb + sg * (st0 + 8);
    g0 = cc0 < 16 ? *(const u32x4*)(Ks + (size_t)r0 * ldk + cc0 * 8) : *(const u32x4*)(Qs + (size_t)r0 * ldq + (cc0 - 16) * 8);
    g1 = cc0 < 16 ? *(const u32x4*)(Ks + (size_t)r1 * ldk + cc0 * 8) : *(const u32x4*)(Qs + (size_t)r1 * ldq + (cc0 - 16) * 8);
    gv = Vs[(size_t)(rb + sg * (tid >> 4)) * ldv + (tid & 15)];
    if (BR == 0 && tid < 32) {
      const int rr = rb + sg * (tid & 15);
      gs = AB[(size_t)rr * 16 + (tid < 16 ? 0 : 8) + dir * 4 + h];
    }
  };
  auto lwrite = [&](char* buf) {
    float* kq = (float*)buf;
    f32x4 a = {bflo(g0[0]), bfhi(g0[0]), bflo(g0[1]), bfhi(g0[1])}, bq = {bflo(g0[2]), bfhi(g0[2]), bflo(g0[3]), bfhi(g0[3])};
    *(f32x4*)(kq + st0 * 256 + cc0 * 8) = a; *(f32x4*)(kq + st0 * 256 + cc0 * 8 + 4) = bq;
    f32x4 c = {bflo(g1[0]), bfhi(g1[0]), bflo(g1[1]), bfhi(g1[1])}, d = {bflo(g1[2]), bfhi(g1[2]), bflo(g1[3]), bfhi(g1[3])};
    *(f32x4*)(kq + (st0 + 8) * 256 + cc0 * 8) = c; *(f32x4*)(kq + (st0 + 8) * 256 + cc0 * 8 + 4) = d;
    ((float*)(buf + 16384))[tid] = bf2f(gv);
    if (BR == 0 && tid < 32) ((float*)(buf + 16384 + 1024))[(tid & 15) * 2 + (tid >> 4)] = tid < 16 ? __expf(gs) : gs;
  };
  auto gram = [&](char* buf) {
    const float* kq = (const float*)buf;
    const int di = tid >> 3, sub = tid & 7, pp = di >> 2, wh = di & 3;
    const float* xv = kq + (2 * pp + (wh == 1 ? 0 : 1)) * 256 + (wh == 0 ? 0 : 128) + sub * 16;
    const float* yv = kq + (2 * pp + (wh == 3 ? 1 : 0)) * 256 + sub * 16;
    float acc = 0.f;
#pragma unroll
    for (int i = 0; i < 4; ++i) { const f32x4 x = *(const f32x4*)(xv + 4 * i), y = *(const f32x4*)(yv + 4 * i); acc += (x[0] * y[0] + x[1] * y[1]) + (x[2] * y[2] + x[3] * y[3]); }
    acc += __int_as_float(__builtin_amdgcn_update_dpp(0, __float_as_int(acc), 0xB1, 0xf, 0xf, true));
    acc += __int_as_float(__builtin_amdgcn_update_dpp(0, __float_as_int(acc), 0x4E, 0xf, 0xf, true));
    acc += __int_as_float(__builtin_amdgcn_update_dpp(0, __float_as_int(acc), 0x141, 0xf, 0xf, true));
    if (sub == 0) ((float*)(buf + 16384 + 1024 + 128))[di] = acc;
  };
  constexpr int NBT = KSP / 16;
  __syncthreads();
  gload(0); lwrite(lds);
  gload(1);
  __syncthreads();
  if (BR == 0) gram(lds);
  lwrite(lds + BUF);
  gload(2);
  __syncthreads();
  int ic = 0;
  for (int bt = 0; bt < NBT; ++bt) {
    char* cur = lds + ic * BUF;
    const int i1 = ic == 2 ? 0 : ic + 1, i2 = i1 == 2 ? 0 : i1 + 1;
    if (bt + 2 < NBT) lwrite(lds + i2 * BUF);
    if (bt + 3 < NBT) gload(bt + 3);
    const float* kq = (const float*)cur;
    const float* vv = (const float*)(cur + 16384);
    const float* ab = (const float*)(cur + 16384 + 1024);
    const float* gm = (const float*)(cur + 16384 + 1024 + 128);
    float osel = 0.f;
    if (BR == 0) {
      f32x4 nk00 = *(const f32x4*)(kq + kg * 4), nk01 = *(const f32x4*)(kq + 64 + kg * 4), nq00 = *(const f32x4*)(kq + 128 + kg * 4), nq01 = *(const f32x4*)(kq + 192 + kg * 4);
      f32x4 nk10 = *(const f32x4*)(kq + 256 + kg * 4), nk11 = *(const f32x4*)(kq + 320 + kg * 4), nq10 = *(const f32x4*)(kq + 384 + kg * 4), nq11 = *(const f32x4*)(kq + 448 + kg * 4);
      float nv0 = vv[w * 4 + ci], nv1 = vv[16 + w * 4 + ci];
      f32x4 nabv = *(const f32x4*)(ab), ngr = *(const f32x4*)(gm);
#pragma unroll
      for (int pp = 0; pp < 8; ++pp) {
        const f32x4 k00 = nk00, k01 = nk01, q00 = nq00, q01 = nq01, k10 = nk10, k11 = nk11, q10 = nq10, q11 = nq11;
        const float v0 = nv0, v1 = nv1;
        const f32x4 abv = nabv;
        const f32x4 gr = ngr;
        if (pp + 1 < 8) {
          const float* kq0 = kq + (2 * pp + 2) * 256; const float* kq1 = kq0 + 256;
          nk00 = *(const f32x4*)(kq0 + kg * 4); nk01 = *(const f32x4*)(kq0 + 64 + kg * 4); nq00 = *(const f32x4*)(kq0 + 128 + kg * 4); nq01 = *(const f32x4*)(kq0 + 192 + kg * 4);
          nk10 = *(const f32x4*)(kq1 + kg * 4); nk11 = *(const f32x4*)(kq1 + 64 + kg * 4); nq10 = *(const f32x4*)(kq1 + 128 + kg * 4); nq11 = *(const f32x4*)(kq1 + 192 + kg * 4);
          nv0 = vv[(2 * pp + 2) * 16 + w * 4 + ci]; nv1 = vv[(2 * pp + 3) * 16 + w * 4 + ci];
          nabv = *(const f32x4*)(ab + (pp + 1) * 4); ngr = *(const f32x4*)(gm + (pp + 1) * 4);
        }
        __builtin_amdgcn_sched_barrier(0);
        const f32x2 k0a = {k00[0], k00[1]}, k0b = {k00[2], k00[3]}, k0c = {k01[0], k01[1]}, k0d = {k01[2], k01[3]};
        const f32x2 k1a = {k10[0], k10[1]}, k1b = {k10[2], k10[3]}, k1c = {k11[0], k11[1]}, k1d = {k11[2], k11[3]};
        const f32x2 q0a = {q00[0], q00[1]}, q0b = {q00[2], q00[3]}, q0c = {q01[0], q01[1]}, q0d = {q01[2], q01[3]};
        const f32x2 q1a = {q10[0], q10[1]}, q1b = {q10[2], q10[3]}, q1c = {q11[0], q11[1]}, q1d = {q11[2], q11[3]};
        const f32x2 t0 = (k0a * S2[0] + k0b * S2[1]) + (k0c * S2[2] + k0d * S2[3]);
        const f32x2 t1 = (k1a * S2[0] + k1b * S2[1]) + (k1c * S2[2] + k1d * S2[3]);
        const f32x2 t2 = (q0a * S2[0] + q0b * S2[1]) + (q0c * S2[2] + q0d * S2[3]);
        const f32x2 t3 = (q1a * S2[0] + q1b * S2[1]) + (q1c * S2[2] + q1d * S2[3]);
        const float kS0 = rowsum16(t0[0] + t0[1]), kS1 = rowsum16(t1[0] + t1[1]), qS0 = rowsum16(t2[0] + t2[1]), qS1 = rowsum16(t3[0] + t3[1]);
        const float a0 = abv[0], b0 = abv[1], a1 = abv[2], b1 = abv[3];
        const float c0 = b0 * (v0 - a0 * kS0);
        const float d1 = a0 * kS1 + gr[0] * c0;
        const float c1 = b1 * (v1 - a1 * d1);
        const float o0 = a0 * qS0 + gr[1] * c0;
        const float o1 = a1 * (a0 * qS1 + gr[2] * c0) + gr[3] * c1;
        const float aa = a1 * a0, e0 = a1 * c0;
        const f32x2 aav = {aa, aa}, e0v = {e0, e0}, c1v = {c1, c1};
        S2[0] = (aav * S2[0] + k0a * e0v) + k1a * c1v; S2[1] = (aav * S2[1] + k0b * e0v) + k1b * c1v;
        S2[2] = (aav * S2[2] + k0c * e0v) + k1c * c1v; S2[3] = (aav * S2[3] + k0d * e0v) + k1d * c1v;
        osel = (kg == 2 * pp) ? o0 : osel;
        osel = (kg == 2 * pp + 1) ? o1 : osel;
      }
    } else {
      f32x4 nk0 = *(const f32x4*)(kq + kg * 4), nk1 = *(const f32x4*)(kq + 64 + kg * 4), nq0 = *(const f32x4*)(kq + 128 + kg * 4), nq1 = *(const f32x4*)(kq + 192 + kg * 4);
      float nv = vv[w * 4 + ci];
#pragma unroll
      for (int st = 0; st < 16; ++st) {
        const f32x4 k0 = nk0, k1 = nk1, q0 = nq0, q1 = nq1;
        const float v = nv;
        if (st + 1 < 16) {
          nk0 = *(const f32x4*)(kq + (st + 1) * 256 + kg * 4); nk1 = *(const f32x4*)(kq + (st + 1) * 256 + 64 + kg * 4);
          nq0 = *(const f32x4*)(kq + (st + 1) * 256 + 128 + kg * 4); nq1 = *(const f32x4*)(kq + (st + 1) * 256 + 192 + kg * 4);
          nv = vv[(st + 1) * 16 + w * 4 + ci];
        }
        __builtin_amdgcn_sched_barrier(0);
        const f32x2 ka = {k0[0], k0[1]}, kb = {k0[2], k0[3]}, kc = {k1[0], k1[1]}, kd = {k1[2], k1[3]};
        const f32x2 qa = {q0[0], q0[1]}, qb = {q0[2], q0[3]}, qc = {q1[0], q1[1]}, qd = {q1[2], q1[3]};
        const f32x2 v2 = {v, v};
        S2[0] = S2[0] + ka * (v2 - S2[0]); S2[1] = S2[1] + kb * (v2 - S2[1]); S2[2] = S2[2] + kc * (v2 - S2[2]); S2[3] = S2[3] + kd * (v2 - S2[3]);
        const f32x2 u = (qa * S2[0] + qb * S2[1]) + (qc * S2[2] + qd * S2[3]);
        const float o = rowsum16(u[0] + u[1]);
        osel = (kg == st) ? o : osel;
      }
    }
    O[(size_t)(rowbase(bt * 16) + sg * kg) * 512] = f2bf(osel);
    if (BR == 0 && bt + 1 < NBT) gram(lds + i1 * BUF);
    __syncthreads();
    ic = i1;
  }
}

DEV void attn_task(const P& p, int b, int h, int r0, int kx_begin, int nkt, char* lds) {
  char* U = p.ws + OFF_U;
  const bf16_t *MQ = (const bf16_t*)(U + U_MQ), *MKN = (const bf16_t*)(U + U_MKN), *MKR = (const bf16_t*)(U + U_MKR), *MVT = (const bf16_t*)(U + U_MVT);
  bf16_t* YB = (bf16_t*)(p.ws + OFF_A);
  const int tid = TIDX(), lane = tid & 63, w = tid >> 6, h2 = lane >> 5, l31 = lane & 31;
  const int qrow = r0 + w * 32 + l31;
  bf16x8 qf[12];
#pragma unroll
  for (int s = 0; s < 12; ++s) qf[s] = *(const bf16x8*)(MQ + (size_t)qrow * 768 + h * 192 + s * 16 + h2 * 8);
  f32x16 oacc[4];
#pragma unroll
  for (int d = 0; d < 4; ++d)
#pragma unroll
    for (int i = 0; i < 16; ++i) oacc[d][i] = 0.f;
  float m = -1e30f, lsum = 0.f;
  char* Kl = lds;
  char* Vl = lds + 64 * 384;
  const int pi = (l31 & 19) | ((l31 & 4) << 1) | ((l31 & 8) >> 1);
  const bf16_t* vbase = MVT + (size_t)(b * 4 + h) * 128 * KSP;
  for (int kt = 0; kt < nkt; ++kt) {
    const int kx0 = kx_begin + kt * 64;
    const int rb = kx0 < 8192 ? b * 8192 + kx0 : TL + b * 256 + (kx0 - 8192);
    u32x4 kr[6], vr[4];
#pragma unroll
    for (int i = 0; i < 6; ++i) {
      const int c = tid + 256 * i, row = c / 24, ch = c % 24;
      kr[i] = ch < 16 ? *(const u32x4*)(MKN + (size_t)(rb + row) * 512 + h * 128 + ch * 8) : *(const u32x4*)(MKR + (size_t)(rb + row) * 64 + (ch - 16) * 8);
    }
#pragma unroll
    for (int i = 0; i < 4; ++i) {
      const int c = tid + 256 * i, row = c >> 3, ch = c & 7;
      vr[i] = *(const u32x4*)(vbase + (size_t)row * KSP + kx0 + ch * 8);
    }
    __syncthreads();
#pragma unroll
    for (int i = 0; i < 6; ++i) {
      const int c = tid + 256 * i, row = c / 24, ch = c % 24;
      *(u32x4*)(Kl + row * 384 + (((ch & 24) | ((ch ^ (row >> 1)) & 7)) << 4)) = kr[i];
    }
#pragma unroll
    for (int i = 0; i < 4; ++i) {
      const int c = tid + 256 * i, row = c >> 3, ch = c & 7;
      *(u32x4*)(Vl + swz(row, ch)) = vr[i];
    }
    __syncthreads();
    f32x16 sacc[2];
#pragma unroll
    for (int i = 0; i < 16; ++i) { sacc[0][i] = 0.f; sacc[1][i] = 0.f; }
#pragma unroll
    for (int s = 0; s < 12; ++s) {
      const int ch = s * 2 + h2;
#pragma unroll
      for (int kb = 0; kb < 2; ++kb) {
        const int row = kb * 32 + pi;
        const bf16x8 kf = *(const bf16x8*)(Kl + row * 384 + (((ch & 24) | ((ch ^ (row >> 1)) & 7)) << 4));
        sacc[kb] = __builtin_amdgcn_mfma_f32_32x32x16_bf16(kf, qf[s], sacc[kb], 0, 0, 0);
      }
      if (s & 1) __builtin_amdgcn_sched_barrier(0);
    }
    float mx = sacc[0][0];
#pragma unroll
    for (int i = 1; i < 16; ++i) mx = fmaxf(mx, sacc[0][i]);
#pragma unroll
    for (int i = 0; i < 16; ++i) mx = fmaxf(mx, sacc[1][i]);
    mx = fmaxf(mx, __shfl_xor(mx, 32));
    const float mn = fmaxf(m, mx);
    const float alpha = __builtin_amdgcn_exp2f(m - mn);
    m = mn;
    float ps = 0.f;
#pragma unroll
    for (int kb = 0; kb < 2; ++kb)
#pragma unroll
      for (int i = 0; i < 16; ++i) { const float e = __builtin_amdgcn_exp2f(sacc[kb][i] - mn); sacc[kb][i] = e; ps += e; }
    lsum = lsum * alpha + ps;
#pragma unroll
    for (int d = 0; d < 4; ++d) oacc[d] = oacc[d] * alpha;
    bf16x8 pf[4];
#pragma unroll
    for (int kb = 0; kb < 2; ++kb)
#pragma unroll
      for (int s2 = 0; s2 < 2; ++s2) {
        u32x4 pw = {pk2(sacc[kb][8 * s2 + 0], sacc[kb][8 * s2 + 1]), pk2(sacc[kb][8 * s2 + 2], sacc[kb][8 * s2 + 3]),
                    pk2(sacc[kb][8 * s2 + 4], sacc[kb][8 * s2 + 5]), pk2(sacc[kb][8 * s2 + 6], sacc[kb][8 * s2 + 7])};
        pf[kb * 2 + s2] = __builtin_bit_cast(bf16x8, pw);
      }
    __builtin_amdgcn_sched_barrier(0);
#pragma unroll
    for (int s = 0; s < 4; ++s) {
#pragma unroll
      for (int d = 0; d < 4; ++d) {
        const bf16x8 vf = *(const bf16x8*)(Vl + swz(d * 32 + l31, s * 2 + h2));
        oacc[d] = __builtin_amdgcn_mfma_f32_32x32x16_bf16(vf, pf[s], oacc[d], 0, 0, 0);
      }
      __builtin_amdgcn_sched_barrier(0);
    }
  }
  lsum += __shfl_xor(lsum, 32);
  const float inv = 1.f / lsum;
  bf16_t* dst = YB + (size_t)qrow * 512 + h * 128 + 4 * h2;
#pragma unroll
  for (int d = 0; d < 4; ++d)
#pragma unroll
    for (int q = 0; q < 4; ++q) st4bf(dst + d * 32 + 8 * q, oacc[d][q * 4] * inv, oacc[d][q * 4 + 1] * inv, oacc[d][q * 4 + 2] * inv, oacc[d][q * 4 + 3] * inv);
  __syncthreads();
}

DEV void mixer_item(const P& p, int it, char* lds) {
  if (it < 256) {
    const int br = it >> 7, rem = it & 127, cgp = rem & 7, dir = (rem >> 3) & 1, h = (rem >> 4) & 3, b = rem >> 6;
    if (br == 0) scan_task<0>(p, b, h, dir, cgp, lds); else scan_task<1>(p, b, h, dir, cgp, lds);
  } else {
    const int a = it - 256;
    if (a < 512) { const int qt = a & 63, h = (a >> 6) & 3, b = a >> 8; attn_task(p, b, h, b * 8192 + qt * 128, 0, 132, lds); }
    else { const int c = a - 512, qt = c & 1, h = (c >> 1) & 3, b = c >> 3; attn_task(p, b, h, TL + b * 256 + qt * 128, 8192, 4, lds); }
  }
}
DEV void mixer_phase(const P& p, int l, char* lds) {
  __shared__ int sh_task;
  unsigned* ctr = (unsigned*)(p.ws + OFF_BAR) + 3600 + l * 64;
  const int G = gridDim.x;
  for (int it = blockIdx.x; it < 256; it += G) mixer_item(p, it, lds);
  for (;;) {
    __syncthreads();
    if (TIDX() == 0) sh_task = (int)atomicAdd(ctr, 1u);
    __syncthreads();
    const int a = sh_task;
    if (a >= 528) break;
    mixer_item(p, 256 + a, lds);
  }
}

DEV void readout_phase(const P& p, int l) {
  char* U = p.ws + OFF_U;
  const bf16_t *OGF = (const bf16_t*)(U + U_OGF), *OGB = (const bf16_t*)(U + U_OGB), *OHF = (const bf16_t*)(U + U_OHF), *OHB = (const bf16_t*)(U + U_OHB);
  const bf16_t *GG = (const bf16_t*)(U + U_GG), *HG = (const bf16_t*)(U + U_HG);
  bf16_t *YA = (bf16_t*)(U + U_YA), *YC = (bf16_t*)(U + U_YC);
  const int lane = TIDX() & 63, wid = TIDX() >> 6;
  for (int r = blockIdx.x * 4 + wid; r < T; r += gridDim.x * 4) {
#pragma unroll
    for (int br = 0; br < 2; ++br) {
      const bf16_t* of = br ? OHF : OGF; const bf16_t* ob = br ? OHB : OGB; const bf16_t* gt = br ? HG : GG;
      const float* nw = (br ? p.hg_norm : p.gdn_norm) + l * 128 + (lane & 15) * 8;
      const size_t off = (size_t)r * 512 + lane * 8;
      const u32x4 a = *(const u32x4*)(of + off), b2 = *(const u32x4*)(ob + off), g = *(const u32x4*)(gt + off);
      float o[8]; float ss = 0.f;
#pragma unroll
      for (int i = 0; i < 4; ++i) { o[2 * i] = bflo(a[i]) + bflo(b2[i]); o[2 * i + 1] = bfhi(a[i]) + bfhi(b2[i]); }
#pragma unroll
      for (int i = 0; i < 8; ++i) ss += o[i] * o[i];
      ss = sum16(ss);
      const float rs = rsqrtf(ss * (1.f / 128.f) + EPS);
      float y[8];
#pragma unroll
      for (int i = 0; i < 8; ++i) { const float gv = (i & 1) ? bfhi(g[i >> 1]) : bflo(g[i >> 1]); y[i] = o[i] * rs * nw[i] * siluf_(gv); }
      u32x4 w = {pk2(y[0], y[1]), pk2(y[2], y[3]), pk2(y[4], y[5]), pk2(y[6], y[7])};
      *(u32x4*)((br ? YC : YA) + off) = w;
    }
  }
}

DEV void merge_gemm(const P& p, char* lds, int MT) {
  char* U = p.ws + OFF_U;
  const bf16_t* ARE = (const bf16_t*)(U + U_ARE);
  const bf16_t* WG = (const bf16_t*)(p.ws + OFF_WT + WT_WG);
  const bf16_t* WBR = (const bf16_t*)(p.ws + OFF_WT + WT_WBR);
  bf16_t* M = (bf16_t*)(U + U_M);
  const int lane = TIDX() & 63, wid = TIDX() >> 6, wr = wid >> 1, wc = wid & 1, h2 = lane >> 5;
  constexpr int NT = 1024 / 128;
  for (int t = vblock(); t < MT * NT; t += gridDim.x) {
    int mt, nt; tile_map(t, MT, NT, mt, nt);
    f32x16 macc[2][2]; zero_acc<2>(macc);
#pragma unroll 1
    for (int j = 0; j < 3; ++j) {
      const bf16_t* Yj = j == 0 ? (const bf16_t*)(U + U_YA) : (j == 1 ? (const bf16_t*)(p.ws + OFF_A) : (const bf16_t*)(U + U_YC));
      f32x16 ag[2][2]; zero_acc<2>(ag);
      gemm_core<128>(ARE + (size_t)mt * 128 * 1024, 1024, WG + ((size_t)j * 1024 + nt * 128) * 1024, 1024, 1024, ag, lds);
#pragma unroll
      for (int mi = 0; mi < 2; ++mi)
#pragma unroll
        for (int ni = 0; ni < 2; ++ni)
#pragma unroll
          for (int i = 0; i < 16; ++i) ag[mi][ni][i] = sigmoidf_(ag[mi][ni][i]);
      f32x16 ab[2][2]; zero_acc<2>(ab);
      gemm_core<128>(Yj + (size_t)mt * 128 * 512, 512, WBR + ((size_t)j * 1024 + nt * 128) * 512, 512, 512, ab, lds);
#pragma unroll
      for (int mi = 0; mi < 2; ++mi)
#pragma unroll
        for (int ni = 0; ni < 2; ++ni)
#pragma unroll
          for (int i = 0; i < 16; ++i) macc[mi][ni][i] += ag[mi][ni][i] * ab[mi][ni][i];
    }
#pragma unroll
    for (int mi = 0; mi < 2; ++mi) {
      const int row = mt * 128 + wr * 64 + mi * 32 + (lane & 31);
#pragma unroll
      for (int ni = 0; ni < 2; ++ni) {
        bf16_t* dst = M + (size_t)row * D + nt * 128 + wc * 64 + ni * 32 + 4 * h2;
#pragma unroll
        for (int q = 0; q < 4; ++q) st4bf(dst + 8 * q, macc[mi][ni][q * 4], macc[mi][ni][q * 4 + 1], macc[mi][ni][q * 4 + 2], macc[mi][ni][q * 4 + 3]);
      }
    }
  }
}

DEV void run_phase(const P& p, int ph, char* lds) {
  char* U = p.ws + OFF_U;
  bf16_t* Abuf = (bf16_t*)(p.ws + OFF_A);
  bf16_t* Y = (bf16_t*)(U + U_Y);
  if (ph == 0) { phase0(p, lds); return; }
  if (ph == 1) { phase0b(p); return; }
  if (ph == 2) { row_phase(p, false, 0, nullptr, 0, 0.f, 0, true, 0, 0, 0, Abuf); return; }
  const int l = (ph - 3) / 13, s = (ph - 3) % 13;
  const int MTall = T / 128, MTpost = (l == 1) ? TL / 128 : T / 128, rows_post = (l == 1) ? TL : T;
  switch (s) {
    case 0: ffn_gemm1(p, lds, MTall); break;
    case 1: gemm_f32out((const bf16_t*)(U + U_HFF), DFF, (const bf16_t*)(p.ws + OFF_WT + WT_WO), Y, lds, MTall); break;
    case 2: row_phase(p, true, l, Y, 2, 0.5f, 1, true, l, 2, 3, Abuf); conv_mixer(p, l, lds); break;
    case 3: win_gemm(p, l, lds); break;
    case 4: gdn_prep_rows(p, l); mla_prep_gemms(p, lds); break;
    case 5: mixer_phase(p, l, lds); break;
    case 6: readout_phase(p, l); row_phase(p, false, 0, nullptr, 0, 0.f, 0, true, l, 2, 3, (bf16_t*)(U + U_ARE)); break;
    case 7: merge_gemm(p, lds, MTpost); break;
    case 8: gemm_f32out((const bf16_t*)(U + U_M), 1024, (const bf16_t*)(p.ws + OFF_WT + WT_WOUT), Y, lds, MTpost); break;
    case 9: row_phase(p, true, l, Y, 5, 1.0f, 3, true, l, 4, 6, Abuf, rows_post); conv_ffn(p, l, 1, lds); break;
    case 10: ffn_gemm1(p, lds, MTpost); break;
    case 11: gemm_f32out((const bf16_t*)(U + U_HFF), DFF, (const bf16_t*)(p.ws + OFF_WT + WT_WO), Y, lds, MTpost); break;
    case 12:
      if (l == 0) { row_phase(p, true, 0, Y, 8, 0.5f, 5, true, 1, 0, 0, Abuf); conv_ffn(p, 1, 0, lds); }
      else row_phase(p, true, 1, Y, 8, 0.5f, 5, false, 0, 0, 0, Abuf, TL);
      break;
    default: break;
  }
}
constexpr int NPHASE = 3 + 2 * 13;

template <int PH>
DEV void run_all(const P& p, char* lds, const XcdBarrier& xb) {
  run_phase(p, PH, lds);
  if constexpr (PROBE_SCAN_ONLY != 0 && PH >= 3 && (PH - 3) % 13 == 5) { GRID_SYNC(); if (PROBE_SCAN_ONLY == 1) { if (blockIdx.x < 256) mixer_item(p, blockIdx.x, lds); } else { for (int a = (int)blockIdx.x - 256; a >= 0 && a < 528; a += gridDim.x - 256) mixer_item(p, 256 + a, lds); } }
  if constexpr (PROBE_DUP_S >= 0 && PH >= 3 && ((PH - 3) % 13 == PROBE_DUP_S || (PH - 3) % 13 == PROBE_DUP_S2)) { GRID_SYNC(); run_phase(p, PH, lds); }
  if constexpr (PH + 1 < NPHASE) { GRID_SYNC(); run_all<PH + 1>(p, lds, xb); }
}
#if COOP
__global__ void __launch_bounds__(256, 2) mega(P p) {
  __shared__ __attribute__((aligned(16))) char lds[65536];
  __shared__ uint4 xb_words;
  if (__builtin_amdgcn_workitem_id_x() == 0) xb_words = make_uint4(0u, 0u, 0u, 0u);
  __syncthreads();
  XcdBarrier xb = xcd_barrier_post((unsigned*)(p.ws + OFF_BAR), (volatile LAS unsigned*)&xb_words);
  if (p.ws == nullptr) cg::this_grid().sync();
  run_all<0>(p, lds, xb);
}
#else
template <int PH>
__global__ void __launch_bounds__(256, 2) mega(P p) {
  __shared__ __attribute__((aligned(16))) char lds[65536];
  run_phase(p, PH, lds);
}
template <int PH> void launch_all(const P& p, int grid, hipStream_t stream) {
  hipLaunchKernelGGL(mega<PH>, dim3(grid), dim3(256), 0, stream, p);
  if constexpr (PH + 1 < NPHASE) launch_all<PH + 1>(p, grid, stream);
}
#endif

extern "C" void kernel_launch(void* const* d_in, const int* in_sizes, int n_in, void* d_out, int out_size, void* d_ws, size_t ws_size, hipStream_t stream) {
  if (ws_size < WS_NEED) { fprintf(stderr, "workspace too small: %zu < %zu\n", ws_size, (size_t)WS_NEED); return; }
  P p{};
  const float** pp = (const float**)&p;
  for (int i = 0; i < 22; ++i) pp[i] = (const float*)d_in[i];
  p.out = (float*)d_out; p.ws = (char*)d_ws;
  static int grid_blocks = 0;
  if (!grid_blocks) {
    int dev = 0, cus = 0, per_cu = 0;
    (void)hipGetDevice(&dev);
    (void)hipDeviceGetAttribute(&cus, hipDeviceAttributeMultiprocessorCount, dev);
#if COOP
    (void)hipOccupancyMaxActiveBlocksPerMultiprocessor(&per_cu, mega, 256, 0);
#else
    per_cu = 2;
#endif
    if (per_cu > 2) per_cu = 2;
    if (per_cu < 1) per_cu = 1;
    grid_blocks = cus * per_cu;
  }
#if COOP
  (void)hipMemsetAsync((char*)d_ws + OFF_BAR, 0, BAR_BYTES, stream);
  void* args[] = {&p};
  hipError_t e = hipLaunchCooperativeKernel((void*)mega, dim3(grid_blocks), dim3(256), args, 0, stream);
  if (e != hipSuccess) fprintf(stderr, "cooperative launch failed: %s (grid %d)\n", hipGetErrorString(e), grid_blocks);
#else
  launch_all<0>(p, grid_blocks, stream);
#endif
}
```

```cpp
#include <hip/hip_runtime.h>
#include <hip/hip_cooperative_groups.h>
#include <cstdint>
#include <cstdio>
namespace cg = cooperative_groups;

typedef unsigned short bf16_t;
typedef short bf16x8 __attribute__((ext_vector_type(8)));
typedef float f32x16 __attribute__((ext_vector_type(16)));
typedef float f32x4 __attribute__((ext_vector_type(4)));
typedef float f32x2 __attribute__((ext_vector_type(2)));
typedef unsigned u32x4 __attribute__((ext_vector_type(4)));
typedef unsigned u32x2 __attribute__((ext_vector_type(2)));
#define DEV __device__ __forceinline__

#ifndef COOP
#define COOP 1
#endif
#ifndef PROBE_SCAN_ONLY
#define PROBE_SCAN_ONLY 0
#endif
#ifndef PROBE_DUP_S
#define PROBE_DUP_S -1
#define PROBE_DUP_S2 -1
#endif

constexpr int T = 16896, TL = 16384, NLAT = 8192, NCTX = 256, D = 1024, DFF = 2816;
constexpr int KSP = 8448;
constexpr float EPS = 1e-6f;
constexpr int WIN_LD = 8400;
constexpr int NWIN = 5504;

constexpr size_t SZ(size_t cols, size_t b) { return (size_t)T * cols * b; }
constexpr size_t OFF_BAR = 0, BAR_BYTES = 16384;
constexpr size_t OFF_MODP = BAR_BYTES;
constexpr size_t OFF_MOD  = OFF_MODP + 4ull * 2 * 3 * 9216 * 4;
constexpr size_t OFF_HCTX = OFF_MOD + 2ull * 3 * 9216 * 4;
constexpr size_t OFF_WT   = OFF_HCTX + 512ull * 1024 * 4;
constexpr size_t WT_BYTES = 24ull << 20;
constexpr size_t OFF_A    = OFF_WT + WT_BYTES;
constexpr size_t OFF_U    = OFF_A + SZ(1024, 2);
constexpr size_t U_GQR  = 0;
constexpr size_t U_MQA  = U_GQR + SZ(1536, 2);
constexpr size_t U_MKVA = U_MQA + SZ(384, 2);
constexpr size_t U_GG   = U_MKVA + SZ(256, 2);
constexpr size_t U_GAB  = U_GG + SZ(512, 2);
constexpr size_t U_MKR  = U_GAB + SZ(16, 4);
constexpr size_t U_HQ   = U_MKR + SZ(64, 2);
constexpr size_t U_HK   = U_HQ + SZ(512, 2);
constexpr size_t U_HI   = U_HK + SZ(1024, 2);
constexpr size_t U_HG   = U_HI + SZ(512, 2);
constexpr size_t U_GQ2  = U_HG + SZ(512, 2);
constexpr size_t U_MQ   = U_GQ2 + SZ(1536, 2);
constexpr size_t U_MKN  = U_MQ + SZ(768, 2);
constexpr size_t U_MVT  = U_MKN + SZ(512, 2);
constexpr size_t U_END  = U_MVT + SZ(512, 2);
constexpr size_t U_OGF = U_GQR, U_OGB = U_GQR + SZ(512, 2), U_OHF = U_GQR + SZ(1024, 2), U_OHB = U_MQA;
constexpr size_t OFF_YB = OFF_U + U_END;
constexpr size_t U_ARE = U_HK, U_YA = U_GQ2, U_YC = U_GQ2 + SZ(512, 2), U_M = U_MQ;
constexpr size_t U_HFF = 0;
constexpr size_t U_Y   = SZ(2816, 2);
constexpr size_t WS_NEED = OFF_YB + SZ(512, 2);
static_assert(U_Y + SZ(1024, 4) <= U_M, "Y overlaps M");
constexpr size_t WT_WI = 0, WT_WO = 5632ull * 1024 * 2;
constexpr size_t WT_WIN = 0, WT_WG = (size_t)NWIN * 1024 * 2, WT_WQB = WT_WG + 3072ull * 1024 * 2, WT_WKVB = WT_WQB + 768ull * 384 * 2,
                 WT_WBR = WT_WKVB + 1024ull * 256 * 2, WT_WOUT = WT_WBR + 3ull * 1024 * 512 * 2, WT_MIX_END = WT_WOUT + 1024ull * 1024 * 2;
static_assert(WT_MIX_END <= WT_BYTES, "WT too small");
static_assert(WT_WO + 1024ull * 2816 * 2 <= WT_BYTES, "WT too small");

struct P {
  const float *x, *c, *ctx, *c_ctx, *w_ada, *b_ada, *norm_w, *ffn_w_in, *ffn_w_out, *w_in, *gdn_conv, *gdn_a_log, *gdn_dt_bias, *gdn_norm,
      *mla_q_norm, *mla_kv_norm, *mla_w_q_b, *mla_w_kv_b, *hg_lb, *hg_norm, *w_branch, *w_out;
  float* out; char* ws;
};

DEV unsigned pk2(float lo, float hi) {
  typedef __bf16 bf2 __attribute__((ext_vector_type(2)));
  f32x2 v = {lo, hi};
  bf2 b = __builtin_convertvector(v, bf2);
  return __builtin_bit_cast(unsigned, b);
}
DEV bf16_t f2bf(float x) { return (bf16_t)(pk2(x, 0.f) & 0xffffu); }
DEV float bflo(unsigned w) { return __uint_as_float(w << 16); }
DEV float bfhi(unsigned w) { return __uint_as_float(w & 0xffff0000u); }
DEV float bf2f(bf16_t h) { return __uint_as_float((unsigned)h << 16); }
DEV void st4bf(bf16_t* dst, float a, float b, float c, float d) { u32x2 w = {pk2(a, b), pk2(c, d)}; *(u32x2*)dst = w; }
DEV float sigmoidf_(float x) { return 1.f / (1.f + __expf(-x)); }
DEV float siluf_(float x) { return x / (1.f + __expf(-x)); }
DEV float wave_sum(float v) {
#pragma unroll
  for (int o = 32; o > 0; o >>= 1) v += __shfl_xor(v, o);
  return v;
}
DEV float sum16(float v) {
#pragma unroll
  for (int o = 8; o > 0; o >>= 1) v += __shfl_xor(v, o);
  return v;
}
DEV float rowsum16(float x) {
  x += __int_as_float(__builtin_amdgcn_update_dpp(0, __float_as_int(x), 0xB1, 0xf, 0xf, true));
  x += __int_as_float(__builtin_amdgcn_update_dpp(0, __float_as_int(x), 0x4E, 0xf, 0xf, true));
  x += __int_as_float(__builtin_amdgcn_update_dpp(0, __float_as_int(x), 0x141, 0xf, 0xf, true));
  x += __int_as_float(__builtin_amdgcn_update_dpp(0, __float_as_int(x), 0x140, 0xf, 0xf, true));
  return x;
}
DEV int TIDX() { int t = __builtin_amdgcn_workitem_id_x(); asm volatile("" : "+v"(t)); return t; }
DEV int sel_of(int r) { return r < TL ? (r >> 13) : 2; }
DEV int kx_of(int r) { return r < TL ? (r & 8191) : 8192 + ((r - TL) & 255); }
DEV int batch_of(int r) { return r < TL ? (r >> 13) : ((r - TL) >> 8); }
DEV int swz(int row, int ch) { return row * 128 + (((ch ^ (row >> 1)) & 7) << 4); }


DEV int vblock() { const int G = gridDim.x, j = blockIdx.x; return (G & 7) ? j : (j & 7) * (G >> 3) + (j >> 3); }
DEV void tile_map(int idx, int MT, int NT, int& mt, int& nt) {
  const int nig = 8 * NT, g = idx / nig, fm = g * 8, gsz = (MT - fm) < 8 ? (MT - fm) : 8, r = idx - g * nig;
  mt = fm + r % gsz; nt = r / gsz;
}


#define XB_TMO      128
#define XB_XCNT(j)  (256  + 64 * (j))
#define XB_XSUB(j)  (1280 + 64 * (j))
#define XB_XGEN(j)  (2304 + 64 * (j))
#define XB_TOP      3328
#define XB_TOPGEN   3392
#define XCD_BAR_WORDS 3456
#define XB_SPIN_CAP (1u << 22)
#define LAS __attribute__((address_space(3)))
static_assert(XCD_BAR_WORDS * 4 <= BAR_BYTES, "barrier words");
DEV unsigned xb_ld(unsigned* p) { return __hip_atomic_load(p, __ATOMIC_RELAXED, __HIP_MEMORY_SCOPE_AGENT); }
DEV unsigned xb_add(unsigned* p, unsigned v) { return __hip_atomic_fetch_add(p, v, __ATOMIC_RELAXED, __HIP_MEMORY_SCOPE_AGENT); }
DEV unsigned xb_xcc_id() { return (unsigned)__builtin_amdgcn_s_getreg((3 << 11) | 20) & 0xFu; }
#define XB_SPIN(cond, bar) do { unsigned _sp = 0; while (cond) { __builtin_amdgcn_s_sleep(1); \
    if ((++_sp & 255u) == 0u) { if (xb_ld(&(bar)[XB_TMO])) break; if (_sp > XB_SPIN_CAP) { atomicAdd(&(bar)[XB_TMO], 1u); break; } } } } while (0)
struct XcdBarrier { unsigned* bar; unsigned x; volatile LAS unsigned* st; };
DEV XcdBarrier xcd_barrier_post(unsigned* bar, volatile LAS unsigned* st) {
  XcdBarrier b; b.bar = bar; b.x = xb_xcc_id(); b.st = st;
  if (__builtin_amdgcn_workitem_id_x() == 0) (void)xb_add(&bar[XB_XCNT(b.x)], 1u);
  return b;
}
DEV void xcd_barrier_complete(unsigned* bar, unsigned x, unsigned& nloc, unsigned& nx) {
  const unsigned G = gridDim.x;
  unsigned sum, cnt, mine, sp = 0u;
  for (;;) {
    sum = 0u; cnt = 0u; mine = 0u;
#pragma unroll
    for (unsigned j = 0; j < 16; ++j) { const unsigned c = xb_ld(&bar[XB_XCNT(j)]); sum += c; cnt += (c > 0u) ? 1u : 0u; mine = (j == x) ? c : mine; }
    if (sum == G) break;
    __builtin_amdgcn_s_sleep(1);
    if ((++sp & 255u) == 0u) { if (xb_ld(&bar[XB_TMO])) break; if (sp > XB_SPIN_CAP) { atomicAdd(&bar[XB_TMO], 1u); break; } }
  }
  nloc = mine > 0u ? mine : 1u; nx = cnt > 0u ? cnt : 1u;
}
DEV void xcd_barrier(const XcdBarrier& b) {
  asm volatile("s_waitcnt vmcnt(0)" ::: "memory");
  __syncthreads();
  if (__builtin_amdgcn_workitem_id_x() == 0) {
    unsigned* bar = b.bar;
    __builtin_amdgcn_s_waitcnt(0);
    unsigned nloc = b.st[0], nx = b.st[1];
    if (nloc == 0u) { xcd_barrier_complete(bar, b.x, nloc, nx); b.st[0] = nloc; b.st[1] = nx; }
    const unsigned old = xb_add(&bar[XB_XSUB(b.x)], 1u);
    const unsigned gen = old / nloc;
    if (old + 1u == (gen + 1u) * nloc) {
      __builtin_amdgcn_fence(__ATOMIC_RELEASE, "agent");
      asm volatile("s_waitcnt vmcnt(0)" ::: "memory");
      const unsigned og = xb_add(&bar[XB_TOP], 1u);
      const unsigned tg = og / nx;
      if (og + 1u == (tg + 1u) * nx) xb_add(&bar[XB_TOPGEN], 1u);
      else XB_SPIN(xb_ld(&bar[XB_TOPGEN]) == tg, bar);
      __builtin_amdgcn_fence(__ATOMIC_ACQUIRE, "agent");
      xb_add(&bar[XB_XGEN(b.x)], 1u);
      asm volatile("s_waitcnt vmcnt(0)" ::: "memory");
    } else {
      XB_SPIN(xb_ld(&bar[XB_XGEN(b.x)]) == gen, bar);
      __builtin_amdgcn_fence(__ATOMIC_ACQUIRE, "agent");
      asm volatile("s_waitcnt vmcnt(0)" ::: "memory");
    }
  }
  __syncthreads();
}

#if COOP
#define GRID_SYNC() xcd_barrier(xb)
#else
#define GRID_SYNC()
#endif

template <int BN>
DEV void gemm_core_reg(const bf16_t* __restrict__ A, int lda, const bf16_t* __restrict__ B, int ldb, int K, f32x16 (&acc)[2][BN / 64], char* lds) {
  constexpr int NB = BN / 64, NBL = BN / 32;
  constexpr int A_BYTES = 128 * 128, ST = A_BYTES + BN * 128;
  const int tid = TIDX(), lane = tid & 63, wid = tid >> 6, wr = wid >> 1, wc = wid & 1;
  const int lrow = tid >> 3, lch = tid & 7;
  u32x4 ra[2][4], rb[2][NBL];
  const bf16_t* ap = A + (size_t)lrow * lda + lch * 8;
  const bf16_t* bp = B + (size_t)lrow * ldb + lch * 8;
  const int nk = K >> 6;
#define GC_LOAD(set, k0) do { _Pragma("unroll") for (int i = 0; i < 4; ++i) ra[set][i] = *(const u32x4*)(ap + (size_t)(32 * i) * lda + (k0)); \
    _Pragma("unroll") for (int i = 0; i < NBL; ++i) rb[set][i] = *(const u32x4*)(bp + (size_t)(32 * i) * ldb + (k0)); } while (0)
#define GC_STORE(stage, set) do { char* st_ = lds + (stage) * ST; _Pragma("unroll") for (int i = 0; i < 4; ++i) *(u32x4*)(st_ + swz(lrow + 32 * i, lch)) = ra[set][i]; \
    _Pragma("unroll") for (int i = 0; i < NBL; ++i) *(u32x4*)(st_ + A_BYTES + swz(lrow + 32 * i, lch)) = rb[set][i]; } while (0)
#define GC_COMPUTE(stage) do { const char* cur = lds + (stage) * ST; _Pragma("unroll") for (int ks = 0; ks < 4; ++ks) { const int ch = ks * 2 + (lane >> 5); bf16x8 af[2], bfr[NB]; \
    _Pragma("unroll") for (int mi = 0; mi < 2; ++mi) af[mi] = *(const bf16x8*)(cur + swz(wr * 64 + mi * 32 + (lane & 31), ch)); \
    _Pragma("unroll") for (int ni = 0; ni < NB; ++ni) bfr[ni] = *(const bf16x8*)(cur + A_BYTES + swz(wc * (BN / 2) + ni * 32 + (lane & 31), ch)); \
    _Pragma("unroll") for (int mi = 0; mi < 2; ++mi) _Pragma("unroll") for (int ni = 0; ni < NB; ++ni) acc[mi][ni] = __builtin_amdgcn_mfma_f32_32x32x16_bf16(bfr[ni], af[mi], acc[mi][ni], 0, 0, 0); } } while (0)
  GC_LOAD(0, 0);
  GC_STORE(0, 0);
  if (nk > 1) GC_LOAD(1, 64);
  __syncthreads();
  for (int kt = 0; kt < nk; kt += 2) {
    if (kt + 2 < nk) GC_LOAD(0, (kt + 2) * 64);
    __builtin_amdgcn_sched_barrier(0);
    GC_COMPUTE(0);
    __builtin_amdgcn_sched_barrier(0);
    if (kt + 1 < nk) GC_STORE(1, 1);
    __syncthreads();
    if (kt + 1 >= nk) break;
    if (kt + 3 < nk) GC_LOAD(1, (kt + 3) * 64);
    __builtin_amdgcn_sched_barrier(0);
    GC_COMPUTE(1);
    __builtin_amdgcn_sched_barrier(0);
    if (kt + 2 < nk) GC_STORE(0, 0);
    __syncthreads();
  }
#undef GC_LOAD
#undef GC_STORE
#undef GC_COMPUTE
}
#define LDSAS __attribute__((address_space(3)))
template <int N> DEV void wait_vmcnt() { asm volatile("s_waitcnt vmcnt(%0)" ::"n"(N) : "memory"); }
template <int BN>
DEV void gemm_core(const bf16_t* __restrict__ A, int lda, const bf16_t* __restrict__ B, int ldb, int K, f32x16 (&acc)[2][BN / 64], char* lds) {
  constexpr int NB = BN / 64, NPB = BN / 32;
  constexpr int NP = 4 + NPB;
  constexpr int A_BYTES = 128 * 128, ST = A_BYTES + BN * 128;
  const int tid = TIDX(), lane = tid & 63, wid = __builtin_amdgcn_readfirstlane(tid >> 6), wr = wid >> 1, wc = wid & 1;
  LDSAS char* l3 = (LDSAS char*)lds;
  unsigned offA[4], offB[NPB];
#pragma unroll
  for (int i = 0; i < 4; ++i) { const int row = (wid * 4 + i) * 8 + (lane >> 3); offA[i] = (unsigned)(row * lda + (((lane & 7) ^ ((row >> 1) & 7)) << 3)) * 2u; }
#pragma unroll
  for (int i = 0; i < NPB; ++i) { const int row = (wid * NPB + i) * 8 + (lane >> 3); offB[i] = (unsigned)(row * ldb + (((lane & 7) ^ ((row >> 1) & 7)) << 3)) * 2u; }
  const int nk = K >> 6;
#define GD_ISSUE(stage, kt_) do { const char* ga_ = (const char*)A + (size_t)(kt_) * 128; const char* gb_ = (const char*)B + (size_t)(kt_) * 128; \
    _Pragma("unroll") for (int i = 0; i < 4; ++i) __builtin_amdgcn_global_load_lds((const unsigned*)(ga_ + offA[i]), (LDSAS unsigned*)(l3 + (stage) * ST + (wid * 4 + i) * 1024), 16, 0, 0); \
    _Pragma("unroll") for (int i = 0; i < NPB; ++i) __builtin_amdgcn_global_load_lds((const unsigned*)(gb_ + offB[i]), (LDSAS unsigned*)(l3 + (stage) * ST + A_BYTES + (wid * NPB + i) * 1024), 16, 0, 0); } while (0)
  wait_vmcnt<0>();
  GD_ISSUE(0, 0);
  if (nk > 1) { GD_ISSUE(1, 1); wait_vmcnt<NP>(); } else wait_vmcnt<0>();
  __builtin_amdgcn_s_barrier(); asm volatile("" ::: "memory");
  for (int kt = 0; kt < nk; ++kt) {
    const char* cur = lds + (kt & 1) * ST;
#pragma unroll
    for (int ks = 0; ks < 4; ++ks) {
      const int ch = ks * 2 + (lane >> 5);
      bf16x8 af[2], bfr[NB];
#pragma unroll
      for (int mi = 0; mi < 2; ++mi) af[mi] = *(const bf16x8*)(cur + swz(wr * 64 + mi * 32 + (lane & 31), ch));
#pragma unroll
      for (int ni = 0; ni < NB; ++ni) bfr[ni] = *(const bf16x8*)(cur + A_BYTES + swz(wc * (BN / 2) + ni * 32 + (lane & 31), ch));
#pragma unroll
      for (int mi = 0; mi < 2; ++mi)
#pragma unroll
        for (int ni = 0; ni < NB; ++ni) acc[mi][ni] = __builtin_amdgcn_mfma_f32_32x32x16_bf16(bfr[ni], af[mi], acc[mi][ni], 0, 0, 0);
    }
    asm volatile("s_waitcnt lgkmcnt(0)" ::: "memory");
    __builtin_amdgcn_s_barrier(); asm volatile("" ::: "memory");
    if (kt + 2 < nk) { GD_ISSUE(kt & 1, kt + 2); wait_vmcnt<NP>(); }
    else wait_vmcnt<0>();
    __builtin_amdgcn_s_barrier(); asm volatile("" ::: "memory");
  }
#undef GD_ISSUE
}
template <int NB>
DEV void zero_acc(f32x16 (&acc)[2][NB]) {
#pragma unroll
  for (int a = 0; a < 2; ++a)
#pragma unroll
    for (int b = 0; b < NB; ++b)
#pragma unroll
      for (int i = 0; i < 16; ++i) acc[a][b][i] = 0.f;
}

struct Cv { const float* src; int ld; int K; int Np; int kind; const float* ks; bf16_t* dst; };
DEV int cv_map(int kind, int n) {
  if (kind == 0) return n;
  if (kind == 1) { const int g = n >> 6, r = n & 63; return r < 32 ? g * 32 + r : 2816 + g * 32 + (r - 32); }
  if (kind == 2) {
    if (n < 2064) return n;
    if (n < 2176) return -1;
    if (n < 2880) return 2064 + (n - 2176);
    if (n < 2944) return -1;
    return 2768 + (n - 2944);
  }
  return 5328 + n;
}
DEV void cv_run(const Cv c, char* lds) {
  float* tile = (float*)lds;
  const int tid = TIDX();
  const int nkt = c.K >> 6, ntile = nkt * (c.Np >> 6);
  for (int t = blockIdx.x; t < ntile; t += gridDim.x) {
    const int k0 = (t % nkt) * 64, n0 = (t / nkt) * 64;
    const int nn = tid & 63, src_n = cv_map(c.kind, n0 + nn);
#pragma unroll 4
    for (int i = 0; i < 16; ++i) {
      const int k = i * 4 + (tid >> 6);
      float v = 0.f;
      if (src_n >= 0) { v = c.src[(size_t)(k0 + k) * c.ld + src_n]; if (c.ks) v *= c.ks[k0 + k]; }
      tile[k * 65 + nn] = v;
    }
    __syncthreads();
#pragma unroll 4
    for (int i = 0; i < 16; ++i) {
      const int n = i * 4 + (tid >> 6), k = tid & 63;
      c.dst[(size_t)(n0 + n) * c.K + k0 + k] = f2bf(tile[k * 65 + n]);
    }
    __syncthreads();
  }
}
DEV void conv_ffn(const P& p, int l, int f, char* lds) {
  bf16_t* wt = (bf16_t*)(p.ws + OFF_WT);
  Cv a = {p.ffn_w_in + (size_t)(l * 2 + f) * 1024 * 5632, 5632, 1024, 5632, 1, nullptr, (bf16_t*)((char*)wt + WT_WI)};
  cv_run(a, lds);
  Cv b = {p.ffn_w_out + (size_t)(l * 2 + f) * 2816 * 1024, 1024, 2816, 1024, 0, nullptr, (bf16_t*)((char*)wt + WT_WO)};
  cv_run(b, lds);
}
DEV void conv_mixer(const P& p, int l, char* lds) {
  char* wt = p.ws + OFF_WT;
  const float* win = p.w_in + (size_t)l * 1024 * WIN_LD;
  Cv a = {win, WIN_LD, 1024, NWIN, 2, nullptr, (bf16_t*)(wt + WT_WIN)}; cv_run(a, lds);
  Cv b = {win, WIN_LD, 1024, 3072, 3, nullptr, (bf16_t*)(wt + WT_WG)}; cv_run(b, lds);
  Cv c = {p.mla_w_q_b + (size_t)l * 384 * 768, 768, 384, 768, 0, p.mla_q_norm + l * 384, (bf16_t*)(wt + WT_WQB)}; cv_run(c, lds);
  Cv d = {p.mla_w_kv_b + (size_t)l * 256 * 1024, 1024, 256, 1024, 0, p.mla_kv_norm + l * 256, (bf16_t*)(wt + WT_WKVB)}; cv_run(d, lds);
#pragma unroll 1
  for (int j = 0; j < 3; ++j) {
    Cv e = {p.w_branch + (size_t)(l * 3 + j) * 512 * 1024, 1024, 512, 1024, 0, nullptr, (bf16_t*)(wt + WT_WBR) + (size_t)j * 1024 * 512};
    cv_run(e, lds);
  }
  Cv f = {p.w_out + (size_t)l * 1024 * 1024, 1024, 1024, 1024, 0, nullptr, (bf16_t*)(wt + WT_WOUT)}; cv_run(f, lds);
}

DEV void phase0(const P& p, char* lds) {
  const int tid = TIDX();
  {
    const f32x4* s = (const f32x4*)p.x; f32x4* d = (f32x4*)p.out;
    const size_t n = (size_t)TL * D / 4;
    for (size_t i = (size_t)blockIdx.x * 256 + tid; i < n; i += (size_t)gridDim.x * 256) d[i] = s[i];
    const f32x4* s2 = (const f32x4*)p.ctx; f32x4* d2 = (f32x4*)(p.ws + OFF_HCTX);
    const size_t n2 = 512ull * D / 4;
    for (size_t i = (size_t)blockIdx.x * 256 + tid; i < n2; i += (size_t)gridDim.x * 256) d2[i] = s2[i];
  }
  {
    float* sv = (float*)lds;
    float* modp = (float*)(p.ws + OFF_MODP);
    for (int t = blockIdx.x; t < 2 * 36 * 4; t += gridDim.x) {
      const int ks = t & 3, cb = (t >> 2) % 36, l = t / 144;
      __syncthreads();
      {
        const int k = ks * 256 + tid;
        sv[tid] = siluf_(p.c[k]); sv[256 + tid] = siluf_(p.c[1024 + k]); sv[512 + tid] = siluf_(p.c_ctx[k]);
      }
      __syncthreads();
      const int col = cb * 256 + tid;
      const float* w = p.w_ada + ((size_t)l * 1024 + ks * 256) * 9216 + col;
      float a0 = 0.f, a1 = 0.f, a2 = 0.f;
#pragma unroll 8
      for (int k = 0; k < 256; ++k) { const float wv = w[(size_t)k * 9216]; a0 += sv[k] * wv; a1 += sv[256 + k] * wv; a2 += sv[512 + k] * wv; }
      float* o = modp + ((size_t)(ks * 2 + l) * 3) * 9216 + col;
      o[0] = a0; o[9216] = a1; o[2 * 9216] = a2;
    }
    __syncthreads();
  }
  conv_ffn(p, 0, 0, lds);
}
DEV void phase0b(const P& p) {
  const float* modp = (const float*)(p.ws + OFF_MODP);
  float* mod = (float*)(p.ws + OFF_MOD);
  for (int i = blockIdx.x * 256 + TIDX(); i < 2 * 3 * 9216; i += gridDim.x * 256) {
    const int col = i % 9216, l = i / (3 * 9216);
    float v = p.b_ada[l * 9216 + col];
#pragma unroll
    for (int ks = 0; ks < 4; ++ks) v += modp[(size_t)ks * 2 * 3 * 9216 + i];
    mod[i] = v;
  }
}

DEV void row_phase(const P& p, bool do_post, int l_post, const bf16_t* __restrict__ Y, int gate_idx, float gate_mul, int postw_idx,
                   bool do_pre, int l_pre, int prew_idx, int shift_idx, bf16_t* __restrict__ Aout, int nrows = T) {
  const float* mod = (const float*)(p.ws + OFF_MOD);
  float* hctx = (float*)(p.ws + OFF_HCTX);
  const int lane = TIDX() & 63, wid = TIDX() >> 6;
  for (int r = blockIdx.x * 4 + wid; r < nrows; r += gridDim.x * 4) {
    float* hrow = r < TL ? p.out + (size_t)r * D : hctx + (size_t)(r - TL) * D;
    const int sel = sel_of(r);
    f32x4 h[4];
#pragma unroll
    for (int i = 0; i < 4; ++i) h[i] = *(const f32x4*)(hrow + i * 256 + lane * 4);
    if (do_post) {
      f32x4 y[4]; float ss = 0.f;
#pragma unroll
      for (int i = 0; i < 4; ++i) { const u32x2 yw = *(const u32x2*)(Y + (size_t)r * D + i * 256 + lane * 4); y[i] = (f32x4){bflo(yw[0]), bfhi(yw[0]), bflo(yw[1]), bfhi(yw[1])}; ss += y[i][0] * y[i][0] + y[i][1] * y[i][1] + y[i][2] * y[i][2] + y[i][3] * y[i][3]; }
      ss = wave_sum(ss);
      const float rs = rsqrtf(ss * (1.f / 1024.f) + EPS);
      const float* pw = p.norm_w + (size_t)(l_post * 6 + postw_idx) * 1024;
      const float* gt = mod + ((size_t)(l_post * 3 + sel) * 9 + gate_idx) * 1024;
#pragma unroll
      for (int i = 0; i < 4; ++i) {
        const f32x4 w4 = *(const f32x4*)(pw + i * 256 + lane * 4), g4 = *(const f32x4*)(gt + i * 256 + lane * 4);
        h[i] += gate_mul * g4 * (y[i] * rs * w4);
        *(f32x4*)(hrow + i * 256 + lane * 4) = h[i];
      }
    }
    if (do_pre) {
      float ss = 0.f;
#pragma unroll
      for (int i = 0; i < 4; ++i) ss += h[i][0] * h[i][0] + h[i][1] * h[i][1] + h[i][2] * h[i][2] + h[i][3] * h[i][3];
      ss = wave_sum(ss);
      const float rs = rsqrtf(ss * (1.f / 1024.f) + EPS);
      const float* nw = p.norm_w + (size_t)(l_pre * 6 + prew_idx) * 1024;
      const float* sh = mod + ((size_t)(l_pre * 3 + sel) * 9 + shift_idx) * 1024;
      const float* sc = sh + 1024;
#pragma unroll
      for (int i = 0; i < 4; ++i) {
        const f32x4 w4 = *(const f32x4*)(nw + i * 256 + lane * 4), s4 = *(const f32x4*)(sh + i * 256 + lane * 4), c4 = *(const f32x4*)(sc + i * 256 + lane * 4);
        const f32x4 v = (h[i] * rs * w4) * (1.f + c4) + s4;
        st4bf(Aout + (size_t)r * D + i * 256 + lane * 4, v[0], v[1], v[2], v[3]);
      }
    }
  }
}

DEV void ffn_gemm1(const P& p, char* lds, int MT) {
  const bf16_t* A = (const bf16_t*)(p.ws + OFF_A);
  const bf16_t* W = (const bf16_t*)(p.ws + OFF_WT + WT_WI);
  bf16_t* H = (bf16_t*)(p.ws + OFF_U + U_HFF);
  const int lane = TIDX() & 63, wid = TIDX() >> 6, wr = wid >> 1, wc = wid & 1, h2 = lane >> 5;
  constexpr int NT = 5632 / 128;
  for (int t = vblock(); t < MT * NT; t += gridDim.x) {
    int mt, nt; tile_map(t, MT, NT, mt, nt);
    f32x16 acc[2][2]; zero_acc<2>(acc);
    gemm_core<128>(A + (size_t)mt * 128 * 1024, 1024, W + (size_t)nt * 128 * 1024, 1024, 1024, acc, lds);
#pragma unroll
    for (int mi = 0; mi < 2; ++mi) {
      const int row = mt * 128 + wr * 64 + mi * 32 + (lane & 31);
      bf16_t* dst = H + (size_t)row * DFF + (nt * 2 + wc) * 32 + 4 * h2;
#pragma unroll
      for (int q = 0; q < 4; ++q) {
        float v[4];
#pragma unroll
        for (int j = 0; j < 4; ++j) v[j] = siluf_(acc[mi][0][q * 4 + j]) * acc[mi][1][q * 4 + j];
        st4bf(dst + 8 * q, v[0], v[1], v[2], v[3]);
      }
    }
  }
}
DEV void gemm_f32out(const bf16_t* A, int K, const bf16_t* W, bf16_t* Y, char* lds, int MT) {
  const int lane = TIDX() & 63, wid = TIDX() >> 6, wr = wid >> 1, wc = wid & 1, h2 = lane >> 5;
  constexpr int NT = 1024 / 128;
  for (int t = vblock(); t < MT * NT; t += gridDim.x) {
    int mt, nt; tile_map(t, MT, NT, mt, nt);
    f32x16 acc[2][2]; zero_acc<2>(acc);
    gemm_core<128>(A + (size_t)mt * 128 * K, K, W + (size_t)nt * 128 * K, K, K, acc, lds);
#pragma unroll
    for (int mi = 0; mi < 2; ++mi) {
      const int row = mt * 128 + wr * 64 + mi * 32 + (lane & 31);
#pragma unroll
      for (int ni = 0; ni < 2; ++ni) {
        bf16_t* dst = Y + (size_t)row * D + nt * 128 + wc * 64 + ni * 32 + 4 * h2;
#pragma unroll
        for (int q = 0; q < 4; ++q) st4bf(dst + 8 * q, acc[mi][ni][q * 4], acc[mi][ni][q * 4 + 1], acc[mi][ni][q * 4 + 2], acc[mi][ni][q * 4 + 3]);
      }
    }
  }
}

DEV void rope32(f32x16& v, int a, int r, int h2) {
  if (r >= TL) return;
  const int n = r & 8191;
  const float pos = (float)(a == 0 ? (n >> 6) : (n & 63));
#pragma unroll
  for (int reg = 0; reg < 8; ++reg) {
    const int f = (reg & 3) + 8 * (reg >> 2) + 4 * h2;
    const float inv = __builtin_amdgcn_exp2f(-(float)f * (13.287712379549449f / 16.f));
    const float ang = pos * inv;
    const float c = __cosf(ang), s = __sinf(ang);
    const float x1 = v[reg], x2 = v[reg + 8];
    v[reg] = x1 * c - x2 * s;
    v[reg + 8] = x2 * c + x1 * s;
  }
}

DEV void win_gemm(const P& p, int l, char* lds) {
  const bf16_t* A = (const bf16_t*)(p.ws + OFF_A);
  const bf16_t* W = (const bf16_t*)(p.ws + OFF_WT + WT_WIN);
  char* U = p.ws + OFF_U;
  bf16_t *GQR = (bf16_t*)(U + U_GQR), *GG = (bf16_t*)(U + U_GG), *MQA = (bf16_t*)(U + U_MQA), *MKVA = (bf16_t*)(U + U_MKVA), *MKR = (bf16_t*)(U + U_MKR),
         *HQ = (bf16_t*)(U + U_HQ), *HK = (bf16_t*)(U + U_HK), *HI = (bf16_t*)(U + U_HI), *HG = (bf16_t*)(U + U_HG);
  float* GAB = (float*)(U + U_GAB);
  const int lane = TIDX() & 63, wid = TIDX() >> 6, wr = wid >> 1, wc = wid & 1, h2 = lane >> 5;
  constexpr int MT = T / 128, NT = NWIN / 128;
  for (int t = vblock(); t < MT * NT; t += gridDim.x) {
    int mt, nt; tile_map(t, MT, NT, mt, nt);
    f32x16 acc[2][2]; zero_acc<2>(acc);
    gemm_core<128>(A + (size_t)mt * 128 * 1024, 1024, W + (size_t)nt * 128 * 1024, 1024, 1024, acc, lds);
#pragma unroll
    for (int ni = 0; ni < 2; ++ni) {
      const int nb = nt * 128 + wc * 64 + ni * 32;
#pragma unroll
      for (int mi = 0; mi < 2; ++mi) {
        const int row = mt * 128 + wr * 64 + mi * 32 + (lane & 31);
        f32x16 v = acc[mi][ni];
        bf16_t* dst = nullptr;
        if (nb < 1536) dst = GQR + (size_t)row * 1536 + nb;
        else if (nb < 2048) dst = GG + (size_t)row * 512 + (nb - 1536);
        else if (nb == 2048) {
#pragma unroll
          for (int reg = 0; reg < 16; ++reg) {
            const int c = (reg & 3) + 8 * (reg >> 2) + 4 * h2;
            if (c < 8) {
              const float al = p.gdn_a_log[l * 8 + c], dtb = p.gdn_dt_bias[l * 8 + c];
              const float xx = v[reg] + dtb;
              const float sp = xx > 20.f ? xx : log1pf(__expf(xx));
              GAB[(size_t)row * 16 + c] = -__expf(al) * sp;
            } else if (c < 16) {
              GAB[(size_t)row * 16 + c] = sigmoidf_(v[reg]);
            }
          }
        }
        else if (nb < 2176) {}
        else if (nb < 2560) dst = MQA + (size_t)row * 384 + (nb - 2176);
        else if (nb < 2816) dst = MKVA + (size_t)row * 256 + (nb - 2560);
        else if (nb < 2880) { rope32(v, (nb - 2816) >> 5, row, h2); dst = MKR + (size_t)row * 64 + (nb - 2816); }
        else if (nb < 2944) {}
        else if (nb < 3456) { v = v * 0.08838834764831845f; dst = HQ + (size_t)row * 512 + (nb - 2944); }
        else if (nb < 4480) {
          const int cb = nb - 3456;
#pragma unroll
          for (int reg = 0; reg < 16; ++reg) {
            const int c = cb + (reg & 3) + 8 * (reg >> 2) + 4 * h2;
            float lb = 0.f;
            if (l == 1) lb = sigmoidf_(p.hg_lb[1024 + c] - p.hg_lb[c]);
            v[reg] = (1.f - lb) * sigmoidf_(-v[reg]);
          }
          dst = HK + (size_t)row * 1024 + cb;
        }
        else if (nb < 4992) dst = HI + (size_t)row * 512 + (nb - 4480);
        else dst = HG + (size_t)row * 512 + (nb - 4992);
        if (dst) {
          dst += 4 * h2;
#pragma unroll
          for (int q = 0; q < 4; ++q) st4bf(dst + 8 * q, v[q * 4], v[q * 4 + 1], v[q * 4 + 2], v[q * 4 + 3]);
        }
      }
    }
  }
}

DEV void gdn_prep_rows(const P& p, int l) {
  char* U = p.ws + OFF_U;
  const bf16_t* GQR = (const bf16_t*)(U + U_GQR);
  bf16_t* GQ2 = (bf16_t*)(U + U_GQ2);
  const float* cw = p.gdn_conv + (size_t)l * 3 * 1536;
  const int lane = TIDX() & 63, wid = TIDX() >> 6;
  for (int r = blockIdx.x * 4 + wid; r < T; r += gridDim.x * 4) {
    bool hp, hn;
    if (r < TL) { const int n = r & 8191; hp = n > 0; hn = n < 8191; } else { const int tt = (r - TL) & 255; hp = tt > 0; hn = tt < 255; }
#pragma unroll
    for (int j = 0; j < 3; ++j) {
      const int c0 = j * 512 + lane * 8;
      const u32x4 z = {0u, 0u, 0u, 0u};
      const u32x4 xc = *(const u32x4*)(GQR + (size_t)r * 1536 + c0);
      const u32x4 xp = hp ? *(const u32x4*)(GQR + (size_t)(r - 1) * 1536 + c0) : z;
      const u32x4 xn = hn ? *(const u32x4*)(GQR + (size_t)(r + 1) * 1536 + c0) : z;
      float val[8]; float ss = 0.f;
#pragma unroll
      for (int i = 0; i < 8; ++i) {
        const unsigned wp = xp[i >> 1], wcur = xc[i >> 1], wn = xn[i >> 1];
        const float fp = (i & 1) ? bfhi(wp) : bflo(wp), fc = (i & 1) ? bfhi(wcur) : bflo(wcur), fn = (i & 1) ? bfhi(wn) : bflo(wn);
        const float s = fp * cw[c0 + i] + fc * cw[1536 + c0 + i] + fn * cw[3072 + c0 + i];
        val[i] = siluf_(s); ss += val[i] * val[i];
      }
      if (j < 2) {
        ss = sum16(ss);
        float sc = rsqrtf(ss + EPS);
        if (j == 0) sc *= 0.08838834764831845f;
#pragma unroll
        for (int i = 0; i < 8; ++i) val[i] *= sc;
      }
      u32x4 o = {pk2(val[0], val[1]), pk2(val[2], val[3]), pk2(val[4], val[5]), pk2(val[6], val[7])};
      *(u32x4*)(GQ2 + (size_t)r * 1536 + c0) = o;
    }
  }
}
DEV void row_scales(const bf16_t* A, int K, float* rs) {
  const int tid = TIDX(), row = tid >> 1, half = tid & 1;
  const bf16_t* a = A + (size_t)row * K + half * (K / 2);
  float ss = 0.f;
  for (int k = 0; k < K / 2; k += 8) {
    const u32x4 w = *(const u32x4*)(a + k);
#pragma unroll
    for (int i = 0; i < 4; ++i) { const float lo = bflo(w[i]), hi = bfhi(w[i]); ss += lo * lo + hi * hi; }
  }
  ss += __shfl_xor(ss, 1);
  if (half == 0) rs[row] = rsqrtf(ss / (float)K + EPS);
}
DEV void mla_prep_gemms(const P& p, char* lds) {
  char* U = p.ws + OFF_U;
  const bf16_t *MQA = (const bf16_t*)(U + U_MQA), *MKVA = (const bf16_t*)(U + U_MKVA);
  const bf16_t *WQ = (const bf16_t*)(p.ws + OFF_WT + WT_WQB), *WKV = (const bf16_t*)(p.ws + OFF_WT + WT_WKVB);
  bf16_t *MQ = (bf16_t*)(U + U_MQ), *MKN = (bf16_t*)(U + U_MKN), *MVT = (bf16_t*)(U + U_MVT);
  const int lane = TIDX() & 63, wid = TIDX() >> 6, wr = wid >> 1, wc = wid & 1, h2 = lane >> 5;
  constexpr int MT = T / 128;
  constexpr float QSCALE = 0.07216878364870322f * 1.4426950408889634f;
  for (int t = vblock(); t < MT * 14; t += gridDim.x) {
    int mt, nt; tile_map(t, MT, 14, mt, nt);
    const bool isq = nt < 6;
    const bf16_t* Ab = isq ? MQA + (size_t)mt * 128 * 384 : MKVA + (size_t)mt * 128 * 256;
    const int K = isq ? 384 : 256;
    float* rsl = (float*)lds;
    __syncthreads();
    row_scales(Ab, K, rsl);
    __syncthreads();
    float rsv[2];
#pragma unroll
    for (int mi = 0; mi < 2; ++mi) rsv[mi] = rsl[wr * 64 + mi * 32 + (lane & 31)];
    __syncthreads();
    f32x16 acc[2][2]; zero_acc<2>(acc);
    if (isq) gemm_core<128>(Ab, 384, WQ + (size_t)nt * 128 * 384, 384, 384, acc, lds);
    else gemm_core<128>(Ab, 256, WKV + (size_t)(nt - 6) * 128 * 256, 256, 256, acc, lds);
#pragma unroll
    for (int mi = 0; mi < 2; ++mi) {
      const int row = mt * 128 + wr * 64 + mi * 32 + (lane & 31);
#pragma unroll
      for (int ni = 0; ni < 2; ++ni) {
        f32x16 v = acc[mi][ni] * rsv[mi];
        if (isq) {
          const int nb = nt * 128 + wc * 64 + ni * 32, jb = nb % 192;
          if (jb >= 128) rope32(v, (jb - 128) >> 5, row, h2);
          v = v * QSCALE;
          bf16_t* dst = MQ + (size_t)row * 768 + nb + 4 * h2;
#pragma unroll
          for (int q = 0; q < 4; ++q) st4bf(dst + 8 * q, v[q * 4], v[q * 4 + 1], v[q * 4 + 2], v[q * 4 + 3]);
        } else {
          const int nb = (nt - 6) * 128 + wc * 64 + ni * 32, head = nb >> 8, jb = nb & 255;
          if (jb < 128) {
            bf16_t* dst = MKN + (size_t)row * 512 + head * 128 + jb + 4 * h2;
#pragma unroll
            for (int q = 0; q < 4; ++q) st4bf(dst + 8 * q, v[q * 4], v[q * 4 + 1], v[q * 4 + 2], v[q * 4 + 3]);
          } else {
            const int b = batch_of(row), kx = kx_of(row);
            bf16_t* dst = MVT + ((size_t)(b * 4 + head) * 128 + (jb - 128) + 4 * h2) * KSP + kx;
#pragma unroll
            for (int reg = 0; reg < 16; ++reg) dst[(size_t)((reg & 3) + 8 * (reg >> 2)) * KSP] = f2bf(v[reg]);
          }
        }
      }
    }
  }
}

template <int BR>
DEV void scan_task(const P& p, int b, int h, int dir, int cgp, char* lds) {
  char* U = p.ws + OFF_U;
  const int tid = TIDX(), lane = tid & 63, w = tid >> 6, kg = lane & 15, ci = lane >> 4;
  const bf16_t *Qs, *Ks, *Vs; int ldq, ldk, ldv;
  if (BR == 0) { const bf16_t* g = (const bf16_t*)(U + U_GQ2); Qs = g + h * 128; Ks = g + 512 + h * 128; Vs = g + 1024 + h * 128 + cgp * 16; ldq = ldk = ldv = 1536; }
  else { Qs = (const bf16_t*)(U + U_HQ) + h * 128; ldq = 512; Ks = (const bf16_t*)(U + U_HK) + dir * 512 + h * 128; ldk = 1024; Vs = (const bf16_t*)(U + U_HI) + h * 128 + cgp * 16; ldv = 512; }
  const float* AB = (const float*)(U + U_GAB);
  bf16_t* O = (bf16_t*)(U + (BR == 0 ? (dir ? U_OGB : U_OGF) : (dir ? U_OHB : U_OHF))) + h * 128 + cgp * 16 + w * 4 + ci;
  constexpr int BUF = 16384 + 1024 + 128 + 128;
  const int sg = 1 - 2 * dir;
  auto rowbase = [&](int s0) -> int {
    const int rb = s0 < 256 ? TL + b * 256 + (dir ? 255 - s0 : s0) : b * 8192 + (dir ? 8191 - (s0 - 256) : (s0 - 256));
    return __builtin_amdgcn_readfirstlane(rb);
  };
  f32x2 S2[4];
#pragma unroll
  for (int i = 0; i < 4; ++i) S2[i] = (f32x2){0.f, 0.f};
  u32x4 g0, g1; bf16_t gv; float gs = 0.f;
  const int st0 = tid >> 5, cc0 = tid & 31;
  auto gload = [&](int bt) {
    const int rb = rowbase(bt * 16);
    const int r0 = rb + sg * st0, r1 = rb + sg * (st0 + 8);
    g0 = cc0 < 16 ? *(const u32x4*)(Ks + (size_t)r0 * ldk + cc0 * 8) : *(const u32x4*)(Qs + (size_t)r0 * ldq + (cc0 - 16) * 8);
    g1 = cc0 < 16 ? *(const u32x4*)(Ks + (size_t)r1 * ldk + cc0 * 8) : *(const u32x4*)(Qs + (size_t)r1 * ldq + (cc0 - 16) * 8);
    gv = Vs[(size_t)(rb + sg * (tid >> 4)) * ldv + (tid & 15)];
    if (BR == 0 && tid < 32) {
      const int rr = rb + sg * (tid & 15);
      gs = AB[(size_t)rr * 16 + (tid < 16 ? 0 : 8) + dir * 4 + h];
    }
  };
  auto lwrite = [&](char* buf) {
    float* kq = (float*)buf;
    f32x4 a = {bflo(g0[0]), bfhi(g0[0]), bflo(g0[1]), bfhi(g0[1])}, bq = {bflo(g0[2]), bfhi(g0[2]), bflo(g0[3]), bfhi(g0[3])};
    *(f32x4*)(kq + st0 * 256 + cc0 * 8) = a; *(f32x4*)(kq + st0 * 256 + cc0 * 8 + 4) = bq;
    f32x4 c = {bflo(g1[0]), bfhi(g1[0]), bflo(g1[1]), bfhi(g1[1])}, d = {bflo(g1[2]), bfhi(g1[2]), bflo(g1[3]), bfhi(g1[3])};
    *(f32x4*)(kq + (st0 + 8) * 256 + cc0 * 8) = c; *(f32x4*)(kq + (st0 + 8) * 256 + cc0 * 8 + 4) = d;
    ((float*)(buf + 16384))[tid] = bf2f(gv);
    if (BR == 0 && tid < 32) ((float*)(buf + 16384 + 1024))[(tid & 15) * 2 + (tid >> 4)] = tid < 16 ? __expf(gs) : gs;
  };
  auto gram = [&](char* buf) {
    const float* kq = (const float*)buf;
    const int di = tid >> 3, sub = tid & 7, pp = di >> 2, wh = di & 3;
    const float* xv = kq + (2 * pp + (wh == 1 ? 0 : 1)) * 256 + (wh == 0 ? 0 : 128) + sub * 16;
    const float* yv = kq + (2 * pp + (wh == 3 ? 1 : 0)) * 256 + sub * 16;
    float acc = 0.f;
#pragma unroll
    for (int i = 0; i < 4; ++i) { const f32x4 x = *(const f32x4*)(xv + 4 * i), y = *(const f32x4*)(yv + 4 * i); acc += (x[0] * y[0] + x[1] * y[1]) + (x[2] * y[2] + x[3] * y[3]); }
    acc += __int_as_float(__builtin_amdgcn_update_dpp(0, __float_as_int(acc), 0xB1, 0xf, 0xf, true));
    acc += __int_as_float(__builtin_amdgcn_update_dpp(0, __float_as_int(acc), 0x4E, 0xf, 0xf, true));
    acc += __int_as_float(__builtin_amdgcn_update_dpp(0, __float_as_int(acc), 0x141, 0xf, 0xf, true));
    if (sub == 0) ((float*)(buf + 16384 + 1024 + 128))[di] = acc;
  };
  constexpr int NBT = KSP / 16;
  __syncthreads();
  gload(0); lwrite(lds);
  gload(1);
  __syncthreads();
  if (BR == 0) gram(lds);
  lwrite(lds + BUF);
  gload(2);
  __syncthreads();
  int ic = 0;
  for (int bt = 0; bt < NBT; ++bt) {
    char* cur = lds + ic * BUF;
    const int i1 = ic == 2 ? 0 : ic + 1, i2 = i1 == 2 ? 0 : i1 + 1;
    if (bt + 2 < NBT) lwrite(lds + i2 * BUF);
    if (bt + 3 < NBT) gload(bt + 3);
    const float* kq = (const float*)cur;
    const float* vv = (const float*)(cur + 16384);
    const float* ab = (const float*)(cur + 16384 + 1024);
    const float* gm = (const float*)(cur + 16384 + 1024 + 128);
    float osel = 0.f;
    if (BR == 0) {
      f32x4 nk00 = *(const f32x4*)(kq + kg * 4), nk01 = *(const f32x4*)(kq + 64 + kg * 4), nq00 = *(const f32x4*)(kq + 128 + kg * 4), nq01 = *(const f32x4*)(kq + 192 + kg * 4);
      f32x4 nk10 = *(const f32x4*)(kq + 256 + kg * 4), nk11 = *(const f32x4*)(kq + 320 + kg * 4), nq10 = *(const f32x4*)(kq + 384 + kg * 4), nq11 = *(const f32x4*)(kq + 448 + kg * 4);
      float nv0 = vv[w * 4 + ci], nv1 = vv[16 + w * 4 + ci];
      f32x4 nabv = *(const f32x4*)(ab), ngr = *(const f32x4*)(gm);
#pragma unroll
      for (int pp = 0; pp < 8; ++pp) {
        const f32x4 k00 = nk00, k01 = nk01, q00 = nq00, q01 = nq01, k10 = nk10, k11 = nk11, q10 = nq10, q11 = nq11;
        const float v0 = nv0, v1 = nv1;
        const f32x4 abv = nabv;
        const f32x4 gr = ngr;
        if (pp + 1 < 8) {
          const float* kq0 = kq + (2 * pp + 2) * 256; const float* kq1 = kq0 + 256;
          nk00 = *(const f32x4*)(kq0 + kg * 4); nk01 = *(const f32x4*)(kq0 + 64 + kg * 4); nq00 = *(const f32x4*)(kq0 + 128 + kg * 4); nq01 = *(const f32x4*)(kq0 + 192 + kg * 4);
          nk10 = *(const f32x4*)(kq1 + kg * 4); nk11 = *(const f32x4*)(kq1 + 64 + kg * 4); nq10 = *(const f32x4*)(kq1 + 128 + kg * 4); nq11 = *(const f32x4*)(kq1 + 192 + kg * 4);
          nv0 = vv[(2 * pp + 2) * 16 + w * 4 + ci]; nv1 = vv[(2 * pp + 3) * 16 + w * 4 + ci];
          nabv = *(const f32x4*)(ab + (pp + 1) * 4); ngr = *(const f32x4*)(gm + (pp + 1) * 4);
        }
        __builtin_amdgcn_sched_barrier(0);
        const f32x2 k0a = {k00[0], k00[1]}, k0b = {k00[2], k00[3]}, k0c = {k01[0], k01[1]}, k0d = {k01[2], k01[3]};
        const f32x2 k1a = {k10[0], k10[1]}, k1b = {k10[2], k10[3]}, k1c = {k11[0], k11[1]}, k1d = {k11[2], k11[3]};
        const f32x2 q0a = {q00[0], q00[1]}, q0b = {q00[2], q00[3]}, q0c = {q01[0], q01[1]}, q0d = {q01[2], q01[3]};
        const f32x2 q1a = {q10[0], q10[1]}, q1b = {q10[2], q10[3]}, q1c = {q11[0], q11[1]}, q1d = {q11[2], q11[3]};
        const f32x2 t0 = (k0a * S2[0] + k0b * S2[1]) + (k0c * S2[2] + k0d * S2[3]);
        const f32x2 t1 = (k1a * S2[0] + k1b * S2[1]) + (k1c * S2[2] + k1d * S2[3]);
        const f32x2 t2 = (q0a * S2[0] + q0b * S2[1]) + (q0c * S2[2] + q0d * S2[3]);
        const f32x2 t3 = (q1a * S2[0] + q1b * S2[1]) + (q1c * S2[2] + q1d * S2[3]);
        const float kS0 = rowsum16(t0[0] + t0[1]), kS1 = rowsum16(t1[0] + t1[1]), qS0 = rowsum16(t2[0] + t2[1]), qS1 = rowsum16(t3[0] + t3[1]);
        const float a0 = abv[0], b0 = abv[1], a1 = abv[2], b1 = abv[3];
        const float c0 = b0 * (v0 - a0 * kS0);
        const float d1 = a0 * kS1 + gr[0] * c0;
        const float c1 = b1 * (v1 - a1 * d1);
        const float o0 = a0 * qS0 + gr[1] * c0;
        const float o1 = a1 * (a0 * qS1 + gr[2] * c0) + gr[3] * c1;
        const float aa = a1 * a0, e0 = a1 * c0;
        const f32x2 aav = {aa, aa}, e0v = {e0, e0}, c1v = {c1, c1};
        S2[0] = (aav * S2[0] + k0a * e0v) + k1a * c1v; S2[1] = (aav * S2[1] + k0b * e0v) + k1b * c1v;
        S2[2] = (aav * S2[2] + k0c * e0v) + k1c * c1v; S2[3] = (aav * S2[3] + k0d * e0v) + k1d * c1v;
        osel = (kg == 2 * pp) ? o0 : osel;
        osel = (kg == 2 * pp + 1) ? o1 : osel;
      }
    } else {
      f32x4 nk0 = *(const f32x4*)(kq + kg * 4), nk1 = *(const f32x4*)(kq + 64 + kg * 4), nq0 = *(const f32x4*)(kq + 128 + kg * 4), nq1 = *(const f32x4*)(kq + 192 + kg * 4);
      float nv = vv[w * 4 + ci];
#pragma unroll
      for (int st = 0; st < 16; ++st) {
        const f32x4 k0 = nk0, k1 = nk1, q0 = nq0, q1 = nq1;
        const float v = nv;
        if (st + 1 < 16) {
          nk0 = *(const f32x4*)(kq + (st + 1) * 256 + kg * 4); nk1 = *(const f32x4*)(kq + (st + 1) * 256 + 64 + kg * 4);
          nq0 = *(const f32x4*)(kq + (st + 1) * 256 + 128 + kg * 4); nq1 = *(const f32x4*)(kq + (st + 1) * 256 + 192 + kg * 4);
          nv = vv[(st + 1) * 16 + w * 4 + ci];
        }
        __builtin_amdgcn_sched_barrier(0);
        const f32x2 ka = {k0[0], k0[1]}, kb = {k0[2], k0[3]}, kc = {k1[0], k1[1]}, kd = {k1[2], k1[3]};
        const f32x2 qa = {q0[0], q0[1]}, qb = {q0[2], q0[3]}, qc = {q1[0], q1[1]}, qd = {q1[2], q1[3]};
        const f32x2 v2 = {v, v};
        S2[0] = S2[0] + ka * (v2 - S2[0]); S2[1] = S2[1] + kb * (v2 - S2[1]); S2[2] = S2[2] + kc * (v2 - S2[2]); S2[3] = S2[3] + kd * (v2 - S2[3]);
        const f32x2 u = (qa * S2[0] + qb * S2[1]) + (qc * S2[2] + qd * S2[3]);
        const float o = rowsum16(u[0] + u[1]);
        osel = (kg == st) ? o : osel;
      }
    }
    O[(size_t)(rowbase(bt * 16) + sg * kg) * 512] = f2bf(osel);
    if (BR == 0 && bt + 1 < NBT) gram(lds + i1 * BUF);
    __syncthreads();
    ic = i1;
  }
}

DEV void attn_task(const P& p, int b, int h, int r0, int kx_begin, int nkt, char* lds) {
  char* U = p.ws + OFF_U;
  const bf16_t *MQ = (const bf16_t*)(U + U_MQ), *MKN = (const bf16_t*)(U + U_MKN), *MKR = (const bf16_t*)(U + U_MKR), *MVT = (const bf16_t*)(U + U_MVT);
  bf16_t* YB = (bf16_t*)(p.ws + OFF_YB);
  const int tid = TIDX(), lane = tid & 63, w = tid >> 6, h2 = lane >> 5, l31 = lane & 31;
  const int qrow = r0 + w * 32 + l31;
  bf16x8 qf[12];
#pragma unroll
  for (int s = 0; s < 12; ++s) qf[s] = *(const bf16x8*)(MQ + (size_t)qrow * 768 + h * 192 + s * 16 + h2 * 8);
  f32x16 oacc[4];
#pragma unroll
  for (int d = 0; d < 4; ++d)
#pragma unroll
    for (int i = 0; i < 16; ++i) oacc[d][i] = 0.f;
  float m = -1e30f, lsum = 0.f;
  char* Kl = lds;
  char* Vl = lds + 64 * 384;
  const int pi = (l31 & 19) | ((l31 & 4) << 1) | ((l31 & 8) >> 1);
  const bf16_t* vbase = MVT + (size_t)(b * 4 + h) * 128 * KSP;
  for (int kt = 0; kt < nkt; ++kt) {
    const int kx0 = kx_begin + kt * 64;
    const int rb = kx0 < 8192 ? b * 8192 + kx0 : TL + b * 256 + (kx0 - 8192);
    u32x4 kr[6], vr[4];
#pragma unroll
    for (int i = 0; i < 6; ++i) {
      const int c = tid + 256 * i, row = c / 24, ch = c % 24;
      kr[i] = ch < 16 ? *(const u32x4*)(MKN + (size_t)(rb + row) * 512 + h * 128 + ch * 8) : *(const u32x4*)(MKR + (size_t)(rb + row) * 64 + (ch - 16) * 8);
    }
#pragma unroll
    for (int i = 0; i < 4; ++i) {
      const int c = tid + 256 * i, row = c >> 3, ch = c & 7;
      vr[i] = *(const u32x4*)(vbase + (size_t)row * KSP + kx0 + ch * 8);
    }
    __syncthreads();
#pragma unroll
    for (int i = 0; i < 6; ++i) {
      const int c = tid + 256 * i, row = c / 24, ch = c % 24;
      *(u32x4*)(Kl + row * 384 + (((ch & 24) | ((ch ^ (row >> 1)) & 7)) << 4)) = kr[i];
    }
#pragma unroll
    for (int i = 0; i < 4; ++i) {
      const int c = tid + 256 * i, row = c >> 3, ch = c & 7;
      *(u32x4*)(Vl + swz(row, ch)) = vr[i];
    }
    __syncthreads();
    f32x16 sacc[2];
#pragma unroll
    for (int i = 0; i < 16; ++i) { sacc[0][i] = 0.f; sacc[1][i] = 0.f; }
#pragma unroll
    for (int s = 0; s < 12; ++s) {
      const int ch = s * 2 + h2;
#pragma unroll
      for (int kb = 0; kb < 2; ++kb) {
        const int row = kb * 32 + pi;
        const bf16x8 kf = *(const bf16x8*)(Kl + row * 384 + (((ch & 24) | ((ch ^ (row >> 1)) & 7)) << 4));
        sacc[kb] = __builtin_amdgcn_mfma_f32_32x32x16_bf16(kf, qf[s], sacc[kb], 0, 0, 0);
      }
      if (s & 1) __builtin_amdgcn_sched_barrier(0);
    }
    float mx = sacc[0][0];
#pragma unroll
    for (int i = 1; i < 16; ++i) mx = fmaxf(mx, sacc[0][i]);
#pragma unroll
    for (int i = 0; i < 16; ++i) mx = fmaxf(mx, sacc[1][i]);
    mx = fmaxf(mx, __shfl_xor(mx, 32));
    const float mn = fmaxf(m, mx);
    const float alpha = __builtin_amdgcn_exp2f(m - mn);
    m = mn;
    float ps = 0.f;
#pragma unroll
    for (int kb = 0; kb < 2; ++kb)
#pragma unroll
      for (int i = 0; i < 16; ++i) { const float e = __builtin_amdgcn_exp2f(sacc[kb][i] - mn); sacc[kb][i] = e; ps += e; }
    lsum = lsum * alpha + ps;
#pragma unroll
    for (int d = 0; d < 4; ++d) oacc[d] = oacc[d] * alpha;
    bf16x8 pf[4];
#pragma unroll
    for (int kb = 0; kb < 2; ++kb)
#pragma unroll
      for (int s2 = 0; s2 < 2; ++s2) {
        u32x4 pw = {pk2(sacc[kb][8 * s2 + 0], sacc[kb][8 * s2 + 1]), pk2(sacc[kb][8 * s2 + 2], sacc[kb][8 * s2 + 3]),
                    pk2(sacc[kb][8 * s2 + 4], sacc[kb][8 * s2 + 5]), pk2(sacc[kb][8 * s2 + 6], sacc[kb][8 * s2 + 7])};
        pf[kb * 2 + s2] = __builtin_bit_cast(bf16x8, pw);
      }
    __builtin_amdgcn_sched_barrier(0);
#pragma unroll
    for (int s = 0; s < 4; ++s) {
#pragma unroll
      for (int d = 0; d < 4; ++d) {
        const bf16x8 vf = *(const bf16x8*)(Vl + swz(d * 32 + l31, s * 2 + h2));
        oacc[d] = __builtin_amdgcn_mfma_f32_32x32x16_bf16(vf, pf[s], oacc[d], 0, 0, 0);
      }
      __builtin_amdgcn_sched_barrier(0);
    }
  }
  lsum += __shfl_xor(lsum, 32);
  const float inv = 1.f / lsum;
  bf16_t* dst = YB + (size_t)qrow * 512 + h * 128 + 4 * h2;
#pragma unroll
  for (int d = 0; d < 4; ++d)
#pragma unroll
    for (int q = 0; q < 4; ++q) st4bf(dst + d * 32 + 8 * q, oacc[d][q * 4] * inv, oacc[d][q * 4 + 1] * inv, oacc[d][q * 4 + 2] * inv, oacc[d][q * 4 + 3] * inv);
  __syncthreads();
}

DEV void mixer_item(const P& p, int it, char* lds) {
  if (it < 256) {
    const int br = it >> 7, rem = it & 127, cgp = rem & 7, dir = (rem >> 3) & 1, h = (rem >> 4) & 3, b = rem >> 6;
    if (br == 0) scan_task<0>(p, b, h, dir, cgp, lds); else scan_task<1>(p, b, h, dir, cgp, lds);
  } else {
    const int a = it - 256;
    if (a < 512) { const int qt = a & 63, h = (a >> 6) & 3, b = a >> 8; attn_task(p, b, h, b * 8192 + qt * 128, 0, 132, lds); }
    else { const int c = a - 512, qt = c & 1, h = (c >> 1) & 3, b = c >> 3; attn_task(p, b, h, TL + b * 256 + qt * 128, 8192, 4, lds); }
  }
}
DEV void mixer_phase(const P& p, int l, char* lds) {
  __shared__ int sh_task;
  unsigned* ctr = (unsigned*)(p.ws + OFF_BAR) + 3600 + l * 64;
  const int G = gridDim.x;
  for (int it = blockIdx.x; it < 256; it += G) mixer_item(p, it, lds);
  for (;;) {
    __syncthreads();
    if (TIDX() == 0) sh_task = (int)atomicAdd(ctr, 1u);
    __syncthreads();
    const int a = sh_task;
    if (a >= 528) break;
    mixer_item(p, 256 + a, lds);
  }
}

DEV void readout_phase(const P& p, int l) {
  char* U = p.ws + OFF_U;
  const bf16_t *OGF = (const bf16_t*)(U + U_OGF), *OGB = (const bf16_t*)(U + U_OGB), *OHF = (const bf16_t*)(U + U_OHF), *OHB = (const bf16_t*)(U + U_OHB);
  const bf16_t *GG = (const bf16_t*)(U + U_GG), *HG = (const bf16_t*)(U + U_HG);
  bf16_t *YA = (bf16_t*)(U + U_YA), *YC = (bf16_t*)(U + U_YC);
  const int lane = TIDX() & 63, wid = TIDX() >> 6;
  for (int r = blockIdx.x * 4 + wid; r < T; r += gridDim.x * 4) {
#pragma unroll
    for (int br = 0; br < 2; ++br) {
      const bf16_t* of = br ? OHF : OGF; const bf16_t* ob = br ? OHB : OGB; const bf16_t* gt = br ? HG : GG;
      const float* nw = (br ? p.hg_norm : p.gdn_norm) + l * 128 + (lane & 15) * 8;
      const size_t off = (size_t)r * 512 + lane * 8;
      const u32x4 a = *(const u32x4*)(of + off), b2 = *(const u32x4*)(ob + off), g = *(const u32x4*)(gt + off);
      float o[8]; float ss = 0.f;
#pragma unroll
      for (int i = 0; i < 4; ++i) { o[2 * i] = bflo(a[i]) + bflo(b2[i]); o[2 * i + 1] = bfhi(a[i]) + bfhi(b2[i]); }
#pragma unroll
      for (int i = 0; i < 8; ++i) ss += o[i] * o[i];
      ss = sum16(ss);
      const float rs = rsqrtf(ss * (1.f / 128.f) + EPS);
      float y[8];
#pragma unroll
      for (int i = 0; i < 8; ++i) { const float gv = (i & 1) ? bfhi(g[i >> 1]) : bflo(g[i >> 1]); y[i] = o[i] * rs * nw[i] * siluf_(gv); }
      u32x4 w = {pk2(y[0], y[1]), pk2(y[2], y[3]), pk2(y[4], y[5]), pk2(y[6], y[7])};
      *(u32x4*)((br ? YC : YA) + off) = w;
    }
  }
}

DEV void merge_gemm(const P& p, char* lds, int MT) {
  char* U = p.ws + OFF_U;
  const bf16_t* ARE = (const bf16_t*)(p.ws + OFF_A);
  const bf16_t* WG = (const bf16_t*)(p.ws + OFF_WT + WT_WG);
  const bf16_t* WBR = (const bf16_t*)(p.ws + OFF_WT + WT_WBR);
  bf16_t* M = (bf16_t*)(U + U_M);
  const int lane = TIDX() & 63, wid = TIDX() >> 6, wr = wid >> 1, wc = wid & 1, h2 = lane >> 5;
  constexpr int NT = 1024 / 128;
  for (int t = vblock(); t < MT * NT; t += gridDim.x) {
    int mt, nt; tile_map(t, MT, NT, mt, nt);
    f32x16 macc[2][2]; zero_acc<2>(macc);
#pragma unroll 1
    for (int j = 0; j < 3; ++j) {
      const bf16_t* Yj = j == 0 ? (const bf16_t*)(U + U_YA) : (j == 1 ? (const bf16_t*)(p.ws + OFF_YB) : (const bf16_t*)(U + U_YC));
      f32x16 ag[2][2]; zero_acc<2>(ag);
      gemm_core<128>(ARE + (size_t)mt * 128 * 1024, 1024, WG + ((size_t)j * 1024 + nt * 128) * 1024, 1024, 1024, ag, lds);
#pragma unroll
      for (int mi = 0; mi < 2; ++mi)
#pragma unroll
        for (int ni = 0; ni < 2; ++ni)
#pragma unroll
          for (int i = 0; i < 16; ++i) ag[mi][ni][i] = sigmoidf_(ag[mi][ni][i]);
      f32x16 ab[2][2]; zero_acc<2>(ab);
      gemm_core<128>(Yj + (size_t)mt * 128 * 512, 512, WBR + ((size_t)j * 1024 + nt * 128) * 512, 512, 512, ab, lds);
#pragma unroll
      for (int mi = 0; mi < 2; ++mi)
#pragma unroll
        for (int ni = 0; ni < 2; ++ni)
#pragma unroll
          for (int i = 0; i < 16; ++i) macc[mi][ni][i] += ag[mi][ni][i] * ab[mi][ni][i];
    }
#pragma unroll
    for (int mi = 0; mi < 2; ++mi) {
      const int row = mt * 128 + wr * 64 + mi * 32 + (lane & 31);
#pragma unroll
      for (int ni = 0; ni < 2; ++ni) {
        bf16_t* dst = M + (size_t)row * D + nt * 128 + wc * 64 + ni * 32 + 4 * h2;
#pragma unroll
        for (int q = 0; q < 4; ++q) st4bf(dst + 8 * q, macc[mi][ni][q * 4], macc[mi][ni][q * 4 + 1], macc[mi][ni][q * 4 + 2], macc[mi][ni][q * 4 + 3]);
      }
    }
  }
}

DEV void run_phase(const P& p, int ph, char* lds) {
  char* U = p.ws + OFF_U;
  bf16_t* Abuf = (bf16_t*)(p.ws + OFF_A);
  bf16_t* Y = (bf16_t*)(U + U_Y);
  if (ph == 0) { phase0(p, lds); return; }
  if (ph == 1) { phase0b(p); return; }
  if (ph == 2) { row_phase(p, false, 0, nullptr, 0, 0.f, 0, true, 0, 0, 0, Abuf); return; }
  const int l = (ph - 3) / 13, s = (ph - 3) % 13;
  const int MTall = T / 128, MTpost = (l == 1) ? TL / 128 : T / 128, rows_post = (l == 1) ? TL : T;
  switch (s) {
    case 0: ffn_gemm1(p, lds, MTall); break;
    case 1: gemm_f32out((const bf16_t*)(U + U_HFF), DFF, (const bf16_t*)(p.ws + OFF_WT + WT_WO), Y, lds, MTall); break;
    case 2: row_phase(p, true, l, Y, 2, 0.5f, 1, true, l, 2, 3, Abuf); conv_mixer(p, l, lds); break;
    case 3: win_gemm(p, l, lds); break;
    case 4: gdn_prep_rows(p, l); mla_prep_gemms(p, lds); break;
    case 5: mixer_phase(p, l, lds); break;
    case 6: readout_phase(p, l); break;
    case 7: merge_gemm(p, lds, MTpost); break;
    case 8: gemm_f32out((const bf16_t*)(U + U_M), 1024, (const bf16_t*)(p.ws + OFF_WT + WT_WOUT), Y, lds, MTpost); break;
    case 9: row_phase(p, true, l, Y, 5, 1.0f, 3, true, l, 4, 6, Abuf, rows_post); conv_ffn(p, l, 1, lds); break;
    case 10: ffn_gemm1(p, lds, MTpost); break;
    case 11: gemm_f32out((const bf16_t*)(U + U_HFF), DFF, (const bf16_t*)(p.ws + OFF_WT + WT_WO), Y, lds, MTpost); break;
    case 12:
      if (l == 0) { row_phase(p, true, 0, Y, 8, 0.5f, 5, true, 1, 0, 0, Abuf); conv_ffn(p, 1, 0, lds); }
      else row_phase(p, true, 1, Y, 8, 0.5f, 5, false, 0, 0, 0, Abuf, TL);
      break;
    default: break;
  }
}
constexpr int NPHASE = 3 + 2 * 13;

template <int PH>
DEV void run_all(const P& p, char* lds, const XcdBarrier& xb) {
  run_phase(p, PH, lds);
  if constexpr (PROBE_SCAN_ONLY != 0 && PH >= 3 && (PH - 3) % 13 == 5) { GRID_SYNC(); if (PROBE_SCAN_ONLY == 1) { if (blockIdx.x < 256) mixer_item(p, blockIdx.x, lds); } else { for (int a = (int)blockIdx.x - 256; a >= 0 && a < 528; a += gridDim.x - 256) mixer_item(p, 256 + a, lds); } }
  if constexpr (PROBE_DUP_S >= 0 && PH >= 3 && ((PH - 3) % 13 == PROBE_DUP_S || (PH - 3) % 13 == PROBE_DUP_S2)) { GRID_SYNC(); run_phase(p, PH, lds); }
  if constexpr (PH + 1 < NPHASE) { GRID_SYNC(); run_all<PH + 1>(p, lds, xb); }
}
#if COOP
__global__ void __launch_bounds__(256, 2) mega(P p) {
  __shared__ __attribute__((aligned(16))) char lds[65536];
  __shared__ uint4 xb_words;
  if (__builtin_amdgcn_workitem_id_x() == 0) xb_words = make_uint4(0u, 0u, 0u, 0u);
  __syncthreads();
  XcdBarrier xb = xcd_barrier_post((unsigned*)(p.ws + OFF_BAR), (volatile LAS unsigned*)&xb_words);
  if (p.ws == nullptr) cg::this_grid().sync();
  run_all<0>(p, lds, xb);
}
#else
template <int PH>
__global__ void __launch_bounds__(256, 2) mega(P p) {
  __shared__ __attribute__((aligned(16))) char lds[65536];
  run_phase(p, PH, lds);
}
template <int PH> void launch_all(const P& p, int grid, hipStream_t stream) {
  hipLaunchKernelGGL(mega<PH>, dim3(grid), dim3(256), 0, stream, p);
  if constexpr (PH + 1 < NPHASE) launch_all<PH + 1>(p, grid, stream);
}
#endif

extern "C" void kernel_launch(void* const* d_in, const int* in_sizes, int n_in, void* d_out, int out_size, void* d_ws, size_t ws_size, hipStream_t stream) {
  if (ws_size < WS_NEED) { fprintf(stderr, "workspace too small: %zu < %zu\n", ws_size, (size_t)WS_NEED); return; }
  P p{};
  const float** pp = (const float**)&p;
  for (int i = 0; i < 22; ++i) pp[i] = (const float*)d_in[i];
  p.out = (float*)d_out; p.ws = (char*)d_ws;
  static int grid_blocks = 0;
  if (!grid_blocks) {
    int dev = 0, cus = 0, per_cu = 0;
    (void)hipGetDevice(&dev);
    (void)hipDeviceGetAttribute(&cus, hipDeviceAttributeMultiprocessorCount, dev);
#if COOP
    (void)hipOccupancyMaxActiveBlocksPerMultiprocessor(&per_cu, mega, 256, 0);
#else
    per_cu = 2;
#endif
    if (per_cu > 2) per_cu = 2;
    if (per_cu < 1) per_cu = 1;
    grid_blocks = cus * per_cu;
  }
#if COOP
  (void)hipMemsetAsync((char*)d_ws + OFF_BAR, 0, BAR_BYTES, stream);
  void* args[] = {&p};
  hipError_t e = hipLaunchCooperativeKernel((void*)mega, dim3(grid_blocks), dim3(256), args, 0, stream);
  if (e != hipSuccess) fprintf(stderr, "cooperative launch failed: %s (grid %d)\n", hipGetErrorString(e), grid_blocks);
#else
  launch_all<0>(p, grid_blocks, stream);
#endif
}
```

```cpp
#include <hip/hip_runtime.h>
#include <hip/hip_cooperative_groups.h>
#include <cstdint>
#include <cstdio>
namespace cg = cooperative_groups;

typedef unsigned short bf16_t;
typedef short bf16x8 __attribute__((ext_vector_type(8)));
typedef float f32x16 __attribute__((ext_vector_type(16)));
typedef float f32x4 __attribute__((ext_vector_type(4)));
typedef float f32x2 __attribute__((ext_vector_type(2)));
typedef unsigned u32x4 __attribute__((ext_vector_type(4)));
typedef unsigned u32x2 __attribute__((ext_vector_type(2)));
#define DEV __device__ __forceinline__

#ifndef COOP
#define COOP 1
#endif
#ifndef PROBE_SCAN_ONLY
#define PROBE_SCAN_ONLY 0
#endif
#ifndef PROBE_DUP_S
#define PROBE_DUP_S -1
#define PROBE_DUP_S2 -1
#endif

constexpr int T = 16896, TL = 16384, NLAT = 8192, NCTX = 256, D = 1024, DFF = 2816;
constexpr int KSP = 8448;
constexpr float EPS = 1e-6f;
constexpr int WIN_LD = 8400;
constexpr int NWIN = 5504;

constexpr size_t SZ(size_t cols, size_t b) { return (size_t)T * cols * b; }
constexpr size_t OFF_BAR = 0, BAR_BYTES = 16384;
constexpr size_t OFF_MODP = BAR_BYTES;
constexpr size_t OFF_MOD  = OFF_MODP + 4ull * 2 * 3 * 9216 * 4;
constexpr size_t OFF_HCTX = OFF_MOD + 2ull * 3 * 9216 * 4;
constexpr size_t OFF_WT   = OFF_HCTX + 512ull * 1024 * 4;
constexpr size_t WT_BYTES = 24ull << 20;
constexpr size_t OFF_A    = OFF_WT + WT_BYTES;
constexpr size_t OFF_U    = OFF_A + SZ(1024, 2);
constexpr size_t U_GQR  = 0;
constexpr size_t U_MQA  = U_GQR + SZ(1536, 2);
constexpr size_t U_MKVA = U_MQA + SZ(384, 2);
constexpr size_t U_GG   = U_MKVA + SZ(256, 2);
constexpr size_t U_GAB  = U_GG + SZ(512, 2);
constexpr size_t U_MKR  = U_GAB + SZ(16, 4);
constexpr size_t U_HQ   = U_MKR + SZ(64, 2);
constexpr size_t U_HK   = U_HQ + SZ(512, 2);
constexpr size_t U_HI   = U_HK + SZ(1024, 2);
constexpr size_t U_HG   = U_HI + SZ(512, 2);
constexpr size_t U_GQ2  = U_HG + SZ(512, 2);
constexpr size_t U_MQ   = U_GQ2 + SZ(1536, 2);
constexpr size_t U_MKN  = U_MQ + SZ(768, 2);
constexpr size_t U_MVT  = U_MKN + SZ(512, 2);
constexpr size_t U_END  = U_MVT + SZ(512, 2);
constexpr size_t U_OGF = U_GQR, U_OGB = U_GQR + SZ(512, 2), U_OHF = U_GQR + SZ(1024, 2), U_OHB = U_MQA;
constexpr size_t OFF_YB = OFF_U + U_END;
constexpr size_t U_ARE = U_HK, U_YA = U_GQ2, U_YC = U_GQ2 + SZ(512, 2), U_M = U_MQ;
constexpr size_t U_HFF = 0;
constexpr size_t U_Y   = SZ(2816, 2);
constexpr size_t WS_NEED = OFF_YB + SZ(512, 2);
static_assert(U_Y + SZ(1024, 4) <= U_M, "Y overlaps M");
constexpr size_t WT_WI = 0, WT_WO = 5632ull * 1024 * 2;
constexpr size_t WT_WIN = 0, WT_WG = (size_t)NWIN * 1024 * 2, WT_WQB = WT_WG + 3072ull * 1024 * 2, WT_WKVB = WT_WQB + 768ull * 384 * 2,
                 WT_WBR = WT_WKVB + 1024ull * 256 * 2, WT_WOUT = WT_WBR + 3ull * 1024 * 512 * 2, WT_MIX_END = WT_WOUT + 1024ull * 1024 * 2;
static_assert(WT_MIX_END <= WT_BYTES, "WT too small");
static_assert(WT_WO + 1024ull * 2816 * 2 <= WT_BYTES, "WT too small");

struct P {
  const float *x, *c, *ctx, *c_ctx, *w_ada, *b_ada, *norm_w, *ffn_w_in, *ffn_w_out, *w_in, *gdn_conv, *gdn_a_log, *gdn_dt_bias, *gdn_norm,
      *mla_q_norm, *mla_kv_norm, *mla_w_q_b, *mla_w_kv_b, *hg_lb, *hg_norm, *w_branch, *w_out;
  float* out; char* ws;
};

DEV unsigned pk2(float lo, float hi) {
  typedef __bf16 bf2 __attribute__((ext_vector_type(2)));
  f32x2 v = {lo, hi};
  bf2 b = __builtin_convertvector(v, bf2);
  return __builtin_bit_cast(unsigned, b);
}
DEV bf16_t f2bf(float x) { return (bf16_t)(pk2(x, 0.f) & 0xffffu); }
DEV float bflo(unsigned w) { return __uint_as_float(w << 16); }
DEV float bfhi(unsigned w) { return __uint_as_float(w & 0xffff0000u); }
DEV float bf2f(bf16_t h) { return __uint_as_float((unsigned)h << 16); }
DEV void st4bf(bf16_t* dst, float a, float b, float c, float d) { u32x2 w = {pk2(a, b), pk2(c, d)}; *(u32x2*)dst = w; }
DEV float sigmoidf_(float x) { return 1.f / (1.f + __expf(-x)); }
DEV float siluf_(float x) { return x / (1.f + __expf(-x)); }
DEV float wave_sum(float v) {
#pragma unroll
  for (int o = 32; o > 0; o >>= 1) v += __shfl_xor(v, o);
  return v;
}
DEV float sum16(float v) {
#pragma unroll
  for (int o = 8; o > 0; o >>= 1) v += __shfl_xor(v, o);
  return v;
}
DEV float rowsum16(float x) {
  x += __int_as_float(__builtin_amdgcn_update_dpp(0, __float_as_int(x), 0xB1, 0xf, 0xf, true));
  x += __int_as_float(__builtin_amdgcn_update_dpp(0, __float_as_int(x), 0x4E, 0xf, 0xf, true));
  x += __int_as_float(__builtin_amdgcn_update_dpp(0, __float_as_int(x), 0x141, 0xf, 0xf, true));
  x += __int_as_float(__builtin_amdgcn_update_dpp(0, __float_as_int(x), 0x140, 0xf, 0xf, true));
  return x;
}
DEV int TIDX() { int t = __builtin_amdgcn_workitem_id_x(); asm volatile("" : "+v"(t)); return t; }
DEV int sel_of(int r) { return r < TL ? (r >> 13) : 2; }
DEV int kx_of(int r) { return r < TL ? (r & 8191) : 8192 + ((r - TL) & 255); }
DEV int batch_of(int r) { return r < TL ? (r >> 13) : ((r - TL) >> 8); }
DEV int swz(int row, int ch) { return row * 128 + (((ch ^ (row >> 1)) & 7) << 4); }


DEV int vblock() { const int G = gridDim.x, j = blockIdx.x; return (G & 7) ? j : (j & 7) * (G >> 3) + (j >> 3); }
DEV void tile_map(int idx, int MT, int NT, int& mt, int& nt) {
  const int nig = 8 * NT, g = idx / nig, fm = g * 8, gsz = (MT - fm) < 8 ? (MT - fm) : 8, r = idx - g * nig;
  mt = fm + r % gsz; nt = r / gsz;
}


#define XB_TMO      128
#define XB_XCNT(j)  (256  + 64 * (j))
#define XB_XSUB(j)  (1280 + 64 * (j))
#define XB_XGEN(j)  (2304 + 64 * (j))
#define XB_TOP      3328
#define XB_TOPGEN   3392
#define XCD_BAR_WORDS 3456
#define XB_SPIN_CAP (1u << 22)
#define LAS __attribute__((address_space(3)))
static_assert(XCD_BAR_WORDS * 4 <= BAR_BYTES, "barrier words");
DEV unsigned xb_ld(unsigned* p) { return __hip_atomic_load(p, __ATOMIC_RELAXED, __HIP_MEMORY_SCOPE_AGENT); }
DEV unsigned xb_add(unsigned* p, unsigned v) { return __hip_atomic_fetch_add(p, v, __ATOMIC_RELAXED, __HIP_MEMORY_SCOPE_AGENT); }
DEV unsigned xb_xcc_id() { return (unsigned)__builtin_amdgcn_s_getreg((3 << 11) | 20) & 0xFu; }
#define XB_SPIN(cond, bar) do { unsigned _sp = 0; while (cond) { __builtin_amdgcn_s_sleep(1); \
    if ((++_sp & 255u) == 0u) { if (xb_ld(&(bar)[XB_TMO])) break; if (_sp > XB_SPIN_CAP) { atomicAdd(&(bar)[XB_TMO], 1u); break; } } } } while (0)
struct XcdBarrier { unsigned* bar; unsigned x; volatile LAS unsigned* st; };
DEV XcdBarrier xcd_barrier_post(unsigned* bar, volatile LAS unsigned* st) {
  XcdBarrier b; b.bar = bar; b.x = xb_xcc_id(); b.st = st;
  if (__builtin_amdgcn_workitem_id_x() == 0) (void)xb_add(&bar[XB_XCNT(b.x)], 1u);
  return b;
}
DEV void xcd_barrier_complete(unsigned* bar, unsigned x, unsigned& nloc, unsigned& nx) {
  const unsigned G = gridDim.x;
  unsigned sum, cnt, mine, sp = 0u;
  for (;;) {
    sum = 0u; cnt = 0u; mine = 0u;
#pragma unroll
    for (unsigned j = 0; j < 16; ++j) { const unsigned c = xb_ld(&bar[XB_XCNT(j)]); sum += c; cnt += (c > 0u) ? 1u : 0u; mine = (j == x) ? c : mine; }
    if (sum == G) break;
    __builtin_amdgcn_s_sleep(1);
    if ((++sp & 255u) == 0u) { if (xb_ld(&bar[XB_TMO])) break; if (sp > XB_SPIN_CAP) { atomicAdd(&bar[XB_TMO], 1u); break; } }
  }
  nloc = mine > 0u ? mine : 1u; nx = cnt > 0u ? cnt : 1u;
}
DEV void xcd_barrier(const XcdBarrier& b) {
  asm volatile("s_waitcnt vmcnt(0)" ::: "memory");
  __syncthreads();
  if (__builtin_amdgcn_workitem_id_x() == 0) {
    unsigned* bar = b.bar;
    __builtin_amdgcn_s_waitcnt(0);
    unsigned nloc = b.st[0], nx = b.st[1];
    if (nloc == 0u) { xcd_barrier_complete(bar, b.x, nloc, nx); b.st[0] = nloc; b.st[1] = nx; }
    const unsigned old = xb_add(&bar[XB_XSUB(b.x)], 1u);
    const unsigned gen = old / nloc;
    if (old + 1u == (gen + 1u) * nloc) {
      __builtin_amdgcn_fence(__ATOMIC_RELEASE, "agent");
      asm volatile("s_waitcnt vmcnt(0)" ::: "memory");
      const unsigned og = xb_add(&bar[XB_TOP], 1u);
      const unsigned tg = og / nx;
      if (og + 1u == (tg + 1u) * nx) xb_add(&bar[XB_TOPGEN], 1u);
      else XB_SPIN(xb_ld(&bar[XB_TOPGEN]) == tg, bar);
      __builtin_amdgcn_fence(__ATOMIC_ACQUIRE, "agent");
      xb_add(&bar[XB_XGEN(b.x)], 1u);
      asm volatile("s_waitcnt vmcnt(0)" ::: "memory");
    } else {
      XB_SPIN(xb_ld(&bar[XB_XGEN(b.x)]) == gen, bar);
      __builtin_amdgcn_fence(__ATOMIC_ACQUIRE, "agent");
      asm volatile("s_waitcnt vmcnt(0)" ::: "memory");
    }
  }
  __syncthreads();
}

#if COOP
#define GRID_SYNC() xcd_barrier(xb)
#else
#define GRID_SYNC()
#endif

template <int BN>
DEV void gemm_core_reg(const bf16_t* __restrict__ A, int lda, const bf16_t* __restrict__ B, int ldb, int K, f32x16 (&acc)[2][BN / 64], char* lds) {
  constexpr int NB = BN / 64, NBL = BN / 32;
  constexpr int A_BYTES = 128 * 128, ST = A_BYTES + BN * 128;
  const int tid = TIDX(), lane = tid & 63, wid = tid >> 6, wr = wid >> 1, wc = wid & 1;
  const int lrow = tid >> 3, lch = tid & 7;
  u32x4 ra[2][4], rb[2][NBL];
  const bf16_t* ap = A + (size_t)lrow * lda + lch * 8;
  const bf16_t* bp = B + (size_t)lrow * ldb + lch * 8;
  const int nk = K >> 6;
#define GC_LOAD(set, k0) do { _Pragma("unroll") for (int i = 0; i < 4; ++i) ra[set][i] = *(const u32x4*)(ap + (size_t)(32 * i) * lda + (k0)); \
    _Pragma("unroll") for (int i = 0; i < NBL; ++i) rb[set][i] = *(const u32x4*)(bp + (size_t)(32 * i) * ldb + (k0)); } while (0)
#define GC_STORE(stage, set) do { char* st_ = lds + (stage) * ST; _Pragma("unroll") for (int i = 0; i < 4; ++i) *(u32x4*)(st_ + swz(lrow + 32 * i, lch)) = ra[set][i]; \
    _Pragma("unroll") for (int i = 0; i < NBL; ++i) *(u32x4*)(st_ + A_BYTES + swz(lrow + 32 * i, lch)) = rb[set][i]; } while (0)
#define GC_COMPUTE(stage) do { const char* cur = lds + (stage) * ST; _Pragma("unroll") for (int ks = 0; ks < 4; ++ks) { const int ch = ks * 2 + (lane >> 5); bf16x8 af[2], bfr[NB]; \
    _Pragma("unroll") for (int mi = 0; mi < 2; ++mi) af[mi] = *(const bf16x8*)(cur + swz(wr * 64 + mi * 32 + (lane & 31), ch)); \
    _Pragma("unroll") for (int ni = 0; ni < NB; ++ni) bfr[ni] = *(const bf16x8*)(cur + A_BYTES + swz(wc * (BN / 2) + ni * 32 + (lane & 31), ch)); \
    _Pragma("unroll") for (int mi = 0; mi < 2; ++mi) _Pragma("unroll") for (int ni = 0; ni < NB; ++ni) acc[mi][ni] = __builtin_amdgcn_mfma_f32_32x32x16_bf16(bfr[ni], af[mi], acc[mi][ni], 0, 0, 0); } } while (0)
  GC_LOAD(0, 0);
  GC_STORE(0, 0);
  if (nk > 1) GC_LOAD(1, 64);
  __syncthreads();
  for (int kt = 0; kt < nk; kt += 2) {
    if (kt + 2 < nk) GC_LOAD(0, (kt + 2) * 64);
    __builtin_amdgcn_sched_barrier(0);
    GC_COMPUTE(0);
    __builtin_amdgcn_sched_barrier(0);
    if (kt + 1 < nk) GC_STORE(1, 1);
    __syncthreads();
    if (kt + 1 >= nk) break;
    if (kt + 3 < nk) GC_LOAD(1, (kt + 3) * 64);
    __builtin_amdgcn_sched_barrier(0);
    GC_COMPUTE(1);
    __builtin_amdgcn_sched_barrier(0);
    if (kt + 2 < nk) GC_STORE(0, 0);
    __syncthreads();
  }
#undef GC_LOAD
#undef GC_STORE
#undef GC_COMPUTE
}
#define LDSAS __attribute__((address_space(3)))
template <int N> DEV void wait_vmcnt() { asm volatile("s_waitcnt vmcnt(%0)" ::"n"(N) : "memory"); }
template <int BN>
DEV void gemm_core(const bf16_t* __restrict__ A, int lda, const bf16_t* __restrict__ B, int ldb, int K, f32x16 (&acc)[2][BN / 64], char* lds) {
  constexpr int NB = BN / 64, NPB = BN / 32;
  constexpr int NP = 4 + NPB;
  constexpr int A_BYTES = 128 * 128, ST = A_BYTES + BN * 128;
  const int tid = TIDX(), lane = tid & 63, wid = __builtin_amdgcn_readfirstlane(tid >> 6), wr = wid >> 1, wc = wid & 1;
  LDSAS char* l3 = (LDSAS char*)lds;
  unsigned offA[4], offB[NPB];
#pragma unroll
  for (int i = 0; i < 4; ++i) { const int row = (wid * 4 + i) * 8 + (lane >> 3); offA[i] = (unsigned)(row * lda + (((lane & 7) ^ ((row >> 1) & 7)) << 3)) * 2u; }
#pragma unroll
  for (int i = 0; i < NPB; ++i) { const int row = (wid * NPB + i) * 8 + (lane >> 3); offB[i] = (unsigned)(row * ldb + (((lane & 7) ^ ((row >> 1) & 7)) << 3)) * 2u; }
  const int nk = K >> 6;
#define GD_ISSUE(stage, kt_) do { const char* ga_ = (const char*)A + (size_t)(kt_) * 128; const char* gb_ = (const char*)B + (size_t)(kt_) * 128; \
    _Pragma("unroll") for (int i = 0; i < 4; ++i) __builtin_amdgcn_global_load_lds((const unsigned*)(ga_ + offA[i]), (LDSAS unsigned*)(l3 + (stage) * ST + (wid * 4 + i) * 1024), 16, 0, 0); \
    _Pragma("unroll") for (int i = 0; i < NPB; ++i) __builtin_amdgcn_global_load_lds((const unsigned*)(gb_ + offB[i]), (LDSAS unsigned*)(l3 + (stage) * ST + A_BYTES + (wid * NPB + i) * 1024), 16, 0, 0); } while (0)
  wait_vmcnt<0>();
  GD_ISSUE(0, 0);
  if (nk > 1) { GD_ISSUE(1, 1); wait_vmcnt<NP>(); } else wait_vmcnt<0>();
  __builtin_amdgcn_s_barrier(); asm volatile("" ::: "memory");
  for (int kt = 0; kt < nk; ++kt) {
    const char* cur = lds + (kt & 1) * ST;
#pragma unroll
    for (int ks = 0; ks < 4; ++ks) {
      const int ch = ks * 2 + (lane >> 5);
      bf16x8 af[2], bfr[NB];
#pragma unroll
      for (int mi = 0; mi < 2; ++mi) af[mi] = *(const bf16x8*)(cur + swz(wr * 64 + mi * 32 + (lane & 31), ch));
#pragma unroll
      for (int ni = 0; ni < NB; ++ni) bfr[ni] = *(const bf16x8*)(cur + A_BYTES + swz(wc * (BN / 2) + ni * 32 + (lane & 31), ch));
#pragma unroll
      for (int mi = 0; mi < 2; ++mi)
#pragma unroll
        for (int ni = 0; ni < NB; ++ni) acc[mi][ni] = __builtin_amdgcn_mfma_f32_32x32x16_bf16(bfr[ni], af[mi], acc[mi][ni], 0, 0, 0);
    }
    asm volatile("s_waitcnt lgkmcnt(0)" ::: "memory");
    __builtin_amdgcn_s_barrier(); asm volatile("" ::: "memory");
    if (kt + 2 < nk) { GD_ISSUE(kt & 1, kt + 2); wait_vmcnt<NP>(); }
    else wait_vmcnt<0>();
    __builtin_amdgcn_s_barrier(); asm volatile("" ::: "memory");
  }
#undef GD_ISSUE
}
template <int NB>
DEV void zero_acc(f32x16 (&acc)[2][NB]) {
#pragma unroll
  for (int a = 0; a < 2; ++a)
#pragma unroll
    for (int b = 0; b < NB; ++b)
#pragma unroll
      for (int i = 0; i < 16; ++i) acc[a][b][i] = 0.f;
}

struct Cv { const float* src; int ld; int K; int Np; int kind; const float* ks; bf16_t* dst; };
DEV int cv_map(int kind, int n) {
  if (kind == 0) return n;
  if (kind == 1) { const int g = n >> 6, r = n & 63; return r < 32 ? g * 32 + r : 2816 + g * 32 + (r - 32); }
  if (kind == 2) {
    if (n < 2064) return n;
    if (n < 2176) return -1;
    if (n < 2880) return 2064 + (n - 2176);
    if (n < 2944) return -1;
    return 2768 + (n - 2944);
  }
  return 5328 + n;
}
DEV void cv_run(const Cv c, char* lds) {
  float* tile = (float*)lds;
  const int tid = TIDX();
  const int nkt = c.K >> 6, ntile = nkt * (c.Np >> 6);
  for (int t = blockIdx.x; t < ntile; t += gridDim.x) {
    const int k0 = (t % nkt) * 64, n0 = (t / nkt) * 64;
    const int nn = tid & 63, src_n = cv_map(c.kind, n0 + nn);
#pragma unroll
    for (int i = 0; i < 16; ++i) {
      const int k = i * 4 + (tid >> 6);
      float v = 0.f;
      if (src_n >= 0) { v = c.src[(size_t)(k0 + k) * c.ld + src_n]; if (c.ks) v *= c.ks[k0 + k]; }
      tile[k * 65 + nn] = v;
    }
    __syncthreads();
#pragma unroll
    for (int i = 0; i < 16; ++i) {
      const int n = i * 4 + (tid >> 6), k = tid & 63;
      c.dst[(size_t)(n0 + n) * c.K + k0 + k] = f2bf(tile[k * 65 + n]);
    }
    __syncthreads();
  }
}
DEV void conv_ffn(const P& p, int l, int f, char* lds) {
  bf16_t* wt = (bf16_t*)(p.ws + OFF_WT);
  Cv a = {p.ffn_w_in + (size_t)(l * 2 + f) * 1024 * 5632, 5632, 1024, 5632, 1, nullptr, (bf16_t*)((char*)wt + WT_WI)};
  cv_run(a, lds);
  Cv b = {p.ffn_w_out + (size_t)(l * 2 + f) * 2816 * 1024, 1024, 2816, 1024, 0, nullptr, (bf16_t*)((char*)wt + WT_WO)};
  cv_run(b, lds);
}
DEV void conv_mixer(const P& p, int l, char* lds) {
  char* wt = p.ws + OFF_WT;
  const float* win = p.w_in + (size_t)l * 1024 * WIN_LD;
  Cv a = {win, WIN_LD, 1024, NWIN, 2, nullptr, (bf16_t*)(wt + WT_WIN)}; cv_run(a, lds);
  Cv b = {win, WIN_LD, 1024, 3072, 3, nullptr, (bf16_t*)(wt + WT_WG)}; cv_run(b, lds);
  Cv c = {p.mla_w_q_b + (size_t)l * 384 * 768, 768, 384, 768, 0, p.mla_q_norm + l * 384, (bf16_t*)(wt + WT_WQB)}; cv_run(c, lds);
  Cv d = {p.mla_w_kv_b + (size_t)l * 256 * 1024, 1024, 256, 1024, 0, p.mla_kv_norm + l * 256, (bf16_t*)(wt + WT_WKVB)}; cv_run(d, lds);
#pragma unroll 1
  for (int j = 0; j < 3; ++j) {
    Cv e = {p.w_branch + (size_t)(l * 3 + j) * 512 * 1024, 1024, 512, 1024, 0, nullptr, (bf16_t*)(wt + WT_WBR) + (size_t)j * 1024 * 512};
    cv_run(e, lds);
  }
  Cv f = {p.w_out + (size_t)l * 1024 * 1024, 1024, 1024, 1024, 0, nullptr, (bf16_t*)(wt + WT_WOUT)}; cv_run(f, lds);
}

DEV void phase0(const P& p, char* lds) {
  const int tid = TIDX();
  {
    const f32x4* s = (const f32x4*)p.x; f32x4* d = (f32x4*)p.out;
    const size_t n = (size_t)TL * D / 4;
    for (size_t i = (size_t)blockIdx.x * 256 + tid; i < n; i += (size_t)gridDim.x * 256) d[i] = s[i];
    const f32x4* s2 = (const f32x4*)p.ctx; f32x4* d2 = (f32x4*)(p.ws + OFF_HCTX);
    const size_t n2 = 512ull * D / 4;
    for (size_t i = (size_t)blockIdx.x * 256 + tid; i < n2; i += (size_t)gridDim.x * 256) d2[i] = s2[i];
  }
  {
    float* sv = (float*)lds;
    float* modp = (float*)(p.ws + OFF_MODP);
    for (int t = blockIdx.x; t < 2 * 36 * 4; t += gridDim.x) {
      const int ks = t & 3, cb = (t >> 2) % 36, l = t / 144;
      __syncthreads();
      {
        const int k = ks * 256 + tid;
        sv[tid] = siluf_(p.c[k]); sv[256 + tid] = siluf_(p.c[1024 + k]); sv[512 + tid] = siluf_(p.c_ctx[k]);
      }
      __syncthreads();
      const int col = cb * 256 + tid;
      const float* w = p.w_ada + ((size_t)l * 1024 + ks * 256) * 9216 + col;
      float a0 = 0.f, a1 = 0.f, a2 = 0.f;
#pragma unroll 8
      for (int k = 0; k < 256; ++k) { const float wv = w[(size_t)k * 9216]; a0 += sv[k] * wv; a1 += sv[256 + k] * wv; a2 += sv[512 + k] * wv; }
      float* o = modp + ((size_t)(ks * 2 + l) * 3) * 9216 + col;
      o[0] = a0; o[9216] = a1; o[2 * 9216] = a2;
    }
    __syncthreads();
  }
  conv_ffn(p, 0, 0, lds);
}
DEV void phase0b(const P& p) {
  const float* modp = (const float*)(p.ws + OFF_MODP);
  float* mod = (float*)(p.ws + OFF_MOD);
  for (int i = blockIdx.x * 256 + TIDX(); i < 2 * 3 * 9216; i += gridDim.x * 256) {
    const int col = i % 9216, l = i / (3 * 9216);
    float v = p.b_ada[l * 9216 + col];
#pragma unroll
    for (int ks = 0; ks < 4; ++ks) v += modp[(size_t)ks * 2 * 3 * 9216 + i];
    mod[i] = v;
  }
}

DEV void row_phase(const P& p, bool do_post, int l_post, const bf16_t* __restrict__ Y, int gate_idx, float gate_mul, int postw_idx,
                   bool do_pre, int l_pre, int prew_idx, int shift_idx, bf16_t* __restrict__ Aout, int nrows = T) {
  const float* mod = (const float*)(p.ws + OFF_MOD);
  float* hctx = (float*)(p.ws + OFF_HCTX);
  const int lane = TIDX() & 63, wid = TIDX() >> 6;
  const int stride = gridDim.x * 4;
  for (int r0 = blockIdx.x * 4 + wid; r0 < nrows; r0 += 2 * stride) {
    const bool two = r0 + stride < nrows;
    f32x4 h[2][4]; u32x2 yw[2][4];
#pragma unroll
    for (int k = 0; k < 2; ++k) {
      if (k == 1 && !two) break;
      const int r = r0 + k * stride;
      const float* hrow = r < TL ? p.out + (size_t)r * D : hctx + (size_t)(r - TL) * D;
#pragma unroll
      for (int i = 0; i < 4; ++i) h[k][i] = *(const f32x4*)(hrow + i * 256 + lane * 4);
      if (do_post) {
#pragma unroll
        for (int i = 0; i < 4; ++i) yw[k][i] = *(const u32x2*)(Y + (size_t)r * D + i * 256 + lane * 4);
      }
    }
#pragma unroll
    for (int k = 0; k < 2; ++k) {
      if (k == 1 && !two) break;
      const int r = r0 + k * stride;
      float* hrow = r < TL ? p.out + (size_t)r * D : hctx + (size_t)(r - TL) * D;
      const int sel = sel_of(r);
      if (do_post) {
        f32x4 y[4]; float ss = 0.f;
#pragma unroll
        for (int i = 0; i < 4; ++i) { y[i] = (f32x4){bflo(yw[k][i][0]), bfhi(yw[k][i][0]), bflo(yw[k][i][1]), bfhi(yw[k][i][1])}; ss += y[i][0] * y[i][0] + y[i][1] * y[i][1] + y[i][2] * y[i][2] + y[i][3] * y[i][3]; }
        ss = wave_sum(ss);
        const float rs = rsqrtf(ss * (1.f / 1024.f) + EPS);
        const float* pw = p.norm_w + (size_t)(l_post * 6 + postw_idx) * 1024;
        const float* gt = mod + ((size_t)(l_post * 3 + sel) * 9 + gate_idx) * 1024;
#pragma unroll
        for (int i = 0; i < 4; ++i) {
          const f32x4 w4 = *(const f32x4*)(pw + i * 256 + lane * 4), g4 = *(const f32x4*)(gt + i * 256 + lane * 4);
          h[k][i] += gate_mul * g4 * (y[i] * rs * w4);
          *(f32x4*)(hrow + i * 256 + lane * 4) = h[k][i];
        }
      }
      if (do_pre) {
        float ss = 0.f;
#pragma unroll
        for (int i = 0; i < 4; ++i) ss += h[k][i][0] * h[k][i][0] + h[k][i][1] * h[k][i][1] + h[k][i][2] * h[k][i][2] + h[k][i][3] * h[k][i][3];
        ss = wave_sum(ss);
        const float rs = rsqrtf(ss * (1.f / 1024.f) + EPS);
        const float* nw = p.norm_w + (size_t)(l_pre * 6 + prew_idx) * 1024;
        const float* sh = mod + ((size_t)(l_pre * 3 + sel) * 9 + shift_idx) * 1024;
        const float* sc = sh + 1024;
#pragma unroll
        for (int i = 0; i < 4; ++i) {
          const f32x4 w4 = *(const f32x4*)(nw + i * 256 + lane * 4), s4 = *(const f32x4*)(sh + i * 256 + lane * 4), c4 = *(const f32x4*)(sc + i * 256 + lane * 4);
          const f32x4 v = (h[k][i] * rs * w4) * (1.f + c4) + s4;
          st4bf(Aout + (size_t)r * D + i * 256 + lane * 4, v[0], v[1], v[2], v[3]);
        }
      }
    }
  }
}

DEV void ffn_gemm1(const P& p, char* lds, int MT) {
  const bf16_t* A = (const bf16_t*)(p.ws + OFF_A);
  const bf16_t* W = (const bf16_t*)(p.ws + OFF_WT + WT_WI);
  bf16_t* H = (bf16_t*)(p.ws + OFF_U + U_HFF);
  const int lane = TIDX() & 63, wid = TIDX() >> 6, wr = wid >> 1, wc = wid & 1, h2 = lane >> 5;
  constexpr int NT = 5632 / 128;
  for (int t = vblock(); t < MT * NT; t += gridDim.x) {
    int mt, nt; tile_map(t, MT, NT, mt, nt);
    f32x16 acc[2][2]; zero_acc<2>(acc);
    gemm_core<128>(A + (size_t)mt * 128 * 1024, 1024, W + (size_t)nt * 128 * 1024, 1024, 1024, acc, lds);
#pragma unroll
    for (int mi = 0; mi < 2; ++mi) {
      const int row = mt * 128 + wr * 64 + mi * 32 + (lane & 31);
      bf16_t* dst = H + (size_t)row * DFF + (nt * 2 + wc) * 32 + 4 * h2;
#pragma unroll
      for (int q = 0; q < 4; ++q) {
        float v[4];
#pragma unroll
        for (int j = 0; j < 4; ++j) v[j] = siluf_(acc[mi][0][q * 4 + j]) * acc[mi][1][q * 4 + j];
        st4bf(dst + 8 * q, v[0], v[1], v[2], v[3]);
      }
    }
  }
}
DEV void gemm_f32out(const bf16_t* A, int K, const bf16_t* W, bf16_t* Y, char* lds, int MT) {
  const int lane = TIDX() & 63, wid = TIDX() >> 6, wr = wid >> 1, wc = wid & 1, h2 = lane >> 5;
  constexpr int NT = 1024 / 128;
  for (int t = vblock(); t < MT * NT; t += gridDim.x) {
    int mt, nt; tile_map(t, MT, NT, mt, nt);
    f32x16 acc[2][2]; zero_acc<2>(acc);
    gemm_core<128>(A + (size_t)mt * 128 * K, K, W + (size_t)nt * 128 * K, K, K, acc, lds);
#pragma unroll
    for (int mi = 0; mi < 2; ++mi) {
      const int row = mt * 128 + wr * 64 + mi * 32 + (lane & 31);
#pragma unroll
      for (int ni = 0; ni < 2; ++ni) {
        bf16_t* dst = Y + (size_t)row * D + nt * 128 + wc * 64 + ni * 32 + 4 * h2;
#pragma unroll
        for (int q = 0; q < 4; ++q) st4bf(dst + 8 * q, acc[mi][ni][q * 4], acc[mi][ni][q * 4 + 1], acc[mi][ni][q * 4 + 2], acc[mi][ni][q * 4 + 3]);
      }
    }
  }
}

DEV void rope32(f32x16& v, int a, int r, int h2) {
  if (r >= TL) return;
  const int n = r & 8191;
  const float pos = (float)(a == 0 ? (n >> 6) : (n & 63));
#pragma unroll
  for (int reg = 0; reg < 8; ++reg) {
    const int f = (reg & 3) + 8 * (reg >> 2) + 4 * h2;
    const float inv = __builtin_amdgcn_exp2f(-(float)f * (13.287712379549449f / 16.f));
    const float ang = pos * inv;
    const float c = __cosf(ang), s = __sinf(ang);
    const float x1 = v[reg], x2 = v[reg + 8];
    v[reg] = x1 * c - x2 * s;
    v[reg + 8] = x2 * c + x1 * s;
  }
}

DEV void win_gemm(const P& p, int l, char* lds) {
  const bf16_t* A = (const bf16_t*)(p.ws + OFF_A);
  const bf16_t* W = (const bf16_t*)(p.ws + OFF_WT + WT_WIN);
  char* U = p.ws + OFF_U;
  bf16_t *GQR = (bf16_t*)(U + U_GQR), *GG = (bf16_t*)(U + U_GG), *MQA = (bf16_t*)(U + U_MQA), *MKVA = (bf16_t*)(U + U_MKVA), *MKR = (bf16_t*)(U + U_MKR),
         *HQ = (bf16_t*)(U + U_HQ), *HK = (bf16_t*)(U + U_HK), *HI = (bf16_t*)(U + U_HI), *HG = (bf16_t*)(U + U_HG);
  float* GAB = (float*)(U + U_GAB);
  const int lane = TIDX() & 63, wid = TIDX() >> 6, wr = wid >> 1, wc = wid & 1, h2 = lane >> 5;
  constexpr int MT = T / 128, NT = NWIN / 128;
  for (int t = vblock(); t < MT * NT; t += gridDim.x) {
    int mt, nt; tile_map(t, MT, NT, mt, nt);
    f32x16 acc[2][2]; zero_acc<2>(acc);
    gemm_core<128>(A + (size_t)mt * 128 * 1024, 1024, W + (size_t)nt * 128 * 1024, 1024, 1024, acc, lds);
#pragma unroll
    for (int ni = 0; ni < 2; ++ni) {
      const int nb = nt * 128 + wc * 64 + ni * 32;
#pragma unroll
      for (int mi = 0; mi < 2; ++mi) {
        const int row = mt * 128 + wr * 64 + mi * 32 + (lane & 31);
        f32x16 v = acc[mi][ni];
        bf16_t* dst = nullptr;
        if (nb < 1536) dst = GQR + (size_t)row * 1536 + nb;
        else if (nb < 2048) dst = GG + (size_t)row * 512 + (nb - 1536);
        else if (nb == 2048) {
#pragma unroll
          for (int reg = 0; reg < 16; ++reg) {
            const int c = (reg & 3) + 8 * (reg >> 2) + 4 * h2;
            if (c < 8) {
              const float al = p.gdn_a_log[l * 8 + c], dtb = p.gdn_dt_bias[l * 8 + c];
              const float xx = v[reg] + dtb;
              const float sp = xx > 20.f ? xx : log1pf(__expf(xx));
              GAB[(size_t)row * 16 + c] = -__expf(al) * sp;
            } else if (c < 16) {
              GAB[(size_t)row * 16 + c] = sigmoidf_(v[reg]);
            }
          }
        }
        else if (nb < 2176) {}
        else if (nb < 2560) dst = MQA + (size_t)row * 384 + (nb - 2176);
        else if (nb < 2816) dst = MKVA + (size_t)row * 256 + (nb - 2560);
        else if (nb < 2880) { rope32(v, (nb - 2816) >> 5, row, h2); dst = MKR + (size_t)row * 64 + (nb - 2816); }
        else if (nb < 2944) {}
        else if (nb < 3456) { v = v * 0.08838834764831845f; dst = HQ + (size_t)row * 512 + (nb - 2944); }
        else if (nb < 4480) {
          const int cb = nb - 3456;
#pragma unroll
          for (int reg = 0; reg < 16; ++reg) {
            const int c = cb + (reg & 3) + 8 * (reg >> 2) + 4 * h2;
            float lb = 0.f;
            if (l == 1) lb = sigmoidf_(p.hg_lb[1024 + c] - p.hg_lb[c]);
            v[reg] = (1.f - lb) * sigmoidf_(-v[reg]);
          }
          dst = HK + (size_t)row * 1024 + cb;
        }
        else if (nb < 4992) dst = HI + (size_t)row * 512 + (nb - 4480);
        else dst = HG + (size_t)row * 512 + (nb - 4992);
        if (dst) {
          dst += 4 * h2;
#pragma unroll
          for (int q = 0; q < 4; ++q) st4bf(dst + 8 * q, v[q * 4], v[q * 4 + 1], v[q * 4 + 2], v[q * 4 + 3]);
        }
      }
    }
  }
}

DEV void gdn_prep_rows(const P& p, int l) {
  char* U = p.ws + OFF_U;
  const bf16_t* GQR = (const bf16_t*)(U + U_GQR);
  bf16_t* GQ2 = (bf16_t*)(U + U_GQ2);
  const float* cw = p.gdn_conv + (size_t)l * 3 * 1536;
  const int lane = TIDX() & 63, wid = TIDX() >> 6;
  for (int r = blockIdx.x * 4 + wid; r < T; r += gridDim.x * 4) {
    bool hp, hn;
    if (r < TL) { const int n = r & 8191; hp = n > 0; hn = n < 8191; } else { const int tt = (r - TL) & 255; hp = tt > 0; hn = tt < 255; }
#pragma unroll
    for (int j = 0; j < 3; ++j) {
      const int c0 = j * 512 + lane * 8;
      const u32x4 z = {0u, 0u, 0u, 0u};
      const u32x4 xc = *(const u32x4*)(GQR + (size_t)r * 1536 + c0);
      const u32x4 xp = hp ? *(const u32x4*)(GQR + (size_t)(r - 1) * 1536 + c0) : z;
      const u32x4 xn = hn ? *(const u32x4*)(GQR + (size_t)(r + 1) * 1536 + c0) : z;
      float val[8]; float ss = 0.f;
#pragma unroll
      for (int i = 0; i < 8; ++i) {
        const unsigned wp = xp[i >> 1], wcur = xc[i >> 1], wn = xn[i >> 1];
        const float fp = (i & 1) ? bfhi(wp) : bflo(wp), fc = (i & 1) ? bfhi(wcur) : bflo(wcur), fn = (i & 1) ? bfhi(wn) : bflo(wn);
        const float s = fp * cw[c0 + i] + fc * cw[1536 + c0 + i] + fn * cw[3072 + c0 + i];
        val[i] = siluf_(s); ss += val[i] * val[i];
      }
      if (j < 2) {
        ss = sum16(ss);
        float sc = rsqrtf(ss + EPS);
        if (j == 0) sc *= 0.08838834764831845f;
#pragma unroll
        for (int i = 0; i < 8; ++i) val[i] *= sc;
      }
      u32x4 o = {pk2(val[0], val[1]), pk2(val[2], val[3]), pk2(val[4], val[5]), pk2(val[6], val[7])};
      *(u32x4*)(GQ2 + (size_t)r * 1536 + c0) = o;
    }
  }
}
DEV void row_scales(const bf16_t* A, int K, float* rs) {
  const int tid = TIDX(), row = tid >> 1, half = tid & 1;
  const bf16_t* a = A + (size_t)row * K + half * (K / 2);
  float ss = 0.f;
  for (int k = 0; k < K / 2; k += 8) {
    const u32x4 w = *(const u32x4*)(a + k);
#pragma unroll
    for (int i = 0; i < 4; ++i) { const float lo = bflo(w[i]), hi = bfhi(w[i]); ss += lo * lo + hi * hi; }
  }
  ss += __shfl_xor(ss, 1);
  if (half == 0) rs[row] = rsqrtf(ss / (float)K + EPS);
}
DEV void mla_prep_gemms(const P& p, char* lds) {
  char* U = p.ws + OFF_U;
  const bf16_t *MQA = (const bf16_t*)(U + U_MQA), *MKVA = (const bf16_t*)(U + U_MKVA);
  const bf16_t *WQ = (const bf16_t*)(p.ws + OFF_WT + WT_WQB), *WKV = (const bf16_t*)(p.ws + OFF_WT + WT_WKVB);
  bf16_t *MQ = (bf16_t*)(U + U_MQ), *MKN = (bf16_t*)(U + U_MKN), *MVT = (bf16_t*)(U + U_MVT);
  const int lane = TIDX() & 63, wid = TIDX() >> 6, wr = wid >> 1, wc = wid & 1, h2 = lane >> 5;
  constexpr int MT = T / 128;
  constexpr float QSCALE = 0.07216878364870322f * 1.4426950408889634f;
  for (int t = vblock(); t < MT * 14; t += gridDim.x) {
    int mt, nt; tile_map(t, MT, 14, mt, nt);
    const bool isq = nt < 6;
    const bf16_t* Ab = isq ? MQA + (size_t)mt * 128 * 384 : MKVA + (size_t)mt * 128 * 256;
    const int K = isq ? 384 : 256;
    float* rsl = (float*)lds;
    __syncthreads();
    row_scales(Ab, K, rsl);
    __syncthreads();
    float rsv[2];
#pragma unroll
    for (int mi = 0; mi < 2; ++mi) rsv[mi] = rsl[wr * 64 + mi * 32 + (lane & 31)];
    __syncthreads();
    f32x16 acc[2][2]; zero_acc<2>(acc);
    if (isq) gemm_core<128>(Ab, 384, WQ + (size_t)nt * 128 * 384, 384, 384, acc, lds);
    else gemm_core<128>(Ab, 256, WKV + (size_t)(nt - 6) * 128 * 256, 256, 256, acc, lds);
#pragma unroll
    for (int mi = 0; mi < 2; ++mi) {
      const int row = mt * 128 + wr * 64 + mi * 32 + (lane & 31);
#pragma unroll
      for (int ni = 0; ni < 2; ++ni) {
        f32x16 v = acc[mi][ni] * rsv[mi];
        if (isq) {
          const int nb = nt * 128 + wc * 64 + ni * 32, jb = nb % 192;
          if (jb >= 128) rope32(v, (jb - 128) >> 5, row, h2);
          v = v * QSCALE;
          bf16_t* dst = MQ + (size_t)row * 768 + nb + 4 * h2;
#pragma unroll
          for (int q = 0; q < 4; ++q) st4bf(dst + 8 * q, v[q * 4], v[q * 4 + 1], v[q * 4 + 2], v[q * 4 + 3]);
        } else {
          const int nb = (nt - 6) * 128 + wc * 64 + ni * 32, head = nb >> 8, jb = nb & 255;
          if (jb < 128) {
            bf16_t* dst = MKN + (size_t)row * 512 + head * 128 + jb + 4 * h2;
#pragma unroll
            for (int q = 0; q < 4; ++q) st4bf(dst + 8 * q, v[q * 4], v[q * 4 + 1], v[q * 4 + 2], v[q * 4 + 3]);
          } else {
            const int b = batch_of(row), kx = kx_of(row);
            bf16_t* dst = MVT + ((size_t)(b * 4 + head) * 128 + (jb - 128) + 4 * h2) * KSP + kx;
#pragma unroll
            for (int reg = 0; reg < 16; ++reg) dst[(size_t)((reg & 3) + 8 * (reg >> 2)) * KSP] = f2bf(v[reg]);
          }
        }
      }
    }
  }
}

template <int BR>
DEV void scan_task(const P& p, int b, int h, int dir, int cgp, char* lds) {
  char* U = p.ws + OFF_U;
  const int tid = TIDX(), lane = tid & 63, w = tid >> 6, kg = lane & 15, ci = lane >> 4;
  const bf16_t *Qs, *Ks, *Vs; int ldq, ldk, ldv;
  if (BR == 0) { const bf16_t* g = (const bf16_t*)(U + U_GQ2); Qs = g + h * 128; Ks = g + 512 + h * 128; Vs = g + 1024 + h * 128 + cgp * 16; ldq = ldk = ldv = 1536; }
  else { Qs = (const bf16_t*)(U + U_HQ) + h * 128; ldq = 512; Ks = (const bf16_t*)(U + U_HK) + dir * 512 + h * 128; ldk = 1024; Vs = (const bf16_t*)(U + U_HI) + h * 128 + cgp * 16; ldv = 512; }
  const float* AB = (const float*)(U + U_GAB);
  bf16_t* O = (bf16_t*)(U + (BR == 0 ? (dir ? U_OGB : U_OGF) : (dir ? U_OHB : U_OHF))) + h * 128 + cgp * 16 + w * 4 + ci;
  constexpr int BUF = 16384 + 1024 + 128 + 128;
  const int sg = 1 - 2 * dir;
  auto rowbase = [&](int s0) -> int {
    const int rb = s0 < 256 ? TL + b * 256 + (dir ? 255 - s0 : s0) : b * 8192 + (dir ? 8191 - (s0 - 256) : (s0 - 256));
    return __builtin_amdgcn_readfirstlane(rb);
  };
  f32x2 S2[4];
#pragma unroll
  for (int i = 0; i < 4; ++i) S2[i] = (f32x2){0.f, 0.f};
  u32x4 g0, g1; bf16_t gv; float gs = 0.f;
  const int st0 = tid >> 5, cc0 = tid & 31;
  auto gload = [&](int bt) {
    const int rb = rowbase(bt * 16);
    const int r0 = rb + sg * st0, r1 = rb + sg * (st0 + 8);
    g0 = cc0 < 16 ? *(const u32x4*)(Ks + (size_t)r0 * ldk + cc0 * 8) : *(const u32x4*)(Qs + (size_t)r0 * ldq + (cc0 - 16) * 8);
    g1 = cc0 < 16 ? *(const u32x4*)(Ks + (size_t)r1 * ldk + cc0 * 8) : *(const u32x4*)(Qs + (size_t)r1 * ldq + (cc0 - 16) * 8);
    gv = Vs[(size_t)(rb + sg * (tid >> 4)) * ldv + (tid & 15)];
    if (BR == 0 && tid < 32) {
      const int rr = rb + sg * (tid & 15);
      gs = AB[(size_t)rr * 16 + (tid < 16 ? 0 : 8) + dir * 4 + h];
    }
  };
  auto lwrite = [&](char* buf) {
    float* kq = (float*)buf;
    f32x4 a = {bflo(g0[0]), bfhi(g0[0]), bflo(g0[1]), bfhi(g0[1])}, bq = {bflo(g0[2]), bfhi(g0[2]), bflo(g0[3]), bfhi(g0[3])};
    *(f32x4*)(kq + st0 * 256 + cc0 * 8) = a; *(f32x4*)(kq + st0 * 256 + cc0 * 8 + 4) = bq;
    f32x4 c = {bflo(g1[0]), bfhi(g1[0]), bflo(g1[1]), bfhi(g1[1])}, d = {bflo(g1[2]), bfhi(g1[2]), bflo(g1[3]), bfhi(g1[3])};
    *(f32x4*)(kq + (st0 + 8) * 256 + cc0 * 8) = c; *(f32x4*)(kq + (st0 + 8) * 256 + cc0 * 8 + 4) = d;
    ((float*)(buf + 16384))[tid] = bf2f(gv);
    if (BR == 0 && tid < 32) ((float*)(buf + 16384 + 1024))[(tid & 15) * 2 + (tid >> 4)] = tid < 16 ? __expf(gs) : gs;
  };
  auto gram = [&](char* buf) {
    const float* kq = (const float*)buf;
    const int di = tid >> 3, sub = tid & 7, pp = di >> 2, wh = di & 3;
    const float* xv = kq + (2 * pp + (wh == 1 ? 0 : 1)) * 256 + (wh == 0 ? 0 : 128) + sub * 16;
    const float* yv = kq + (2 * pp + (wh == 3 ? 1 : 0)) * 256 + sub * 16;
    float acc = 0.f;
#pragma unroll
    for (int i = 0; i < 4; ++i) { const f32x4 x = *(const f32x4*)(xv + 4 * i), y = *(const f32x4*)(yv + 4 * i); acc += (x[0] * y[0] + x[1] * y[1]) + (x[2] * y[2] + x[3] * y[3]); }
    acc += __int_as_float(__builtin_amdgcn_update_dpp(0, __float_as_int(acc), 0xB1, 0xf, 0xf, true));
    acc += __int_as_float(__builtin_amdgcn_update_dpp(0, __float_as_int(acc), 0x4E, 0xf, 0xf, true));
    acc += __int_as_float(__builtin_amdgcn_update_dpp(0, __float_as_int(acc), 0x141, 0xf, 0xf, true));
    if (sub == 0) ((float*)(buf + 16384 + 1024 + 128))[di] = acc;
  };
  constexpr int NBT = KSP / 16;
  __syncthreads();
  gload(0); lwrite(lds);
  gload(1);
  __syncthreads();
  if (BR == 0) gram(lds);
  lwrite(lds + BUF);
  gload(2);
  __syncthreads();
  int ic = 0;
  for (int bt = 0; bt < NBT; ++bt) {
    char* cur = lds + ic * BUF;
    const int i1 = ic == 2 ? 0 : ic + 1, i2 = i1 == 2 ? 0 : i1 + 1;
    if (bt + 2 < NBT) lwrite(lds + i2 * BUF);
    if (bt + 3 < NBT) gload(bt + 3);
    const float* kq = (const float*)cur;
    const float* vv = (const float*)(cur + 16384);
    const float* ab = (const float*)(cur + 16384 + 1024);
    const float* gm = (const float*)(cur + 16384 + 1024 + 128);
    float osel = 0.f;
    if (BR == 0) {
      f32x4 nk00 = *(const f32x4*)(kq + kg * 4), nk01 = *(const f32x4*)(kq + 64 + kg * 4), nq00 = *(const f32x4*)(kq + 128 + kg * 4), nq01 = *(const f32x4*)(kq + 192 + kg * 4);
      f32x4 nk10 = *(const f32x4*)(kq + 256 + kg * 4), nk11 = *(const f32x4*)(kq + 320 + kg * 4), nq10 = *(const f32x4*)(kq + 384 + kg * 4), nq11 = *(const f32x4*)(kq + 448 + kg * 4);
      float nv0 = vv[w * 4 + ci], nv1 = vv[16 + w * 4 + ci];
      f32x4 nabv = *(const f32x4*)(ab), ngr = *(const f32x4*)(gm);
#pragma unroll
      for (int pp = 0; pp < 8; ++pp) {
        const f32x4 k00 = nk00, k01 = nk01, q00 = nq00, q01 = nq01, k10 = nk10, k11 = nk11, q10 = nq10, q11 = nq11;
        const float v0 = nv0, v1 = nv1;
        const f32x4 abv = nabv;
        const f32x4 gr = ngr;
        if (pp + 1 < 8) {
          const float* kq0 = kq + (2 * pp + 2) * 256; const float* kq1 = kq0 + 256;
          nk00 = *(const f32x4*)(kq0 + kg * 4); nk01 = *(const f32x4*)(kq0 + 64 + kg * 4); nq00 = *(const f32x4*)(kq0 + 128 + kg * 4); nq01 = *(const f32x4*)(kq0 + 192 + kg * 4);
          nk10 = *(const f32x4*)(kq1 + kg * 4); nk11 = *(const f32x4*)(kq1 + 64 + kg * 4); nq10 = *(const f32x4*)(kq1 + 128 + kg * 4); nq11 = *(const f32x4*)(kq1 + 192 + kg * 4);
          nv0 = vv[(2 * pp + 2) * 16 + w * 4 + ci]; nv1 = vv[(2 * pp + 3) * 16 + w * 4 + ci];
          nabv = *(const f32x4*)(ab + (pp + 1) * 4); ngr = *(const f32x4*)(gm + (pp + 1) * 4);
        }
        __builtin_amdgcn_sched_barrier(0);
        const f32x2 k0a = {k00[0], k00[1]}, k0b = {k00[2], k00[3]}, k0c = {k01[0], k01[1]}, k0d = {k01[2], k01[3]};
        const f32x2 k1a = {k10[0], k10[1]}, k1b = {k10[2], k10[3]}, k1c = {k11[0], k11[1]}, k1d = {k11[2], k11[3]};
        const f32x2 q0a = {q00[0], q00[1]}, q0b = {q00[2], q00[3]}, q0c = {q01[0], q01[1]}, q0d = {q01[2], q01[3]};
        const f32x2 q1a = {q10[0], q10[1]}, q1b = {q10[2], q10[3]}, q1c = {q11[0], q11[1]}, q1d = {q11[2], q11[3]};
        const f32x2 t0 = (k0a * S2[0] + k0b * S2[1]) + (k0c * S2[2] + k0d * S2[3]);
        const f32x2 t1 = (k1a * S2[0] + k1b * S2[1]) + (k1c * S2[2] + k1d * S2[3]);
        const f32x2 t2 = (q0a * S2[0] + q0b * S2[1]) + (q0c * S2[2] + q0d * S2[3]);
        const f32x2 t3 = (q1a * S2[0] + q1b * S2[1]) + (q1c * S2[2] + q1d * S2[3]);
        const float kS0 = rowsum16(t0[0] + t0[1]), kS1 = rowsum16(t1[0] + t1[1]), qS0 = rowsum16(t2[0] + t2[1]), qS1 = rowsum16(t3[0] + t3[1]);
        const float a0 = abv[0], b0 = abv[1], a1 = abv[2], b1 = abv[3];
        const float c0 = b0 * (v0 - a0 * kS0);
        const float d1 = a0 * kS1 + gr[0] * c0;
        const float c1 = b1 * (v1 - a1 * d1);
        const float o0 = a0 * qS0 + gr[1] * c0;
        const float o1 = a1 * (a0 * qS1 + gr[2] * c0) + gr[3] * c1;
        const float aa = a1 * a0, e0 = a1 * c0;
        const f32x2 aav = {aa, aa}, e0v = {e0, e0}, c1v = {c1, c1};
        S2[0] = (aav * S2[0] + k0a * e0v) + k1a * c1v; S2[1] = (aav * S2[1] + k0b * e0v) + k1b * c1v;
        S2[2] = (aav * S2[2] + k0c * e0v) + k1c * c1v; S2[3] = (aav * S2[3] + k0d * e0v) + k1d * c1v;
        osel = (kg == 2 * pp) ? o0 : osel;
        osel = (kg == 2 * pp + 1) ? o1 : osel;
      }
    } else {
      f32x4 nk0 = *(const f32x4*)(kq + kg * 4), nk1 = *(const f32x4*)(kq + 64 + kg * 4), nq0 = *(const f32x4*)(kq + 128 + kg * 4), nq1 = *(const f32x4*)(kq + 192 + kg * 4);
      float nv = vv[w * 4 + ci];
#pragma unroll
      for (int st = 0; st < 16; ++st) {
        const f32x4 k0 = nk0, k1 = nk1, q0 = nq0, q1 = nq1;
        const float v = nv;
        if (st + 1 < 16) {
          nk0 = *(const f32x4*)(kq + (st + 1) * 256 + kg * 4); nk1 = *(const f32x4*)(kq + (st + 1) * 256 + 64 + kg * 4);
          nq0 = *(const f32x4*)(kq + (st + 1) * 256 + 128 + kg * 4); nq1 = *(const f32x4*)(kq + (st + 1) * 256 + 192 + kg * 4);
          nv = vv[(st + 1) * 16 + w * 4 + ci];
        }
        __builtin_amdgcn_sched_barrier(0);
        const f32x2 ka = {k0[0], k0[1]}, kb = {k0[2], k0[3]}, kc = {k1[0], k1[1]}, kd = {k1[2], k1[3]};
        const f32x2 qa = {q0[0], q0[1]}, qb = {q0[2], q0[3]}, qc = {q1[0], q1[1]}, qd = {q1[2], q1[3]};
        const f32x2 v2 = {v, v};
        S2[0] = S2[0] + ka * (v2 - S2[0]); S2[1] = S2[1] + kb * (v2 - S2[1]); S2[2] = S2[2] + kc * (v2 - S2[2]); S2[3] = S2[3] + kd * (v2 - S2[3]);
        const f32x2 u = (qa * S2[0] + qb * S2[1]) + (qc * S2[2] + qd * S2[3]);
        const float o = rowsum16(u[0] + u[1]);
        osel = (kg == st) ? o : osel;
      }
    }
    O[(size_t)(rowbase(bt * 16) + sg * kg) * 512] = f2bf(osel);
    if (BR == 0 && bt + 1 < NBT) gram(lds + i1 * BUF);
    __syncthreads();
    ic = i1;
  }
}

DEV void attn_task(const P& p, int b, int h, int r0, int kx_begin, int nkt, char* lds) {
  char* U = p.ws + OFF_U;
  const bf16_t *MQ = (const bf16_t*)(U + U_MQ), *MKN = (const bf16_t*)(U + U_MKN), *MKR = (const bf16_t*)(U + U_MKR), *MVT = (const bf16_t*)(U + U_MVT);
  bf16_t* YB = (bf16_t*)(p.ws + OFF_YB);
  const int tid = TIDX(), lane = tid & 63, w = tid >> 6, h2 = lane >> 5, l31 = lane & 31;
  const int qrow = r0 + w * 32 + l31;
  bf16x8 qf[12];
#pragma unroll
  for (int s = 0; s < 12; ++s) qf[s] = *(const bf16x8*)(MQ + (size_t)qrow * 768 + h * 192 + s * 16 + h2 * 8);
  f32x16 oacc[4];
#pragma unroll
  for (int d = 0; d < 4; ++d)
#pragma unroll
    for (int i = 0; i < 16; ++i) oacc[d][i] = 0.f;
  float m = -1e30f, lsum = 0.f;
  char* Kl = lds;
  char* Vl = lds + 64 * 384;
  const int pi = (l31 & 19) | ((l31 & 4) << 1) | ((l31 & 8) >> 1);
  const bf16_t* vbase = MVT + (size_t)(b * 4 + h) * 128 * KSP;
  for (int kt = 0; kt < nkt; ++kt) {
    const int kx0 = kx_begin + kt * 64;
    const int rb = kx0 < 8192 ? b * 8192 + kx0 : TL + b * 256 + (kx0 - 8192);
    u32x4 kr[6], vr[4];
#pragma unroll
    for (int i = 0; i < 6; ++i) {
      const int c = tid + 256 * i, row = c / 24, ch = c % 24;
      kr[i] = ch < 16 ? *(const u32x4*)(MKN + (size_t)(rb + row) * 512 + h * 128 + ch * 8) : *(const u32x4*)(MKR + (size_t)(rb + row) * 64 + (ch - 16) * 8);
    }
#pragma unroll
    for (int i = 0; i < 4; ++i) {
      const int c = tid + 256 * i, row = c >> 3, ch = c & 7;
      vr[i] = *(const u32x4*)(vbase + (size_t)row * KSP + kx0 + ch * 8);
    }
    __syncthreads();
#pragma unroll
    for (int i = 0; i < 6; ++i) {
      const int c = tid + 256 * i, row = c / 24, ch = c % 24;
      *(u32x4*)(Kl + row * 384 + (((ch & 24) | ((ch ^ (row >> 1)) & 7)) << 4)) = kr[i];
    }
#pragma unroll
    for (int i = 0; i < 4; ++i) {
      const int c = tid + 256 * i, row = c >> 3, ch = c & 7;
      *(u32x4*)(Vl + swz(row, ch)) = vr[i];
    }
    __syncthreads();
    f32x16 sacc[2];
#pragma unroll
    for (int i = 0; i < 16; ++i) { sacc[0][i] = 0.f; sacc[1][i] = 0.f; }
#pragma unroll
    for (int s = 0; s < 12; ++s) {
      const int ch = s * 2 + h2;
#pragma unroll
      for (int kb = 0; kb < 2; ++kb) {
        const int row = kb * 32 + pi;
        const bf16x8 kf = *(const bf16x8*)(Kl + row * 384 + (((ch & 24) | ((ch ^ (row >> 1)) & 7)) << 4));
        sacc[kb] = __builtin_amdgcn_mfma_f32_32x32x16_bf16(kf, qf[s], sacc[kb], 0, 0, 0);
      }
      if (s & 1) __builtin_amdgcn_sched_barrier(0);
    }
    float mx = sacc[0][0];
#pragma unroll
    for (int i = 1; i < 16; ++i) mx = fmaxf(mx, sacc[0][i]);
#pragma unroll
    for (int i = 0; i < 16; ++i) mx = fmaxf(mx, sacc[1][i]);
    mx = fmaxf(mx, __shfl_xor(mx, 32));
    const float mn = fmaxf(m, mx);
    const float alpha = __builtin_amdgcn_exp2f(m - mn);
    m = mn;
    float ps = 0.f;
#pragma unroll
    for (int kb = 0; kb < 2; ++kb)
#pragma unroll
      for (int i = 0; i < 16; ++i) { const float e = __builtin_amdgcn_exp2f(sacc[kb][i] - mn); sacc[kb][i] = e; ps += e; }
    lsum = lsum * alpha + ps;
#pragma unroll
    for (int d = 0; d < 4; ++d) oacc[d] = oacc[d] * alpha;
    bf16x8 pf[4];
#pragma unroll
    for (int kb = 0; kb < 2; ++kb)
#pragma unroll
      for (int s2 = 0; s2 < 2; ++s2) {
        u32x4 pw = {pk2(sacc[kb][8 * s2 + 0], sacc[kb][8 * s2 + 1]), pk2(sacc[kb][8 * s2 + 2], sacc[kb][8 * s2 + 3]),
                    pk2(sacc[kb][8 * s2 + 4], sacc[kb][8 * s2 + 5]), pk2(sacc[kb][8 * s2 + 6], sacc[kb][8 * s2 + 7])};
        pf[kb * 2 + s2] = __builtin_bit_cast(bf16x8, pw);
      }
    __builtin_amdgcn_sched_barrier(0);
#pragma unroll
    for (int s = 0; s < 4; ++s) {
#pragma unroll
      for (int d = 0; d < 4; ++d) {
        const bf16x8 vf = *(const bf16x8*)(Vl + swz(d * 32 + l31, s * 2 + h2));
        oacc[d] = __builtin_amdgcn_mfma_f32_32x32x16_bf16(vf, pf[s], oacc[d], 0, 0, 0);
      }
      __builtin_amdgcn_sched_barrier(0);
    }
  }
  lsum += __shfl_xor(lsum, 32);
  const float inv = 1.f / lsum;
  bf16_t* dst = YB + (size_t)qrow * 512 + h * 128 + 4 * h2;
#pragma unroll
  for (int d = 0; d < 4; ++d)
#pragma unroll
    for (int q = 0; q < 4; ++q) st4bf(dst + d * 32 + 8 * q, oacc[d][q * 4] * inv, oacc[d][q * 4 + 1] * inv, oacc[d][q * 4 + 2] * inv, oacc[d][q * 4 + 3] * inv);
  __syncthreads();
}

DEV void mixer_item(const P& p, int it, char* lds) {
  if (it < 256) {
    const int br = it >> 7, rem = it & 127, cgp = rem & 7, dir = (rem >> 3) & 1, h = (rem >> 4) & 3, b = rem >> 6;
    if (br == 0) scan_task<0>(p, b, h, dir, cgp, lds); else scan_task<1>(p, b, h, dir, cgp, lds);
  } else {
    const int a = it - 256;
    if (a < 512) { const int qt = a & 63, h = (a >> 6) & 3, b = a >> 8; attn_task(p, b, h, b * 8192 + qt * 128, 0, 132, lds); }
    else { const int c = a - 512, qt = c & 1, h = (c >> 1) & 3, b = c >> 3; attn_task(p, b, h, TL + b * 256 + qt * 128, 8192, 4, lds); }
  }
}
DEV void mixer_phase(const P& p, int l, char* lds) {
  __shared__ int sh_task;
  unsigned* ctr = (unsigned*)(p.ws + OFF_BAR) + 3600 + l * 64;
  const int G = gridDim.x;
  for (int it = blockIdx.x; it < 256; it += G) mixer_item(p, it, lds);
  for (;;) {
    __syncthreads();
    if (TIDX() == 0) sh_task = (int)atomicAdd(ctr, 1u);
    __syncthreads();
    const int a = sh_task;
    if (a >= 528) break;
    mixer_item(p, 256 + a, lds);
  }
}

DEV void readout_phase(const P& p, int l) {
  char* U = p.ws + OFF_U;
  const bf16_t *OGF = (const bf16_t*)(U + U_OGF), *OGB = (const bf16_t*)(U + U_OGB), *OHF = (const bf16_t*)(U + U_OHF), *OHB = (const bf16_t*)(U + U_OHB);
  const bf16_t *GG = (const bf16_t*)(U + U_GG), *HG = (const bf16_t*)(U + U_HG);
  bf16_t *YA = (bf16_t*)(U + U_YA), *YC = (bf16_t*)(U + U_YC);
  const int lane = TIDX() & 63, wid = TIDX() >> 6;
  for (int r = blockIdx.x * 4 + wid; r < T; r += gridDim.x * 4) {
#pragma unroll
    for (int br = 0; br < 2; ++br) {
      const bf16_t* of = br ? OHF : OGF; const bf16_t* ob = br ? OHB : OGB; const bf16_t* gt = br ? HG : GG;
      const float* nw = (br ? p.hg_norm : p.gdn_norm) + l * 128 + (lane & 15) * 8;
      const size_t off = (size_t)r * 512 + lane * 8;
      const u32x4 a = *(const u32x4*)(of + off), b2 = *(const u32x4*)(ob + off), g = *(const u32x4*)(gt + off);
      float o[8]; float ss = 0.f;
#pragma unroll
      for (int i = 0; i < 4; ++i) { o[2 * i] = bflo(a[i]) + bflo(b2[i]); o[2 * i + 1] = bfhi(a[i]) + bfhi(b2[i]); }
#pragma unroll
      for (int i = 0; i < 8; ++i) ss += o[i] * o[i];
      ss = sum16(ss);
      const float rs = rsqrtf(ss * (1.f / 128.f) + EPS);
      float y[8];
#pragma unroll
      for (int i = 0; i < 8; ++i) { const float gv = (i & 1) ? bfhi(g[i >> 1]) : bflo(g[i >> 1]); y[i] = o[i] * rs * nw[i] * siluf_(gv); }
      u32x4 w = {pk2(y[0], y[1]), pk2(y[2], y[3]), pk2(y[4], y[5]), pk2(y[6], y[7])};
      *(u32x4*)((br ? YC : YA) + off) = w;
    }
  }
}

DEV void merge_gemm(const P& p, char* lds, int MT) {
  char* U = p.ws + OFF_U;
  const bf16_t* ARE = (const bf16_t*)(p.ws + OFF_A);
  const bf16_t* WG = (const bf16_t*)(p.ws + OFF_WT + WT_WG);
  const bf16_t* WBR = (const bf16_t*)(p.ws + OFF_WT + WT_WBR);
  bf16_t* M = (bf16_t*)(U + U_M);
  const int lane = TIDX() & 63, wid = TIDX() >> 6, wr = wid >> 1, wc = wid & 1, h2 = lane >> 5;
  constexpr int NT = 1024 / 128;
  for (int t = vblock(); t < MT * NT; t += gridDim.x) {
    int mt, nt; tile_map(t, MT, NT, mt, nt);
    f32x16 macc[2][2]; zero_acc<2>(macc);
#pragma unroll 1
    for (int j = 0; j < 3; ++j) {
      const bf16_t* Yj = j == 0 ? (const bf16_t*)(U + U_YA) : (j == 1 ? (const bf16_t*)(p.ws + OFF_YB) : (const bf16_t*)(U + U_YC));
      f32x16 ag[2][2]; zero_acc<2>(ag);
      gemm_core<128>(ARE + (size_t)mt * 128 * 1024, 1024, WG + ((size_t)j * 1024 + nt * 128) * 1024, 1024, 1024, ag, lds);
#pragma unroll
      for (int mi = 0; mi < 2; ++mi)
#pragma unroll
        for (int ni = 0; ni < 2; ++ni)
#pragma unroll
          for (int i = 0; i < 16; ++i) ag[mi][ni][i] = sigmoidf_(ag[mi][ni][i]);
      f32x16 ab[2][2]; zero_acc<2>(ab);
      gemm_core<128>(Yj + (size_t)mt * 128 * 512, 512, WBR + ((size_t)j * 1024 + nt * 128) * 512, 512, 512, ab, lds);
#pragma unroll
      for (int mi = 0; mi < 2; ++mi)
#pragma unroll
        for (int ni = 0; ni < 2; ++ni)
#pragma unroll
          for (int i = 0; i < 16; ++i) macc[mi][ni][i] += ag[mi][ni][i] * ab[mi][ni][i];
    }
#pragma unroll
    for (int mi = 0; mi < 2; ++mi) {
      const int row = mt * 128 + wr * 64 + mi * 32 + (lane & 31);
#pragma unroll
      for (int ni = 0; ni < 2; ++ni) {
        bf16_t* dst = M + (size_t)row * D + nt * 128 + wc * 64 + ni * 32 + 4 * h2;
#pragma unroll
        for (int q = 0; q < 4; ++q) st4bf(dst + 8 * q, macc[mi][ni][q * 4], macc[mi][ni][q * 4 + 1], macc[mi][ni][q * 4 + 2], macc[mi][ni][q * 4 + 3]);
      }
    }
  }
}

DEV void run_phase(const P& p, int ph, char* lds) {
  char* U = p.ws + OFF_U;
  bf16_t* Abuf = (bf16_t*)(p.ws + OFF_A);
  bf16_t* Y = (bf16_t*)(U + U_Y);
  if (ph == 0) { phase0(p, lds); return; }
  if (ph == 1) { phase0b(p); return; }
  if (ph == 2) { row_phase(p, false, 0, nullptr, 0, 0.f, 0, true, 0, 0, 0, Abuf); return; }
  const int l = (ph - 3) / 13, s = (ph - 3) % 13;
  const int MTall = T / 128, MTpost = (l == 1) ? TL / 128 : T / 128, rows_post = (l == 1) ? TL : T;
  switch (s) {
    case 0: ffn_gemm1(p, lds, MTall); break;
    case 1: gemm_f32out((const bf16_t*)(U + U_HFF), DFF, (const bf16_t*)(p.ws + OFF_WT + WT_WO), Y, lds, MTall); break;
    case 2: row_phase(p, true, l, Y, 2, 0.5f, 1, true, l, 2, 3, Abuf); conv_mixer(p, l, lds); break;
    case 3: win_gemm(p, l, lds); break;
    case 4: gdn_prep_rows(p, l); mla_prep_gemms(p, lds); break;
    case 5: mixer_phase(p, l, lds); break;
    case 6: readout_phase(p, l); break;
    case 7: merge_gemm(p, lds, MTpost); break;
    case 8: gemm_f32out((const bf16_t*)(U + U_M), 1024, (const bf16_t*)(p.ws + OFF_WT + WT_WOUT), Y, lds, MTpost); break;
    case 9: row_phase(p, true, l, Y, 5, 1.0f, 3, true, l, 4, 6, Abuf, rows_post); conv_ffn(p, l, 1, lds); break;
    case 10: ffn_gemm1(p, lds, MTpost); break;
    case 11: gemm_f32out((const bf16_t*)(U + U_HFF), DFF, (const bf16_t*)(p.ws + OFF_WT + WT_WO), Y, lds, MTpost); break;
    case 12:
      if (l == 0) { row_phase(p, true, 0, Y, 8, 0.5f, 5, true, 1, 0, 0, Abuf); conv_ffn(p, 1, 0, lds); }
      else row_phase(p, true, 1, Y, 8, 0.5f, 5, false, 0, 0, 0, Abuf, TL);
      break;
    default: break;
  }
}
constexpr int NPHASE = 3 + 2 * 13;

template <int PH>
DEV void run_all(const P& p, char* lds, const XcdBarrier& xb) {
  run_phase(p, PH, lds);
  if constexpr (PROBE_SCAN_ONLY != 0 && PH >= 3 && (PH - 3) % 13 == 5) { GRID_SYNC(); if (PROBE_SCAN_ONLY == 1) { if (blockIdx.x < 256) mixer_item(p, blockIdx.x, lds); } else { for (int a = (int)blockIdx.x - 256; a >= 0 && a < 528; a += gridDim.x - 256) mixer_item(p, 256 + a, lds); } }
  if constexpr (PROBE_DUP_S >= 0 && PH >= 3 && ((PH - 3) % 13 == PROBE_DUP_S || (PH - 3) % 13 == PROBE_DUP_S2)) { GRID_SYNC(); run_phase(p, PH, lds); }
  if constexpr (PH + 1 < NPHASE) { GRID_SYNC(); run_all<PH + 1>(p, lds, xb); }
}
#if COOP
__global__ void __launch_bounds__(256, 2) mega(P p) {
  __shared__ __attribute__((aligned(16))) char lds[65536];
  __shared__ uint4 xb_words;
  if (__builtin_amdgcn_workitem_id_x() == 0) xb_words = make_uint4(0u, 0u, 0u, 0u);
  __syncthreads();
  XcdBarrier xb = xcd_barrier_post((unsigned*)(p.ws + OFF_BAR), (volatile LAS unsigned*)&xb_words);
  if (p.ws == nullptr) cg::this_grid().sync();
  run_all<0>(p, lds, xb);
}
#else
template <int PH>
__global__ void __launch_bounds__(256, 2) mega(P p) {
  __shared__ __attribute__((aligned(16))) char lds[65536];
  run_phase(p, PH, lds);
}
template <int PH> void launch_all(const P& p, int grid, hipStream_t stream) {
  hipLaunchKernelGGL(mega<PH>, dim3(grid), dim3(256), 0, stream, p);
  if constexpr (PH + 1 < NPHASE) launch_all<PH + 1>(p, grid, stream);
}
#endif

extern "C" void kernel_launch(void* const* d_in, const int* in_sizes, int n_in, void* d_out, int out_size, void* d_ws, size_t ws_size, hipStream_t stream) {
  if (ws_size < WS_NEED) { fprintf(stderr, "workspace too small: %zu < %zu\n", ws_size, (size_t)WS_NEED); return; }
  P p{};
  const float** pp = (const float**)&p;
  for (int i = 0; i < 22; ++i) pp[i] = (const float*)d_in[i];
  p.out = (float*)d_out; p.ws = (char*)d_ws;
  static int grid_blocks = 0;
  if (!grid_blocks) {
    int dev = 0, cus = 0, per_cu = 0;
    (void)hipGetDevice(&dev);
    (void)hipDeviceGetAttribute(&cus, hipDeviceAttributeMultiprocessorCount, dev);
#if COOP
    (void)hipOccupancyMaxActiveBlocksPerMultiprocessor(&per_cu, mega, 256, 0);
#else
    per_cu = 2;
#endif
    if (per_cu > 2) per_cu = 2;
    if (per_cu < 1) per_cu = 1;
    grid_blocks = cus * per_cu;
  }
#if COOP
  (void)hipMemsetAsync((char*)d_ws + OFF_BAR, 0, BAR_BYTES, stream);
  void* args[] = {&p};
  hipError_t e = hipLaunchCooperativeKernel((void*)mega, dim3(grid_blocks), dim3(256), args, 0, stream);
  if (e != hipSuccess) fprintf(stderr, "cooperative launch failed: %s (grid %d)\n", hipGetErrorString(e), grid_blocks);
#else
  launch_all<0>(p, grid_blocks, stream);
#endif
}
```

```cpp
#include <hip/hip_runtime.h>
#include <hip/hip_cooperative_groups.h>
#include <cstdint>
#include <cstdio>
namespace cg = cooperative_groups;

typedef unsigned short bf16_t;
typedef short bf16x8 __attribute__((ext_vector_type(8)));
typedef float f32x16 __attribute__((ext_vector_type(16)));
typedef float f32x4 __attribute__((ext_vector_type(4)));
typedef float f32x2 __attribute__((ext_vector_type(2)));
typedef unsigned u32x4 __attribute__((ext_vector_type(4)));
typedef unsigned u32x2 __attribute__((ext_vector_type(2)));
#define DEV __device__ __forceinline__

#ifndef COOP
#define COOP 1
#endif
#ifndef PROBE_SCAN_ONLY
#define PROBE_SCAN_ONLY 0
#endif
#ifndef PROBE_DUP_S
#define PROBE_DUP_S -1
#define PROBE_DUP_S2 -1
#endif

constexpr int T = 16896, TL = 16384, NLAT = 8192, NCTX = 256, D = 1024, DFF = 2816;
constexpr int KSP = 8448;
constexpr float EPS = 1e-6f;
constexpr int WIN_LD = 8400;
constexpr int NWIN = 5504;

constexpr size_t SZ(size_t cols, size_t b) { return (size_t)T * cols * b; }
constexpr size_t OFF_BAR = 0, BAR_BYTES = 16384;
constexpr size_t OFF_MODP = BAR_BYTES;
constexpr size_t OFF_MOD  = OFF_MODP + 4ull * 2 * 3 * 9216 * 4;
constexpr size_t OFF_HCTX = OFF_MOD + 2ull * 3 * 9216 * 4;
constexpr size_t OFF_WT   = OFF_HCTX + 512ull * 1024 * 4;
constexpr size_t WT_BYTES = 24ull << 20;
constexpr size_t OFF_A    = OFF_WT + WT_BYTES;
constexpr size_t OFF_U    = OFF_A + SZ(1024, 2);
constexpr size_t U_GQR  = 0;
constexpr size_t U_MQA  = U_GQR + SZ(1536, 2);
constexpr size_t U_MKVA = U_MQA + SZ(384, 2);
constexpr size_t U_GG   = U_MKVA + SZ(256, 2);
constexpr size_t U_GAB  = U_GG + SZ(512, 2);
constexpr size_t U_MKR  = U_GAB + SZ(16, 4);
constexpr size_t U_HQ   = U_MKR + SZ(64, 2);
constexpr size_t U_HK   = U_HQ + SZ(512, 2);
constexpr size_t U_HI   = U_HK + SZ(1024, 2);
constexpr size_t U_HG   = U_HI + SZ(512, 2);
constexpr size_t U_GQ2  = U_HG + SZ(512, 2);
constexpr size_t U_MQ   = U_GQ2 + SZ(1536, 2);
constexpr size_t U_MKN  = U_MQ + SZ(768, 2);
constexpr size_t U_MVT  = U_MKN + SZ(512, 2);
constexpr size_t U_END  = U_MVT + SZ(512, 2);
constexpr size_t U_OGF = U_GQR, U_OGB = U_GQR + SZ(512, 2), U_OHF = U_GQR + SZ(1024, 2), U_OHB = U_MQA;
constexpr size_t OFF_YB = OFF_U + U_END;
constexpr size_t U_ARE = U_HK, U_YA = U_GQ2, U_YC = U_GQ2 + SZ(512, 2), U_M = U_MQ;
constexpr size_t U_HFF = 0;
constexpr size_t U_Y   = SZ(2816, 2);
constexpr size_t WS_NEED = OFF_YB + SZ(512, 2);
static_assert(U_Y + SZ(1024, 4) <= U_M, "Y overlaps M");
constexpr size_t WT_WI = 0, WT_WO = 5632ull * 1024 * 2;
constexpr size_t WT_WIN = 0, WT_WG = (size_t)NWIN * 1024 * 2, WT_WQB = WT_WG + 3072ull * 1024 * 2, WT_WKVB = WT_WQB + 768ull * 384 * 2,
                 WT_WBR = WT_WKVB + 1024ull * 256 * 2, WT_WOUT = WT_WBR + 3ull * 1024 * 512 * 2, WT_MIX_END = WT_WOUT + 1024ull * 1024 * 2;
static_assert(WT_MIX_END <= WT_BYTES, "WT too small");
static_assert(WT_WO + 1024ull * 2816 * 2 <= WT_BYTES, "WT too small");

struct P {
  const float *x, *c, *ctx, *c_ctx, *w_ada, *b_ada, *norm_w, *ffn_w_in, *ffn_w_out, *w_in, *gdn_conv, *gdn_a_log, *gdn_dt_bias, *gdn_norm,
      *mla_q_norm, *mla_kv_norm, *mla_w_q_b, *mla_w_kv_b, *hg_lb, *hg_norm, *w_branch, *w_out;
  float* out; char* ws;
};

DEV unsigned pk2(float lo, float hi) {
  typedef __bf16 bf2 __attribute__((ext_vector_type(2)));
  f32x2 v = {lo, hi};
  bf2 b = __builtin_convertvector(v, bf2);
  return __builtin_bit_cast(unsigned, b);
}
DEV bf16_t f2bf(float x) { return (bf16_t)(pk2(x, 0.f) & 0xffffu); }
DEV float bflo(unsigned w) { return __uint_as_float(w << 16); }
DEV float bfhi(unsigned w) { return __uint_as_float(w & 0xffff0000u); }
DEV float bf2f(bf16_t h) { return __uint_as_float((unsigned)h << 16); }
DEV void st4bf(bf16_t* dst, float a, float b, float c, float d) { u32x2 w = {pk2(a, b), pk2(c, d)}; *(u32x2*)dst = w; }
DEV float sigmoidf_(float x) { return 1.f / (1.f + __expf(-x)); }
DEV float siluf_(float x) { return x / (1.f + __expf(-x)); }
DEV float wave_sum(float v) {
#pragma unroll
  for (int o = 32; o > 0; o >>= 1) v += __shfl_xor(v, o);
  return v;
}
DEV float sum16(float v) {
#pragma unroll
  for (int o = 8; o > 0; o >>= 1) v += __shfl_xor(v, o);
  return v;
}
DEV float rowsum16(float x) {
  x += __int_as_float(__builtin_amdgcn_update_dpp(0, __float_as_int(x), 0xB1, 0xf, 0xf, true));
  x += __int_as_float(__builtin_amdgcn_update_dpp(0, __float_as_int(x), 0x4E, 0xf, 0xf, true));
  x += __int_as_float(__builtin_amdgcn_update_dpp(0, __float_as_int(x), 0x141, 0xf, 0xf, true));
  x += __int_as_float(__builtin_amdgcn_update_dpp(0, __float_as_int(x), 0x140, 0xf, 0xf, true));
  return x;
}
DEV int TIDX() { int t = __builtin_amdgcn_workitem_id_x(); asm volatile("" : "+v"(t)); return t; }
DEV int sel_of(int r) { return r < TL ? (r >> 13) : 2; }
DEV int kx_of(int r) { return r < TL ? (r & 8191) : 8192 + ((r - TL) & 255); }
DEV int batch_of(int r) { return r < TL ? (r >> 13) : ((r - TL) >> 8); }
DEV int swz(int row, int ch) { return row * 128 + (((ch ^ (row >> 1)) & 7) << 4); }


DEV int vblock() { const int G = gridDim.x, j = blockIdx.x; return (G & 7) ? j : (j & 7) * (G >> 3) + (j >> 3); }
DEV void tile_map(int idx, int MT, int NT, int& mt, int& nt) {
  const int nig = 8 * NT, g = idx / nig, fm = g * 8, gsz = (MT - fm) < 8 ? (MT - fm) : 8, r = idx - g * nig;
  mt = fm + r % gsz; nt = r / gsz;
}


#define XB_TMO      128
#define XB_XCNT(j)  (256  + 64 * (j))
#define XB_XSUB(j)  (1280 + 64 * (j))
#define XB_XGEN(j)  (2304 + 64 * (j))
#define XB_TOP      3328
#define XB_TOPGEN   3392
#define XCD_BAR_WORDS 3456
#define XB_SPIN_CAP (1u << 22)
#define LAS __attribute__((address_space(3)))
static_assert(XCD_BAR_WORDS * 4 <= BAR_BYTES, "barrier words");
DEV unsigned xb_ld(unsigned* p) { return __hip_atomic_load(p, __ATOMIC_RELAXED, __HIP_MEMORY_SCOPE_AGENT); }
DEV unsigned xb_add(unsigned* p, unsigned v) { return __hip_atomic_fetch_add(p, v, __ATOMIC_RELAXED, __HIP_MEMORY_SCOPE_AGENT); }
DEV unsigned xb_xcc_id() { return (unsigned)__builtin_amdgcn_s_getreg((3 << 11) | 20) & 0xFu; }
#define XB_SPIN(cond, bar) do { unsigned _sp = 0; while (cond) { __builtin_amdgcn_s_sleep(1); \
    if ((++_sp & 255u) == 0u) { if (xb_ld(&(bar)[XB_TMO])) break; if (_sp > XB_SPIN_CAP) { atomicAdd(&(bar)[XB_TMO], 1u); break; } } } } while (0)
struct XcdBarrier { unsigned* bar; unsigned x; volatile LAS unsigned* st; };
DEV XcdBarrier xcd_barrier_post(unsigned* bar, volatile LAS unsigned* st) {
  XcdBarrier b; b.bar = bar; b.x = xb_xcc_id(); b.st = st;
  if (__builtin_amdgcn_workitem_id_x() == 0) (void)xb_add(&bar[XB_XCNT(b.x)], 1u);
  return b;
}
DEV void xcd_barrier_complete(unsigned* bar, unsigned x, unsigned& nloc, unsigned& nx) {
  const unsigned G = gridDim.x;
  unsigned sum, cnt, mine, sp = 0u;
  for (;;) {
    sum = 0u; cnt = 0u; mine = 0u;
#pragma unroll
    for (unsigned j = 0; j < 16; ++j) { const unsigned c = xb_ld(&bar[XB_XCNT(j)]); sum += c; cnt += (c > 0u) ? 1u : 0u; mine = (j == x) ? c : mine; }
    if (sum == G) break;
    __builtin_amdgcn_s_sleep(1);
    if ((++sp & 255u) == 0u) { if (xb_ld(&bar[XB_TMO])) break; if (sp > XB_SPIN_CAP) { atomicAdd(&bar[XB_TMO], 1u); break; } }
  }
  nloc = mine > 0u ? mine : 1u; nx = cnt > 0u ? cnt : 1u;
}
DEV void xcd_barrier(const XcdBarrier& b) {
  asm volatile("s_waitcnt vmcnt(0)" ::: "memory");
  __syncthreads();
  if (__builtin_amdgcn_workitem_id_x() == 0) {
    unsigned* bar = b.bar;
    __builtin_amdgcn_s_waitcnt(0);
    unsigned nloc = b.st[0], nx = b.st[1];
    if (nloc == 0u) { xcd_barrier_complete(bar, b.x, nloc, nx); b.st[0] = nloc; b.st[1] = nx; }
    const unsigned old = xb_add(&bar[XB_XSUB(b.x)], 1u);
    const unsigned gen = old / nloc;
    if (old + 1u == (gen + 1u) * nloc) {
      __builtin_amdgcn_fence(__ATOMIC_RELEASE, "agent");
      asm volatile("s_waitcnt vmcnt(0)" ::: "memory");
      const unsigned og = xb_add(&bar[XB_TOP], 1u);
      const unsigned tg = og / nx;
      if (og + 1u == (tg + 1u) * nx) xb_add(&bar[XB_TOPGEN], 1u);
      else XB_SPIN(xb_ld(&bar[XB_TOPGEN]) == tg, bar);
      __builtin_amdgcn_fence(__ATOMIC_ACQUIRE, "agent");
      xb_add(&bar[XB_XGEN(b.x)], 1u);
      asm volatile("s_waitcnt vmcnt(0)" ::: "memory");
    } else {
      XB_SPIN(xb_ld(&bar[XB_XGEN(b.x)]) == gen, bar);
      __builtin_amdgcn_fence(__ATOMIC_ACQUIRE, "agent");
      asm volatile("s_waitcnt vmcnt(0)" ::: "memory");
    }
  }
  __syncthreads();
}

#if COOP
#define GRID_SYNC() xcd_barrier(xb)
#else
#define GRID_SYNC()
#endif

template <int BN>
DEV void gemm_core_reg(const bf16_t* __restrict__ A, int lda, const bf16_t* __restrict__ B, int ldb, int K, f32x16 (&acc)[2][BN / 64], char* lds) {
  constexpr int NB = BN / 64, NBL = BN / 32;
  constexpr int A_BYTES = 128 * 128, ST = A_BYTES + BN * 128;
  const int tid = TIDX(), lane = tid & 63, wid = tid >> 6, wr = wid >> 1, wc = wid & 1;
  const int lrow = tid >> 3, lch = tid & 7;
  u32x4 ra[2][4], rb[2][NBL];
  const bf16_t* ap = A + (size_t)lrow * lda + lch * 8;
  const bf16_t* bp = B + (size_t)lrow * ldb + lch * 8;
  const int nk = K >> 6;
#define GC_LOAD(set, k0) do { _Pragma("unroll") for (int i = 0; i < 4; ++i) ra[set][i] = *(const u32x4*)(ap + (size_t)(32 * i) * lda + (k0)); \
    _Pragma("unroll") for (int i = 0; i < NBL; ++i) rb[set][i] = *(const u32x4*)(bp + (size_t)(32 * i) * ldb + (k0)); } while (0)
#define GC_STORE(stage, set) do { char* st_ = lds + (stage) * ST; _Pragma("unroll") for (int i = 0; i < 4; ++i) *(u32x4*)(st_ + swz(lrow + 32 * i, lch)) = ra[set][i]; \
    _Pragma("unroll") for (int i = 0; i < NBL; ++i) *(u32x4*)(st_ + A_BYTES + swz(lrow + 32 * i, lch)) = rb[set][i]; } while (0)
#define GC_COMPUTE(stage) do { const char* cur = lds + (stage) * ST; _Pragma("unroll") for (int ks = 0; ks < 4; ++ks) { const int ch = ks * 2 + (lane >> 5); bf16x8 af[2], bfr[NB]; \
    _Pragma("unroll") for (int mi = 0; mi < 2; ++mi) af[mi] = *(const bf16x8*)(cur + swz(wr * 64 + mi * 32 + (lane & 31), ch)); \
    _Pragma("unroll") for (int ni = 0; ni < NB; ++ni) bfr[ni] = *(const bf16x8*)(cur + A_BYTES + swz(wc * (BN / 2) + ni * 32 + (lane & 31), ch)); \
    _Pragma("unroll") for (int mi = 0; mi < 2; ++mi) _Pragma("unroll") for (int ni = 0; ni < NB; ++ni) acc[mi][ni] = __builtin_amdgcn_mfma_f32_32x32x16_bf16(bfr[ni], af[mi], acc[mi][ni], 0, 0, 0); } } while (0)
  GC_LOAD(0, 0);
  GC_STORE(0, 0);
  if (nk > 1) GC_LOAD(1, 64);
  __syncthreads();
  for (int kt = 0; kt < nk; kt += 2) {
    if (kt + 2 < nk) GC_LOAD(0, (kt + 2) * 64);
    __builtin_amdgcn_sched_barrier(0);
    GC_COMPUTE(0);
    __builtin_amdgcn_sched_barrier(0);
    if (kt + 1 < nk) GC_STORE(1, 1);
    __syncthreads();
    if (kt + 1 >= nk) break;
    if (kt + 3 < nk) GC_LOAD(1, (kt + 3) * 64);
    __builtin_amdgcn_sched_barrier(0);
    GC_COMPUTE(1);
    __builtin_amdgcn_sched_barrier(0);
    if (kt + 2 < nk) GC_STORE(0, 0);
    __syncthreads();
  }
#undef GC_LOAD
#undef GC_STORE
#undef GC_COMPUTE
}
#define LDSAS __attribute__((address_space(3)))
template <int N> DEV void wait_vmcnt() { asm volatile("s_waitcnt vmcnt(%0)" ::"n"(N) : "memory"); }
template <int BN>
DEV void gemm_core(const bf16_t* __restrict__ A, int lda, const bf16_t* __restrict__ B, int ldb, int K, f32x16 (&acc)[2][BN / 64], char* lds) {
  constexpr int NB = BN / 64, NPB = BN / 32;
  constexpr int NP = 4 + NPB;
  constexpr int A_BYTES = 128 * 128, ST = A_BYTES + BN * 128;
  const int tid = TIDX(), lane = tid & 63, wid = __builtin_amdgcn_readfirstlane(tid >> 6), wr = wid >> 1, wc = wid & 1;
  LDSAS char* l3 = (LDSAS char*)lds;
  unsigned offA[4], offB[NPB];
#pragma unroll
  for (int i = 0; i < 4; ++i) { const int row = (wid * 4 + i) * 8 + (lane >> 3); offA[i] = (unsigned)(row * lda + (((lane & 7) ^ ((row >> 1) & 7)) << 3)) * 2u; }
#pragma unroll
  for (int i = 0; i < NPB; ++i) { const int row = (wid * NPB + i) * 8 + (lane >> 3); offB[i] = (unsigned)(row * ldb + (((lane & 7) ^ ((row >> 1) & 7)) << 3)) * 2u; }
  const int nk = K >> 6;
#define GD_ISSUE(stage, kt_) do { const char* ga_ = (const char*)A + (size_t)(kt_) * 128; const char* gb_ = (const char*)B + (size_t)(kt_) * 128; \
    _Pragma("unroll") for (int i = 0; i < 4; ++i) __builtin_amdgcn_global_load_lds((const unsigned*)(ga_ + offA[i]), (LDSAS unsigned*)(l3 + (stage) * ST + (wid * 4 + i) * 1024), 16, 0, 0); \
    _Pragma("unroll") for (int i = 0; i < NPB; ++i) __builtin_amdgcn_global_load_lds((const unsigned*)(gb_ + offB[i]), (LDSAS unsigned*)(l3 + (stage) * ST + A_BYTES + (wid * NPB + i) * 1024), 16, 0, 0); } while (0)
  wait_vmcnt<0>();
  GD_ISSUE(0, 0);
  if (nk > 1) { GD_ISSUE(1, 1); wait_vmcnt<NP>(); } else wait_vmcnt<0>();
  __builtin_amdgcn_s_barrier(); asm volatile("" ::: "memory");
  for (int kt = 0; kt < nk; ++kt) {
    const char* cur = lds + (kt & 1) * ST;
#pragma unroll
    for (int ks = 0; ks < 4; ++ks) {
      const int ch = ks * 2 + (lane >> 5);
      bf16x8 af[2], bfr[NB];
#pragma unroll
      for (int mi = 0; mi < 2; ++mi) af[mi] = *(const bf16x8*)(cur + swz(wr * 64 + mi * 32 + (lane & 31), ch));
#pragma unroll
      for (int ni = 0; ni < NB; ++ni) bfr[ni] = *(const bf16x8*)(cur + A_BYTES + swz(wc * (BN / 2) + ni * 32 + (lane & 31), ch));
#pragma unroll
      for (int mi = 0; mi < 2; ++mi)
#pragma unroll
        for (int ni = 0; ni < NB; ++ni) acc[mi][ni] = __builtin_amdgcn_mfma_f32_32x32x16_bf16(bfr[ni], af[mi], acc[mi][ni], 0, 0, 0);
    }
    asm volatile("s_waitcnt lgkmcnt(0)" ::: "memory");
    __builtin_amdgcn_s_barrier(); asm volatile("" ::: "memory");
    if (kt + 2 < nk) { GD_ISSUE(kt & 1, kt + 2); wait_vmcnt<NP>(); }
    else wait_vmcnt<0>();
    __builtin_amdgcn_s_barrier(); asm volatile("" ::: "memory");
  }
#undef GD_ISSUE
}
template <int NB>
DEV void zero_acc(f32x16 (&acc)[2][NB]) {
#pragma unroll
  for (int a = 0; a < 2; ++a)
#pragma unroll
    for (int b = 0; b < NB; ++b)
#pragma unroll
      for (int i = 0; i < 16; ++i) acc[a][b][i] = 0.f;
}

struct Cv { const float* src; int ld; int K; int Np; int kind; const float* ks; bf16_t* dst; };
DEV int cv_map(int kind, int n) {
  if (kind == 0) return n;
  if (kind == 1) { const int g = n >> 6, r = n & 63; return r < 32 ? g * 32 + r : 2816 + g * 32 + (r - 32); }
  if (kind == 2) {
    if (n < 2064) return n;
    if (n < 2176) return -1;
    if (n < 2880) return 2064 + (n - 2176);
    if (n < 2944) return -1;
    return 2768 + (n - 2944);
  }
  return 5328 + n;
}
DEV void cv_run(const Cv c, char* lds) {
  float* tile = (float*)lds;
  const int tid = TIDX();
  const int nkt = c.K >> 6, ntile = nkt * (c.Np >> 6);
  for (int t = blockIdx.x; t < ntile; t += gridDim.x) {
    const int k0 = (t % nkt) * 64, n0 = (t / nkt) * 64;
    const int nn = tid & 63, src_n = cv_map(c.kind, n0 + nn);
#pragma unroll
    for (int i = 0; i < 16; ++i) {
      const int k = i * 4 + (tid >> 6);
      float v = 0.f;
      if (src_n >= 0) { v = c.src[(size_t)(k0 + k) * c.ld + src_n]; if (c.ks) v *= c.ks[k0 + k]; }
      tile[k * 65 + nn] = v;
    }
    __syncthreads();
#pragma unroll
    for (int i = 0; i < 16; ++i) {
      const int n = i * 4 + (tid >> 6), k = tid & 63;
      c.dst[(size_t)(n0 + n) * c.K + k0 + k] = f2bf(tile[k * 65 + n]);
    }
    __syncthreads();
  }
}
DEV void conv_ffn(const P& p, int l, int f, char* lds) {
  bf16_t* wt = (bf16_t*)(p.ws + OFF_WT);
  Cv a = {p.ffn_w_in + (size_t)(l * 2 + f) * 1024 * 5632, 5632, 1024, 5632, 1, nullptr, (bf16_t*)((char*)wt + WT_WI)};
  cv_run(a, lds);
  Cv b = {p.ffn_w_out + (size_t)(l * 2 + f) * 2816 * 1024, 1024, 2816, 1024, 0, nullptr, (bf16_t*)((char*)wt + WT_WO)};
  cv_run(b, lds);
}
DEV void conv_mixer(const P& p, int l, char* lds) {
  char* wt = p.ws + OFF_WT;
  const float* win = p.w_in + (size_t)l * 1024 * WIN_LD;
  Cv a = {win, WIN_LD, 1024, NWIN, 2, nullptr, (bf16_t*)(wt + WT_WIN)}; cv_run(a, lds);
  Cv b = {win, WIN_LD, 1024, 3072, 3, nullptr, (bf16_t*)(wt + WT_WG)}; cv_run(b, lds);
  Cv c = {p.mla_w_q_b + (size_t)l * 384 * 768, 768, 384, 768, 0, p.mla_q_norm + l * 384, (bf16_t*)(wt + WT_WQB)}; cv_run(c, lds);
  Cv d = {p.mla_w_kv_b + (size_t)l * 256 * 1024, 1024, 256, 1024, 0, p.mla_kv_norm + l * 256, (bf16_t*)(wt + WT_WKVB)}; cv_run(d, lds);
#pragma unroll 1
  for (int j = 0; j < 3; ++j) {
    Cv e = {p.w_branch + (size_t)(l * 3 + j) * 512 * 1024, 1024, 512, 1024, 0, nullptr, (bf16_t*)(wt + WT_WBR) + (size_t)j * 1024 * 512};
    cv_run(e, lds);
  }
  Cv f = {p.w_out + (size_t)l * 1024 * 1024, 1024, 1024, 1024, 0, nullptr, (bf16_t*)(wt + WT_WOUT)}; cv_run(f, lds);
}

DEV void phase0(const P& p, char* lds) {
  const int tid = TIDX();
  {
    const f32x4* s = (const f32x4*)p.x; f32x4* d = (f32x4*)p.out;
    const size_t n = (size_t)TL * D / 4;
    for (size_t i = (size_t)blockIdx.x * 256 + tid; i < n; i += (size_t)gridDim.x * 256) d[i] = s[i];
    const f32x4* s2 = (const f32x4*)p.ctx; f32x4* d2 = (f32x4*)(p.ws + OFF_HCTX);
    const size_t n2 = 512ull * D / 4;
    for (size_t i = (size_t)blockIdx.x * 256 + tid; i < n2; i += (size_t)gridDim.x * 256) d2[i] = s2[i];
  }
  {
    float* sv = (float*)lds;
    float* modp = (float*)(p.ws + OFF_MODP);
    for (int t = blockIdx.x; t < 2 * 36 * 4; t += gridDim.x) {
      const int ks = t & 3, cb = (t >> 2) % 36, l = t / 144;
      __syncthreads();
      {
        const int k = ks * 256 + tid;
        sv[tid] = siluf_(p.c[k]); sv[256 + tid] = siluf_(p.c[1024 + k]); sv[512 + tid] = siluf_(p.c_ctx[k]);
      }
      __syncthreads();
      const int col = cb * 256 + tid;
      const float* w = p.w_ada + ((size_t)l * 1024 + ks * 256) * 9216 + col;
      float a0 = 0.f, a1 = 0.f, a2 = 0.f;
#pragma unroll 8
      for (int k = 0; k < 256; ++k) { const float wv = w[(size_t)k * 9216]; a0 += sv[k] * wv; a1 += sv[256 + k] * wv; a2 += sv[512 + k] * wv; }
      float* o = modp + ((size_t)(ks * 2 + l) * 3) * 9216 + col;
      o[0] = a0; o[9216] = a1; o[2 * 9216] = a2;
    }
    __syncthreads();
  }
  conv_ffn(p, 0, 0, lds);
}
DEV void phase0b(const P& p) {
  const float* modp = (const float*)(p.ws + OFF_MODP);
  float* mod = (float*)(p.ws + OFF_MOD);
  for (int i = blockIdx.x * 256 + TIDX(); i < 2 * 3 * 9216; i += gridDim.x * 256) {
    const int col = i % 9216, l = i / (3 * 9216);
    float v = p.b_ada[l * 9216 + col];
#pragma unroll
    for (int ks = 0; ks < 4; ++ks) v += modp[(size_t)ks * 2 * 3 * 9216 + i];
    mod[i] = v;
  }
}

DEV void row_phase(const P& p, bool do_post, int l_post, const bf16_t* __restrict__ Y, int gate_idx, float gate_mul, int postw_idx,
                   bool do_pre, int l_pre, int prew_idx, int shift_idx, bf16_t* __restrict__ Aout, int nrows = T) {
  const float* mod = (const float*)(p.ws + OFF_MOD);
  float* hctx = (float*)(p.ws + OFF_HCTX);
  const int lane = TIDX() & 63, wid = TIDX() >> 6;
  const int stride = gridDim.x * 4;
  for (int r0 = blockIdx.x * 4 + wid; r0 < nrows; r0 += 2 * stride) {
    const bool two = r0 + stride < nrows;
    f32x4 h[2][4]; u32x2 yw[2][4];
#pragma unroll
    for (int k = 0; k < 2; ++k) {
      if (k == 1 && !two) break;
      const int r = r0 + k * stride;
      const float* hrow = r < TL ? p.out + (size_t)r * D : hctx + (size_t)(r - TL) * D;
#pragma unroll
      for (int i = 0; i < 4; ++i) h[k][i] = *(const f32x4*)(hrow + i * 256 + lane * 4);
      if (do_post) {
#pragma unroll
        for (int i = 0; i < 4; ++i) yw[k][i] = *(const u32x2*)(Y + (size_t)r * D + i * 256 + lane * 4);
      }
    }
#pragma unroll
    for (int k = 0; k < 2; ++k) {
      if (k == 1 && !two) break;
      const int r = r0 + k * stride;
      float* hrow = r < TL ? p.out + (size_t)r * D : hctx + (size_t)(r - TL) * D;
      const int sel = sel_of(r);
      if (do_post) {
        f32x4 y[4]; float ss = 0.f;
#pragma unroll
        for (int i = 0; i < 4; ++i) { y[i] = (f32x4){bflo(yw[k][i][0]), bfhi(yw[k][i][0]), bflo(yw[k][i][1]), bfhi(yw[k][i][1])}; ss += y[i][0] * y[i][0] + y[i][1] * y[i][1] + y[i][2] * y[i][2] + y[i][3] * y[i][3]; }
        ss = wave_sum(ss);
        const float rs = rsqrtf(ss * (1.f / 1024.f) + EPS);
        const float* pw = p.norm_w + (size_t)(l_post * 6 + postw_idx) * 1024;
        const float* gt = mod + ((size_t)(l_post * 3 + sel) * 9 + gate_idx) * 1024;
#pragma unroll
        for (int i = 0; i < 4; ++i) {
          const f32x4 w4 = *(const f32x4*)(pw + i * 256 + lane * 4), g4 = *(const f32x4*)(gt + i * 256 + lane * 4);
          h[k][i] += gate_mul * g4 * (y[i] * rs * w4);
          *(f32x4*)(hrow + i * 256 + lane * 4) = h[k][i];
        }
      }
      if (do_pre) {
        float ss = 0.f;
#pragma unroll
        for (int i = 0; i < 4; ++i) ss += h[k][i][0] * h[k][i][0] + h[k][i][1] * h[k][i][1] + h[k][i][2] * h[k][i][2] + h[k][i][3] * h[k][i][3];
        ss = wave_sum(ss);
        const float rs = rsqrtf(ss * (1.f / 1024.f) + EPS);
        const float* nw = p.norm_w + (size_t)(l_pre * 6 + prew_idx) * 1024;
        const float* sh = mod + ((size_t)(l_pre * 3 + sel) * 9 + shift_idx) * 1024;
        const float* sc = sh + 1024;
#pragma unroll
        for (int i = 0; i < 4; ++i) {
          const f32x4 w4 = *(const f32x4*)(nw + i * 256 + lane * 4), s4 = *(const f32x4*)(sh + i * 256 + lane * 4), c4 = *(const f32x4*)(sc + i * 256 + lane * 4);
          const f32x4 v = (h[k][i] * rs * w4) * (1.f + c4) + s4;
          st4bf(Aout + (size_t)r * D + i * 256 + lane * 4, v[0], v[1], v[2], v[3]);
        }
      }
    }
  }
}

DEV void ffn_gemm1(const P& p, char* lds, int MT) {
  const bf16_t* A = (const bf16_t*)(p.ws + OFF_A);
  const bf16_t* W = (const bf16_t*)(p.ws + OFF_WT + WT_WI);
  bf16_t* H = (bf16_t*)(p.ws + OFF_U + U_HFF);
  const int lane = TIDX() & 63, wid = TIDX() >> 6, wr = wid >> 1, wc = wid & 1, h2 = lane >> 5;
  constexpr int NT = 5632 / 128;
  for (int t = vblock(); t < MT * NT; t += gridDim.x) {
    int mt, nt; tile_map(t, MT, NT, mt, nt);
    f32x16 acc[2][2]; zero_acc<2>(acc);
    gemm_core<128>(A + (size_t)mt * 128 * 1024, 1024, W + (size_t)nt * 128 * 1024, 1024, 1024, acc, lds);
#pragma unroll
    for (int mi = 0; mi < 2; ++mi) {
      const int row = mt * 128 + wr * 64 + mi * 32 + (lane & 31);
      bf16_t* dst = H + (size_t)row * DFF + (nt * 2 + wc) * 32 + 4 * h2;
#pragma unroll
      for (int q = 0; q < 4; ++q) {
        float v[4];
#pragma unroll
        for (int j = 0; j < 4; ++j) v[j] = siluf_(acc[mi][0][q * 4 + j]) * acc[mi][1][q * 4 + j];
        st4bf(dst + 8 * q, v[0], v[1], v[2], v[3]);
      }
    }
  }
}
DEV void gemm_f32out(const bf16_t* A, int K, const bf16_t* W, bf16_t* Y, char* lds, int MT) {
  const int lane = TIDX() & 63, wid = TIDX() >> 6, wr = wid >> 1, wc = wid & 1, h2 = lane >> 5;
  constexpr int NT = 1024 / 128;
  for (int t = vblock(); t < MT * NT; t += gridDim.x) {
    int mt, nt; tile_map(t, MT, NT, mt, nt);
    f32x16 acc[2][2]; zero_acc<2>(acc);
    gemm_core<128>(A + (size_t)mt * 128 * K, K, W + (size_t)nt * 128 * K, K, K, acc, lds);
#pragma unroll
    for (int mi = 0; mi < 2; ++mi) {
      const int row = mt * 128 + wr * 64 + mi * 32 + (lane & 31);
#pragma unroll
      for (int ni = 0; ni < 2; ++ni) {
        bf16_t* dst = Y + (size_t)row * D + nt * 128 + wc * 64 + ni * 32 + 4 * h2;
#pragma unroll
        for (int q = 0; q < 4; ++q) st4bf(dst + 8 * q, acc[mi][ni][q * 4], acc[mi][ni][q * 4 + 1], acc[mi][ni][q * 4 + 2], acc[mi][ni][q * 4 + 3]);
      }
    }
  }
}

DEV void rope32(f32x16& v, int a, int r, int h2) {
  if (r >= TL) return;
  const int n = r & 8191;
  const float pos = (float)(a == 0 ? (n >> 6) : (n & 63));
#pragma unroll
  for (int reg = 0; reg < 8; ++reg) {
    const int f = (reg & 3) + 8 * (reg >> 2) + 4 * h2;
    const float inv = __builtin_amdgcn_exp2f(-(float)f * (13.287712379549449f / 16.f));
    const float ang = pos * inv;
    const float c = __cosf(ang), s = __sinf(ang);
    const float x1 = v[reg], x2 = v[reg + 8];
    v[reg] = x1 * c - x2 * s;
    v[reg + 8] = x2 * c + x1 * s;
  }
}

DEV void win_gemm(const P& p, int l, char* lds) {
  const bf16_t* A = (const bf16_t*)(p.ws + OFF_A);
  const bf16_t* W = (const bf16_t*)(p.ws + OFF_WT + WT_WIN);
  char* U = p.ws + OFF_U;
  bf16_t *GQR = (bf16_t*)(U + U_GQR), *GG = (bf16_t*)(U + U_GG), *MQA = (bf16_t*)(U + U_MQA), *MKVA = (bf16_t*)(U + U_MKVA), *MKR = (bf16_t*)(U + U_MKR),
         *HQ = (bf16_t*)(U + U_HQ), *HK = (bf16_t*)(U + U_HK), *HI = (bf16_t*)(U + U_HI), *HG = (bf16_t*)(U + U_HG);
  float* GAB = (float*)(U + U_GAB);
  const int lane = TIDX() & 63, wid = TIDX() >> 6, wr = wid >> 1, wc = wid & 1, h2 = lane >> 5;
  constexpr int MT = T / 128, NT = NWIN / 128;
  for (int t = vblock(); t < MT * NT; t += gridDim.x) {
    int mt, nt; tile_map(t, MT, NT, mt, nt);
    f32x16 acc[2][2]; zero_acc<2>(acc);
    gemm_core<128>(A + (size_t)mt * 128 * 1024, 1024, W + (size_t)nt * 128 * 1024, 1024, 1024, acc, lds);
#pragma unroll
    for (int ni = 0; ni < 2; ++ni) {
      const int nb = nt * 128 + wc * 64 + ni * 32;
#pragma unroll
      for (int mi = 0; mi < 2; ++mi) {
        const int row = mt * 128 + wr * 64 + mi * 32 + (lane & 31);
        f32x16 v = acc[mi][ni];
        bf16_t* dst = nullptr;
        if (nb < 1536) dst = GQR + (size_t)row * 1536 + nb;
        else if (nb < 2048) dst = GG + (size_t)row * 512 + (nb - 1536);
        else if (nb == 2048) {
#pragma unroll
          for (int reg = 0; reg < 16; ++reg) {
            const int c = (reg & 3) + 8 * (reg >> 2) + 4 * h2;
            if (c < 8) {
              const float al = p.gdn_a_log[l * 8 + c], dtb = p.gdn_dt_bias[l * 8 + c];
              const float xx = v[reg] + dtb;
              const float sp = xx > 20.f ? xx : log1pf(__expf(xx));
              GAB[(size_t)row * 16 + c] = -__expf(al) * sp;
            } else if (c < 16) {
              GAB[(size_t)row * 16 + c] = sigmoidf_(v[reg]);
            }
          }
        }
        else if (nb < 2176) {}
        else if (nb < 2560) dst = MQA + (size_t)row * 384 + (nb - 2176);
        else if (nb < 2816) dst = MKVA + (size_t)row * 256 + (nb - 2560);
        else if (nb < 2880) { rope32(v, (nb - 2816) >> 5, row, h2); dst = MKR + (size_t)row * 64 + (nb - 2816); }
        else if (nb < 2944) {}
        else if (nb < 3456) { v = v * 0.08838834764831845f; dst = HQ + (size_t)row * 512 + (nb - 2944); }
        else if (nb < 4480) {
          const int cb = nb - 3456;
#pragma unroll
          for (int reg = 0; reg < 16; ++reg) {
            const int c = cb + (reg & 3) + 8 * (reg >> 2) + 4 * h2;
            float lb = 0.f;
            if (l == 1) lb = sigmoidf_(p.hg_lb[1024 + c] - p.hg_lb[c]);
            v[reg] = (1.f - lb) * sigmoidf_(-v[reg]);
          }
          dst = HK + (size_t)row * 1024 + cb;
        }
        else if (nb < 4992) dst = HI + (size_t)row * 512 + (nb - 4480);
        else dst = HG + (size_t)row * 512 + (nb - 4992);
        if (dst) {
          dst += 4 * h2;
#pragma unroll
          for (int q = 0; q < 4; ++q) st4bf(dst + 8 * q, v[q * 4], v[q * 4 + 1], v[q * 4 + 2], v[q * 4 + 3]);
        }
      }
    }
  }
}

DEV void gdn_prep_rows(const P& p, int l) {
  char* U = p.ws + OFF_U;
  const bf16_t* GQR = (const bf16_t*)(U + U_GQR);
  bf16_t* GQ2 = (bf16_t*)(U + U_GQ2);
  const float* cw = p.gdn_conv + (size_t)l * 3 * 1536;
  const int lane = TIDX() & 63, wid = TIDX() >> 6;
  const int stride = gridDim.x * 4;
  float cwr[3][3][8];
#pragma unroll
  for (int j = 0; j < 3; ++j)
#pragma unroll
    for (int tp = 0; tp < 3; ++tp)
#pragma unroll
      for (int i = 0; i < 8; ++i) cwr[j][tp][i] = cw[tp * 1536 + j * 512 + lane * 8 + i];
  for (int r0 = blockIdx.x * 4 + wid; r0 < T; r0 += 2 * stride) {
    const bool two = r0 + stride < T;
    u32x4 xc[2][3], xp[2][3], xn[2][3];
#pragma unroll
    for (int k = 0; k < 2; ++k) {
      if (k == 1 && !two) break;
      const int r = r0 + k * stride;
      bool hp, hn;
      if (r < TL) { const int n = r & 8191; hp = n > 0; hn = n < 8191; } else { const int tt = (r - TL) & 255; hp = tt > 0; hn = tt < 255; }
      const u32x4 z = {0u, 0u, 0u, 0u};
#pragma unroll
      for (int j = 0; j < 3; ++j) {
        const int c0 = j * 512 + lane * 8;
        xc[k][j] = *(const u32x4*)(GQR + (size_t)r * 1536 + c0);
        xp[k][j] = hp ? *(const u32x4*)(GQR + (size_t)(r - 1) * 1536 + c0) : z;
        xn[k][j] = hn ? *(const u32x4*)(GQR + (size_t)(r + 1) * 1536 + c0) : z;
      }
    }
#pragma unroll
    for (int k = 0; k < 2; ++k) {
      if (k == 1 && !two) break;
      const int r = r0 + k * stride;
#pragma unroll
      for (int j = 0; j < 3; ++j) {
        const int c0 = j * 512 + lane * 8;
        float val[8]; float ss = 0.f;
#pragma unroll
        for (int i = 0; i < 8; ++i) {
          const unsigned wp = xp[k][j][i >> 1], wcur = xc[k][j][i >> 1], wn = xn[k][j][i >> 1];
          const float fp = (i & 1) ? bfhi(wp) : bflo(wp), fc = (i & 1) ? bfhi(wcur) : bflo(wcur), fn = (i & 1) ? bfhi(wn) : bflo(wn);
          const float sv = fp * cwr[j][0][i] + fc * cwr[j][1][i] + fn * cwr[j][2][i];
          val[i] = siluf_(sv); ss += val[i] * val[i];
        }
        if (j < 2) {
          ss = sum16(ss);
          float sc = rsqrtf(ss + EPS);
          if (j == 0) sc *= 0.08838834764831845f;
#pragma unroll
          for (int i = 0; i < 8; ++i) val[i] *= sc;
        }
        u32x4 o = {pk2(val[0], val[1]), pk2(val[2], val[3]), pk2(val[4], val[5]), pk2(val[6], val[7])};
        *(u32x4*)(GQ2 + (size_t)r * 1536 + c0) = o;
      }
    }
  }
}
DEV void row_scales(const bf16_t* A, int K, float* rs) {
  const int tid = TIDX(), row = tid >> 1, half = tid & 1;
  const bf16_t* a = A + (size_t)row * K + half * (K / 2);
  float ss = 0.f;
  for (int k = 0; k < K / 2; k += 8) {
    const u32x4 w = *(const u32x4*)(a + k);
#pragma unroll
    for (int i = 0; i < 4; ++i) { const float lo = bflo(w[i]), hi = bfhi(w[i]); ss += lo * lo + hi * hi; }
  }
  ss += __shfl_xor(ss, 1);
  if (half == 0) rs[row] = rsqrtf(ss / (float)K + EPS);
}
DEV void mla_prep_gemms(const P& p, char* lds) {
  char* U = p.ws + OFF_U;
  const bf16_t *MQA = (const bf16_t*)(U + U_MQA), *MKVA = (const bf16_t*)(U + U_MKVA);
  const bf16_t *WQ = (const bf16_t*)(p.ws + OFF_WT + WT_WQB), *WKV = (const bf16_t*)(p.ws + OFF_WT + WT_WKVB);
  bf16_t *MQ = (bf16_t*)(U + U_MQ), *MKN = (bf16_t*)(U + U_MKN), *MVT = (bf16_t*)(U + U_MVT);
  const int lane = TIDX() & 63, wid = TIDX() >> 6, wr = wid >> 1, wc = wid & 1, h2 = lane >> 5;
  constexpr int MT = T / 128;
  constexpr float QSCALE = 0.07216878364870322f * 1.4426950408889634f;
  for (int t = vblock(); t < MT * 14; t += gridDim.x) {
    int mt, nt; tile_map(t, MT, 14, mt, nt);
    const bool isq = nt < 6;
    const bf16_t* Ab = isq ? MQA + (size_t)mt * 128 * 384 : MKVA + (size_t)mt * 128 * 256;
    const int K = isq ? 384 : 256;
    float* rsl = (float*)lds;
    __syncthreads();
    row_scales(Ab, K, rsl);
    __syncthreads();
    float rsv[2];
#pragma unroll
    for (int mi = 0; mi < 2; ++mi) rsv[mi] = rsl[wr * 64 + mi * 32 + (lane & 31)];
    __syncthreads();
    f32x16 acc[2][2]; zero_acc<2>(acc);
    if (isq) gemm_core<128>(Ab, 384, WQ + (size_t)nt * 128 * 384, 384, 384, acc, lds);
    else gemm_core<128>(Ab, 256, WKV + (size_t)(nt - 6) * 128 * 256, 256, 256, acc, lds);
#pragma unroll
    for (int mi = 0; mi < 2; ++mi) {
      const int row = mt * 128 + wr * 64 + mi * 32 + (lane & 31);
#pragma unroll
      for (int ni = 0; ni < 2; ++ni) {
        f32x16 v = acc[mi][ni] * rsv[mi];
        if (isq) {
          const int nb = nt * 128 + wc * 64 + ni * 32, jb = nb % 192;
          if (jb >= 128) rope32(v, (jb - 128) >> 5, row, h2);
          v = v * QSCALE;
          bf16_t* dst = MQ + (size_t)row * 768 + nb + 4 * h2;
#pragma unroll
          for (int q = 0; q < 4; ++q) st4bf(dst + 8 * q, v[q * 4], v[q * 4 + 1], v[q * 4 + 2], v[q * 4 + 3]);
        } else {
          const int nb = (nt - 6) * 128 + wc * 64 + ni * 32, head = nb >> 8, jb = nb & 255;
          if (jb < 128) {
            bf16_t* dst = MKN + (size_t)row * 512 + head * 128 + jb + 4 * h2;
#pragma unroll
            for (int q = 0; q < 4; ++q) st4bf(dst + 8 * q, v[q * 4], v[q * 4 + 1], v[q * 4 + 2], v[q * 4 + 3]);
          } else {
            const int b = batch_of(row), kx = kx_of(row);
            bf16_t* dst = MVT + ((size_t)(b * 4 + head) * 128 + (jb - 128) + 4 * h2) * KSP + kx;
#pragma unroll
            for (int reg = 0; reg < 16; ++reg) dst[(size_t)((reg & 3) + 8 * (reg >> 2)) * KSP] = f2bf(v[reg]);
          }
        }
      }
    }
  }
}

template <int BR>
DEV void scan_task(const P& p, int b, int h, int dir, int cgp, char* lds) {
  char* U = p.ws + OFF_U;
  const int tid = TIDX(), lane = tid & 63, w = tid >> 6, kg = lane & 15, ci = lane >> 4;
  const bf16_t *Qs, *Ks, *Vs; int ldq, ldk, ldv;
  if (BR == 0) { const bf16_t* g = (const bf16_t*)(U + U_GQ2); Qs = g + h * 128; Ks = g + 512 + h * 128; Vs = g + 1024 + h * 128 + cgp * 16; ldq = ldk = ldv = 1536; }
  else { Qs = (const bf16_t*)(U + U_HQ) + h * 128; ldq = 512; Ks = (const bf16_t*)(U + U_HK) + dir * 512 + h * 128; ldk = 1024; Vs = (const bf16_t*)(U + U_HI) + h * 128 + cgp * 16; ldv = 512; }
  const float* AB = (const float*)(U + U_GAB);
  bf16_t* O = (bf16_t*)(U + (BR == 0 ? (dir ? U_OGB : U_OGF) : (dir ? U_OHB : U_OHF))) + h * 128 + cgp * 16 + w * 4 + ci;
  constexpr int BUF = 16384 + 1024 + 128 + 128;
  const int sg = 1 - 2 * dir;
  auto rowbase = [&](int s0) -> int {
    const int rb = s0 < 256 ? TL + b * 256 + (dir ? 255 - s0 : s0) : b * 8192 + (dir ? 8191 - (s0 - 256) : (s0 - 256));
    return __builtin_amdgcn_readfirstlane(rb);
  };
  f32x2 S2[4];
#pragma unroll
  for (int i = 0; i < 4; ++i) S2[i] = (f32x2){0.f, 0.f};
  u32x4 g0, g1; bf16_t gv; float gs = 0.f;
  const int st0 = tid >> 5, cc0 = tid & 31;
  auto gload = [&](int bt) {
    const int rb = rowbase(bt * 16);
    const int r0 = rb + sg * st0, r1 = rb + sg * (st0 + 8);
    g0 = cc0 < 16 ? *(const u32x4*)(Ks + (size_t)r0 * ldk + cc0 * 8) : *(const u32x4*)(Qs + (size_t)r0 * ldq + (cc0 - 16) * 8);
    g1 = cc0 < 16 ? *(const u32x4*)(Ks + (size_t)r1 * ldk + cc0 * 8) : *(const u32x4*)(Qs + (size_t)r1 * ldq + (cc0 - 16) * 8);
    gv = Vs[(size_t)(rb + sg * (tid >> 4)) * ldv + (tid & 15)];
    if (BR == 0 && tid < 32) {
      const int rr = rb + sg * (tid & 15);
      gs = AB[(size_t)rr * 16 + (tid < 16 ? 0 : 8) + dir * 4 + h];
    }
  };
  auto lwrite = [&](char* buf) {
    float* kq = (float*)buf;
    f32x4 a = {bflo(g0[0]), bfhi(g0[0]), bflo(g0[1]), bfhi(g0[1])}, bq = {bflo(g0[2]), bfhi(g0[2]), bflo(g0[3]), bfhi(g0[3])};
    *(f32x4*)(kq + st0 * 256 + cc0 * 8) = a; *(f32x4*)(kq + st0 * 256 + cc0 * 8 + 4) = bq;
    f32x4 c = {bflo(g1[0]), bfhi(g1[0]), bflo(g1[1]), bfhi(g1[1])}, d = {bflo(g1[2]), bfhi(g1[2]), bflo(g1[3]), bfhi(g1[3])};
    *(f32x4*)(kq + (st0 + 8) * 256 + cc0 * 8) = c; *(f32x4*)(kq + (st0 + 8) * 256 + cc0 * 8 + 4) = d;
    ((float*)(buf + 16384))[tid] = bf2f(gv);
    if (BR == 0 && tid < 32) ((float*)(buf + 16384 + 1024))[(tid & 15) * 2 + (tid >> 4)] = tid < 16 ? __expf(gs) : gs;
  };
  auto gram = [&](char* buf) {
    const float* kq = (const float*)buf;
    const int di = tid >> 3, sub = tid & 7, pp = di >> 2, wh = di & 3;
    const float* xv = kq + (2 * pp + (wh == 1 ? 0 : 1)) * 256 + (wh == 0 ? 0 : 128) + sub * 16;
    const float* yv = kq + (2 * pp + (wh == 3 ? 1 : 0)) * 256 + sub * 16;
    float acc = 0.f;
#pragma unroll
    for (int i = 0; i < 4; ++i) { const f32x4 x = *(const f32x4*)(xv + 4 * i), y = *(const f32x4*)(yv + 4 * i); acc += (x[0] * y[0] + x[1] * y[1]) + (x[2] * y[2] + x[3] * y[3]); }
    acc += __int_as_float(__builtin_amdgcn_update_dpp(0, __float_as_int(acc), 0xB1, 0xf, 0xf, true));
    acc += __int_as_float(__builtin_amdgcn_update_dpp(0, __float_as_int(acc), 0x4E, 0xf, 0xf, true));
    acc += __int_as_float(__builtin_amdgcn_update_dpp(0, __float_as_int(acc), 0x141, 0xf, 0xf, true));
    if (sub == 0) ((float*)(buf + 16384 + 1024 + 128))[di] = acc;
  };
  constexpr int NBT = KSP / 16;
  __syncthreads();
  gload(0); lwrite(lds);
  gload(1);
  __syncthreads();
  if (BR == 0) gram(lds);
  lwrite(lds + BUF);
  gload(2);
  __syncthreads();
  int ic = 0;
  for (int bt = 0; bt < NBT; ++bt) {
    char* cur = lds + ic * BUF;
    const int i1 = ic == 2 ? 0 : ic + 1, i2 = i1 == 2 ? 0 : i1 + 1;
    if (bt + 2 < NBT) lwrite(lds + i2 * BUF);
    if (bt + 3 < NBT) gload(bt + 3);
    const float* kq = (const float*)cur;
    const float* vv = (const float*)(cur + 16384);
    const float* ab = (const float*)(cur + 16384 + 1024);
    const float* gm = (const float*)(cur + 16384 + 1024 + 128);
    float osel = 0.f;
    if (BR == 0) {
      f32x4 nk00 = *(const f32x4*)(kq + kg * 4), nk01 = *(const f32x4*)(kq + 64 + kg * 4), nq00 = *(const f32x4*)(kq + 128 + kg * 4), nq01 = *(const f32x4*)(kq + 192 + kg * 4);
      f32x4 nk10 = *(const f32x4*)(kq + 256 + kg * 4), nk11 = *(const f32x4*)(kq + 320 + kg * 4), nq10 = *(const f32x4*)(kq + 384 + kg * 4), nq11 = *(const f32x4*)(kq + 448 + kg * 4);
      float nv0 = vv[w * 4 + ci], nv1 = vv[16 + w * 4 + ci];
      f32x4 nabv = *(const f32x4*)(ab), ngr = *(const f32x4*)(gm);
#pragma unroll
      for (int pp = 0; pp < 8; ++pp) {
        const f32x4 k00 = nk00, k01 = nk01, q00 = nq00, q01 = nq01, k10 = nk10, k11 = nk11, q10 = nq10, q11 = nq11;
        const float v0 = nv0, v1 = nv1;
        const f32x4 abv = nabv;
        const f32x4 gr = ngr;
        if (pp + 1 < 8) {
          const float* kq0 = kq + (2 * pp + 2) * 256; const float* kq1 = kq0 + 256;
          nk00 = *(const f32x4*)(kq0 + kg * 4); nk01 = *(const f32x4*)(kq0 + 64 + kg * 4); nq00 = *(const f32x4*)(kq0 + 128 + kg * 4); nq01 = *(const f32x4*)(kq0 + 192 + kg * 4);
          nk10 = *(const f32x4*)(kq1 + kg * 4); nk11 = *(const f32x4*)(kq1 + 64 + kg * 4); nq10 = *(const f32x4*)(kq1 + 128 + kg * 4); nq11 = *(const f32x4*)(kq1 + 192 + kg * 4);
          nv0 = vv[(2 * pp + 2) * 16 + w * 4 + ci]; nv1 = vv[(2 * pp + 3) * 16 + w * 4 + ci];
          nabv = *(const f32x4*)(ab + (pp + 1) * 4); ngr = *(const f32x4*)(gm + (pp + 1) * 4);
        }
        __builtin_amdgcn_sched_barrier(0);
        const f32x2 k0a = {k00[0], k00[1]}, k0b = {k00[2], k00[3]}, k0c = {k01[0], k01[1]}, k0d = {k01[2], k01[3]};
        const f32x2 k1a = {k10[0], k10[1]}, k1b = {k10[2], k10[3]}, k1c = {k11[0], k11[1]}, k1d = {k11[2], k11[3]};
        const f32x2 q0a = {q00[0], q00[1]}, q0b = {q00[2], q00[3]}, q0c = {q01[0], q01[1]}, q0d = {q01[2], q01[3]};
        const f32x2 q1a = {q10[0], q10[1]}, q1b = {q10[2], q10[3]}, q1c = {q11[0], q11[1]}, q1d = {q11[2], q11[3]};
        const f32x2 t0 = (k0a * S2[0] + k0b * S2[1]) + (k0c * S2[2] + k0d * S2[3]);
        const f32x2 t1 = (k1a * S2[0] + k1b * S2[1]) + (k1c * S2[2] + k1d * S2[3]);
        const f32x2 t2 = (q0a * S2[0] + q0b * S2[1]) + (q0c * S2[2] + q0d * S2[3]);
        const f32x2 t3 = (q1a * S2[0] + q1b * S2[1]) + (q1c * S2[2] + q1d * S2[3]);
        const float kS0 = rowsum16(t0[0] + t0[1]), kS1 = rowsum16(t1[0] + t1[1]), qS0 = rowsum16(t2[0] + t2[1]), qS1 = rowsum16(t3[0] + t3[1]);
        const float a0 = abv[0], b0 = abv[1], a1 = abv[2], b1 = abv[3];
        const float c0 = b0 * (v0 - a0 * kS0);
        const float d1 = a0 * kS1 + gr[0] * c0;
        const float c1 = b1 * (v1 - a1 * d1);
        const float o0 = a0 * qS0 + gr[1] * c0;
        const float o1 = a1 * (a0 * qS1 + gr[2] * c0) + gr[3] * c1;
        const float aa = a1 * a0, e0 = a1 * c0;
        const f32x2 aav = {aa, aa}, e0v = {e0, e0}, c1v = {c1, c1};
        S2[0] = (aav * S2[0] + k0a * e0v) + k1a * c1v; S2[1] = (aav * S2[1] + k0b * e0v) + k1b * c1v;
        S2[2] = (aav * S2[2] + k0c * e0v) + k1c * c1v; S2[3] = (aav * S2[3] + k0d * e0v) + k1d * c1v;
        osel = (kg == 2 * pp) ? o0 : osel;
        osel = (kg == 2 * pp + 1) ? o1 : osel;
      }
    } else {
      f32x4 nk0 = *(const f32x4*)(kq + kg * 4), nk1 = *(const f32x4*)(kq + 64 + kg * 4), nq0 = *(const f32x4*)(kq + 128 + kg * 4), nq1 = *(const f32x4*)(kq + 192 + kg * 4);
      float nv = vv[w * 4 + ci];
#pragma unroll
      for (int st = 0; st < 16; ++st) {
        const f32x4 k0 = nk0, k1 = nk1, q0 = nq0, q1 = nq1;
        const float v = nv;
        if (st + 1 < 16) {
          nk0 = *(const f32x4*)(kq + (st + 1) * 256 + kg * 4); nk1 = *(const f32x4*)(kq + (st + 1) * 256 + 64 + kg * 4);
          nq0 = *(const f32x4*)(kq + (st + 1) * 256 + 128 + kg * 4); nq1 = *(const f32x4*)(kq + (st + 1) * 256 + 192 + kg * 4);
          nv = vv[(st + 1) * 16 + w * 4 + ci];
        }
        __builtin_amdgcn_sched_barrier(0);
        const f32x2 ka = {k0[0], k0[1]}, kb = {k0[2], k0[3]}, kc = {k1[0], k1[1]}, kd = {k1[2], k1[3]};
        const f32x2 qa = {q0[0], q0[1]}, qb = {q0[2], q0[3]}, qc = {q1[0], q1[1]}, qd = {q1[2], q1[3]};
        const f32x2 v2 = {v, v};
        S2[0] = S2[0] + ka * (v2 - S2[0]); S2[1] = S2[1] + kb * (v2 - S2[1]); S2[2] = S2[2] + kc * (v2 - S2[2]); S2[3] = S2[3] + kd * (v2 - S2[3]);
        const f32x2 u = (qa * S2[0] + qb * S2[1]) + (qc * S2[2] + qd * S2[3]);
        const float o = rowsum16(u[0] + u[1]);
        osel = (kg == st) ? o : osel;
      }
    }
    O[(size_t)(rowbase(bt * 16) + sg * kg) * 512] = f2bf(osel);
    if (BR == 0 && bt + 1 < NBT) gram(lds + i1 * BUF);
    __syncthreads();
    ic = i1;
  }
}

DEV void attn_task(const P& p, int b, int h, int r0, int kx_begin, int nkt, char* lds) {
  char* U = p.ws + OFF_U;
  const bf16_t *MQ = (const bf16_t*)(U + U_MQ), *MKN = (const bf16_t*)(U + U_MKN), *MKR = (const bf16_t*)(U + U_MKR), *MVT = (const bf16_t*)(U + U_MVT);
  bf16_t* YB = (bf16_t*)(p.ws + OFF_YB);
  const int tid = TIDX(), lane = tid & 63, w = tid >> 6, h2 = lane >> 5, l31 = lane & 31;
  const int qrow = r0 + w * 32 + l31;
  bf16x8 qf[12];
#pragma unroll
  for (int s = 0; s < 12; ++s) qf[s] = *(const bf16x8*)(MQ + (size_t)qrow * 768 + h * 192 + s * 16 + h2 * 8);
  f32x16 oacc[4];
#pragma unroll
  for (int d = 0; d < 4; ++d)
#pragma unroll
    for (int i = 0; i < 16; ++i) oacc[d][i] = 0.f;
  float m = -1e30f, lsum = 0.f;
  char* Kl = lds;
  char* Vl = lds + 64 * 384;
  const int pi = (l31 & 19) | ((l31 & 4) << 1) | ((l31 & 8) >> 1);
  const bf16_t* vbase = MVT + (size_t)(b * 4 + h) * 128 * KSP;
  for (int kt = 0; kt < nkt; ++kt) {
    const int kx0 = kx_begin + kt * 64;
    const int rb = kx0 < 8192 ? b * 8192 + kx0 : TL + b * 256 + (kx0 - 8192);
    u32x4 kr[6], vr[4];
#pragma unroll
    for (int i = 0; i < 6; ++i) {
      const int c = tid + 256 * i, row = c / 24, ch = c % 24;
      kr[i] = ch < 16 ? *(const u32x4*)(MKN + (size_t)(rb + row) * 512 + h * 128 + ch * 8) : *(const u32x4*)(MKR + (size_t)(rb + row) * 64 + (ch - 16) * 8);
    }
#pragma unroll
    for (int i = 0; i < 4; ++i) {
      const int c = tid + 256 * i, row = c >> 3, ch = c & 7;
      vr[i] = *(const u32x4*)(vbase + (size_t)row * KSP + kx0 + ch * 8);
    }
    __syncthreads();
#pragma unroll
    for (int i = 0; i < 6; ++i) {
      const int c = tid + 256 * i, row = c / 24, ch = c % 24;
      *(u32x4*)(Kl + row * 384 + (((ch & 24) | ((ch ^ (row >> 1)) & 7)) << 4)) = kr[i];
    }
#pragma unroll
    for (int i = 0; i < 4; ++i) {
      const int c = tid + 256 * i, row = c >> 3, ch = c & 7;
      *(u32x4*)(Vl + swz(row, ch)) = vr[i];
    }
    __syncthreads();
    f32x16 sacc[2];
#pragma unroll
    for (int i = 0; i < 16; ++i) { sacc[0][i] = 0.f; sacc[1][i] = 0.f; }
#pragma unroll
    for (int s = 0; s < 12; ++s) {
      const int ch = s * 2 + h2;
#pragma unroll
      for (int kb = 0; kb < 2; ++kb) {
        const int row = kb * 32 + pi;
        const bf16x8 kf = *(const bf16x8*)(Kl + row * 384 + (((ch & 24) | ((ch ^ (row >> 1)) & 7)) << 4));
        sacc[kb] = __builtin_amdgcn_mfma_f32_32x32x16_bf16(kf, qf[s], sacc[kb], 0, 0, 0);
      }
      if (s & 1) __builtin_amdgcn_sched_barrier(0);
    }
    float mx = sacc[0][0];
#pragma unroll
    for (int i = 1; i < 16; ++i) mx = fmaxf(mx, sacc[0][i]);
#pragma unroll
    for (int i = 0; i < 16; ++i) mx = fmaxf(mx, sacc[1][i]);
    mx = fmaxf(mx, __shfl_xor(mx, 32));
    const float mn = fmaxf(m, mx);
    const float alpha = __builtin_amdgcn_exp2f(m - mn);
    m = mn;
    float ps = 0.f;
#pragma unroll
    for (int kb = 0; kb < 2; ++kb)
#pragma unroll
      for (int i = 0; i < 16; ++i) { const float e = __builtin_amdgcn_exp2f(sacc[kb][i] - mn); sacc[kb][i] = e; ps += e; }
    lsum = lsum * alpha + ps;
#pragma unroll
    for (int d = 0; d < 4; ++d) oacc[d] = oacc[d] * alpha;
    bf16x8 pf[4];
#pragma unroll
    for (int kb = 0; kb < 2; ++kb)
#pragma unroll
      for (int s2 = 0; s2 < 2; ++s2) {
        u32x4 pw = {pk2(sacc[kb][8 * s2 + 0], sacc[kb][8 * s2 + 1]), pk2(sacc[kb][8 * s2 + 2], sacc[kb][8 * s2 + 3]),
                    pk2(sacc[kb][8 * s2 + 4], sacc[kb][8 * s2 + 5]), pk2(sacc[kb][8 * s2 + 6], sacc[kb][8 * s2 + 7])};
        pf[kb * 2 + s2] = __builtin_bit_cast(bf16x8, pw);
      }
    __builtin_amdgcn_sched_barrier(0);
#pragma unroll
    for (int s = 0; s < 4; ++s) {
#pragma unroll
      for (int d = 0; d < 4; ++d) {
        const bf16x8 vf = *(const bf16x8*)(Vl + swz(d * 32 + l31, s * 2 + h2));
        oacc[d] = __builtin_amdgcn_mfma_f32_32x32x16_bf16(vf, pf[s], oacc[d], 0, 0, 0);
      }
      __builtin_amdgcn_sched_barrier(0);
    }
  }
  lsum += __shfl_xor(lsum, 32);
  const float inv = 1.f / lsum;
  bf16_t* dst = YB + (size_t)qrow * 512 + h * 128 + 4 * h2;
#pragma unroll
  for (int d = 0; d < 4; ++d)
#pragma unroll
    for (int q = 0; q < 4; ++q) st4bf(dst + d * 32 + 8 * q, oacc[d][q * 4] * inv, oacc[d][q * 4 + 1] * inv, oacc[d][q * 4 + 2] * inv, oacc[d][q * 4 + 3] * inv);
  __syncthreads();
}

DEV void mixer_item(const P& p, int it, char* lds) {
  if (it < 256) {
    const int br = it >> 7, rem = it & 127, cgp = rem & 7, dir = (rem >> 3) & 1, h = (rem >> 4) & 3, b = rem >> 6;
    if (br == 0) scan_task<0>(p, b, h, dir, cgp, lds); else scan_task<1>(p, b, h, dir, cgp, lds);
  } else {
    const int a = it - 256;
    if (a < 512) { const int qt = a & 63, h = (a >> 6) & 3, b = a >> 8; attn_task(p, b, h, b * 8192 + qt * 128, 0, 132, lds); }
    else { const int c = a - 512, qt = c & 1, h = (c >> 1) & 3, b = c >> 3; attn_task(p, b, h, TL + b * 256 + qt * 128, 8192, 4, lds); }
  }
}
DEV void mixer_phase(const P& p, int l, char* lds) {
  __shared__ int sh_task;
  unsigned* ctr = (unsigned*)(p.ws + OFF_BAR) + 3600 + l * 64;
  const int G = gridDim.x;
  for (int it = blockIdx.x; it < 256; it += G) mixer_item(p, it, lds);
  for (;;) {
    __syncthreads();
    if (TIDX() == 0) sh_task = (int)atomicAdd(ctr, 1u);
    __syncthreads();
    const int a = sh_task;
    if (a >= 528) break;
    mixer_item(p, 256 + a, lds);
  }
}

DEV void readout_phase(const P& p, int l) {
  char* U = p.ws + OFF_U;
  const bf16_t *OGF = (const bf16_t*)(U + U_OGF), *OGB = (const bf16_t*)(U + U_OGB), *OHF = (const bf16_t*)(U + U_OHF), *OHB = (const bf16_t*)(U + U_OHB);
  const bf16_t *GG = (const bf16_t*)(U + U_GG), *HG = (const bf16_t*)(U + U_HG);
  bf16_t *YA = (bf16_t*)(U + U_YA), *YC = (bf16_t*)(U + U_YC);
  const int lane = TIDX() & 63, wid = TIDX() >> 6;
  const int stride = gridDim.x * 4;
  float nwv[2][8];
#pragma unroll
  for (int br = 0; br < 2; ++br)
#pragma unroll
    for (int i = 0; i < 8; ++i) nwv[br][i] = ((br ? p.hg_norm : p.gdn_norm) + l * 128 + (lane & 15) * 8)[i];
  for (int r0 = blockIdx.x * 4 + wid; r0 < T; r0 += 2 * stride) {
    const bool two = r0 + stride < T;
    u32x4 a[2][2], b2[2][2], g[2][2];
#pragma unroll
    for (int k = 0; k < 2; ++k) {
      if (k == 1 && !two) break;
      const size_t off = (size_t)(r0 + k * stride) * 512 + lane * 8;
      a[k][0] = *(const u32x4*)(OGF + off); b2[k][0] = *(const u32x4*)(OGB + off); g[k][0] = *(const u32x4*)(GG + off);
      a[k][1] = *(const u32x4*)(OHF + off); b2[k][1] = *(const u32x4*)(OHB + off); g[k][1] = *(const u32x4*)(HG + off);
    }
#pragma unroll
    for (int k = 0; k < 2; ++k) {
      if (k == 1 && !two) break;
      const size_t off = (size_t)(r0 + k * stride) * 512 + lane * 8;
#pragma unroll
      for (int br = 0; br < 2; ++br) {
        float o[8]; float ss = 0.f;
#pragma unroll
        for (int i = 0; i < 4; ++i) { o[2 * i] = bflo(a[k][br][i]) + bflo(b2[k][br][i]); o[2 * i + 1] = bfhi(a[k][br][i]) + bfhi(b2[k][br][i]); }
#pragma unroll
        for (int i = 0; i < 8; ++i) ss += o[i] * o[i];
        ss = sum16(ss);
        const float rs = rsqrtf(ss * (1.f / 128.f) + EPS);
        float y[8];
#pragma unroll
        for (int i = 0; i < 8; ++i) { const float gv = (i & 1) ? bfhi(g[k][br][i >> 1]) : bflo(g[k][br][i >> 1]); y[i] = o[i] * rs * nwv[br][i] * siluf_(gv); }
        u32x4 w = {pk2(y[0], y[1]), pk2(y[2], y[3]), pk2(y[4], y[5]), pk2(y[6], y[7])};
        *(u32x4*)((br ? YC : YA) + off) = w;
      }
    }
  }
}

DEV void merge_gemm(const P& p, char* lds, int MT) {
  char* U = p.ws + OFF_U;
  const bf16_t* ARE = (const bf16_t*)(p.ws + OFF_A);
  const bf16_t* WG = (const bf16_t*)(p.ws + OFF_WT + WT_WG);
  const bf16_t* WBR = (const bf16_t*)(p.ws + OFF_WT + WT_WBR);
  bf16_t* M = (bf16_t*)(U + U_M);
  const int lane = TIDX() & 63, wid = TIDX() >> 6, wr = wid >> 1, wc = wid & 1, h2 = lane >> 5;
  constexpr int NT = 1024 / 128;
  for (int t = vblock(); t < MT * NT; t += gridDim.x) {
    int mt, nt; tile_map(t, MT, NT, mt, nt);
    f32x16 macc[2][2]; zero_acc<2>(macc);
#pragma unroll 1
    for (int j = 0; j < 3; ++j) {
      const bf16_t* Yj = j == 0 ? (const bf16_t*)(U + U_YA) : (j == 1 ? (const bf16_t*)(p.ws + OFF_YB) : (const bf16_t*)(U + U_YC));
      f32x16 ag[2][2]; zero_acc<2>(ag);
      gemm_core<128>(ARE + (size_t)mt * 128 * 1024, 1024, WG + ((size_t)j * 1024 + nt * 128) * 1024, 1024, 1024, ag, lds);
#pragma unroll
      for (int mi = 0; mi < 2; ++mi)
#pragma unroll
        for (int ni = 0; ni < 2; ++ni)
#pragma unroll
          for (int i = 0; i < 16; ++i) ag[mi][ni][i] = sigmoidf_(ag[mi][ni][i]);
      f32x16 ab[2][2]; zero_acc<2>(ab);
      gemm_core<128>(Yj + (size_t)mt * 128 * 512, 512, WBR + ((size_t)j * 1024 + nt * 128) * 512, 512, 512, ab, lds);
#pragma unroll
      for (int mi = 0; mi < 2; ++mi)
#pragma unroll
        for (int ni = 0; ni < 2; ++ni)
#pragma unroll
          for (int i = 0; i < 16; ++i) macc[mi][ni][i] += ag[mi][ni][i] * ab[mi][ni][i];
    }
#pragma unroll
    for (int mi = 0; mi < 2; ++mi) {
      const int row = mt * 128 + wr * 64 + mi * 32 + (lane & 31);
#pragma unroll
      for (int ni = 0; ni < 2; ++ni) {
        bf16_t* dst = M + (size_t)row * D + nt * 128 + wc * 64 + ni * 32 + 4 * h2;
#pragma unroll
        for (int q = 0; q < 4; ++q) st4bf(dst + 8 * q, macc[mi][ni][q * 4], macc[mi][ni][q * 4 + 1], macc[mi][ni][q * 4 + 2], macc[mi][ni][q * 4 + 3]);
      }
    }
  }
}

DEV void run_phase(const P& p, int ph, char* lds) {
  char* U = p.ws + OFF_U;
  bf16_t* Abuf = (bf16_t*)(p.ws + OFF_A);
  bf16_t* Y = (bf16_t*)(U + U_Y);
  if (ph == 0) { phase0(p, lds); return; }
  if (ph == 1) { phase0b(p); return; }
  if (ph == 2) { row_phase(p, false, 0, nullptr, 0, 0.f, 0, true, 0, 0, 0, Abuf); return; }
  const int l = (ph - 3) / 13, s = (ph - 3) % 13;
  const int MTall = T / 128, MTpost = (l == 1) ? TL / 128 : T / 128, rows_post = (l == 1) ? TL : T;
  switch (s) {
    case 0: ffn_gemm1(p, lds, MTall); break;
    case 1: gemm_f32out((const bf16_t*)(U + U_HFF), DFF, (const bf16_t*)(p.ws + OFF_WT + WT_WO), Y, lds, MTall); break;
    case 2: row_phase(p, true, l, Y, 2, 0.5f, 1, true, l, 2, 3, Abuf); conv_mixer(p, l, lds); break;
    case 3: win_gemm(p, l, lds); break;
    case 4: gdn_prep_rows(p, l); mla_prep_gemms(p, lds); break;
    case 5: mixer_phase(p, l, lds); break;
    case 6: readout_phase(p, l); break;
    case 7: merge_gemm(p, lds, MTpost); break;
    case 8: gemm_f32out((const bf16_t*)(U + U_M), 1024, (const bf16_t*)(p.ws + OFF_WT + WT_WOUT), Y, lds, MTpost); break;
    case 9: row_phase(p, true, l, Y, 5, 1.0f, 3, true, l, 4, 6, Abuf, rows_post); conv_ffn(p, l, 1, lds); break;
    case 10: ffn_gemm1(p, lds, MTpost); break;
    case 11: gemm_f32out((const bf16_t*)(U + U_HFF), DFF, (const bf16_t*)(p.ws + OFF_WT + WT_WO), Y, lds, MTpost); break;
    case 12:
      if (l == 0) { row_phase(p, true, 0, Y, 8, 0.5f, 5, true, 1, 0, 0, Abuf); conv_ffn(p, 1, 0, lds); }
      else row_phase(p, true, 1, Y, 8, 0.5f, 5, false, 0, 0, 0, Abuf, TL);
      break;
    default: break;
  }
}
constexpr int NPHASE = 3 + 2 * 13;

template <int PH>
DEV void run_all(const P& p, char* lds, const XcdBarrier& xb) {
  run_phase(p, PH, lds);
  if constexpr (PROBE_SCAN_ONLY != 0 && PH >= 3 && (PH - 3) % 13 == 5) { GRID_SYNC(); if (PROBE_SCAN_ONLY == 1) { if (blockIdx.x < 256) mixer_item(p, blockIdx.x, lds); } else { for (int a = (int)blockIdx.x - 256; a >= 0 && a < 528; a += gridDim.x - 256) mixer_item(p, 256 + a, lds); } }
  if constexpr (PROBE_DUP_S >= 0 && PH >= 3 && ((PH - 3) % 13 == PROBE_DUP_S || (PH - 3) % 13 == PROBE_DUP_S2)) { GRID_SYNC(); run_phase(p, PH, lds); }
  if constexpr (PH + 1 < NPHASE) { GRID_SYNC(); run_all<PH + 1>(p, lds, xb); }
}
#if COOP
__global__ void __launch_bounds__(256, 2) mega(P p) {
  __shared__ __attribute__((aligned(16))) char lds[65536];
  __shared__ uint4 xb_words;
  if (__builtin_amdgcn_workitem_id_x() == 0) xb_words = make_uint4(0u, 0u, 0u, 0u);
  __syncthreads();
  XcdBarrier xb = xcd_barrier_post((unsigned*)(p.ws + OFF_BAR), (volatile LAS unsigned*)&xb_words);
  if (p.ws == nullptr) cg::this_grid().sync();
  run_all<0>(p, lds, xb);
}
#else
template <int PH>
__global__ void __launch_bounds__(256, 2) mega(P p) {
  __shared__ __attribute__((aligned(16))) char lds[65536];
  run_phase(p, PH, lds);
}
template <int PH> void launch_all(const P& p, int grid, hipStream_t stream) {
  hipLaunchKernelGGL(mega<PH>, dim3(grid), dim3(256), 0, stream, p);
  if constexpr (PH + 1 < NPHASE) launch_all<PH + 1>(p, grid, stream);
}
#endif

extern "C" void kernel_launch(void* const* d_in, const int* in_sizes, int n_in, void* d_out, int out_size, void* d_ws, size_t ws_size, hipStream_t stream) {
  if (ws_size < WS_NEED) { fprintf(stderr, "workspace too small: %zu < %zu\n", ws_size, (size_t)WS_NEED); return; }
  P p{};
  const float** pp = (const float**)&p;
  for (int i = 0; i < 22; ++i) pp[i] = (const float*)d_in[i];
  p.out = (float*)d_out; p.ws = (char*)d_ws;
  static int grid_blocks = 0;
  if (!grid_blocks) {
    int dev = 0, cus = 0, per_cu = 0;
    (void)hipGetDevice(&dev);
    (void)hipDeviceGetAttribute(&cus, hipDeviceAttributeMultiprocessorCount, dev);
#if COOP
    (void)hipOccupancyMaxActiveBlocksPerMultiprocessor(&per_cu, mega, 256, 0);
#else
    per_cu = 2;
#endif
    if (per_cu > 2) per_cu = 2;
    if (per_cu < 1) per_cu = 1;
    grid_blocks = cus * per_cu;
  }
#if COOP
  (void)hipMemsetAsync((char*)d_ws + OFF_BAR, 0, BAR_BYTES, stream);
  void* args[] = {&p};
  hipError_t e = hipLaunchCooperativeKernel((void*)mega, dim3(grid_blocks), dim3(256), args, 0, stream);
  if (e != hipSuccess) fprintf(stderr, "cooperative launch failed: %s (grid %d)\n", hipGetErrorString(e), grid_blocks);
#else
  launch_all<0>(p, grid_blocks, stream);
#endif
}
```

```cpp
#include <hip/hip_runtime.h>
#include <hip/hip_cooperative_groups.h>
#include <cstdint>
#include <cstdio>
namespace cg = cooperative_groups;

typedef unsigned short bf16_t;
typedef short bf16x8 __attribute__((ext_vector_type(8)));
typedef float f32x16 __attribute__((ext_vector_type(16)));
typedef float f32x4 __attribute__((ext_vector_type(4)));
typedef float f32x2 __attribute__((ext_vector_type(2)));
typedef unsigned u32x4 __attribute__((ext_vector_type(4)));
typedef unsigned u32x2 __attribute__((ext_vector_type(2)));
#define DEV __device__ __forceinline__

#ifndef COOP
#define COOP 1
#endif
#ifndef PROBE_SCAN_ONLY
#define PROBE_SCAN_ONLY 0
#endif
#ifndef PROBE_DUP_S
#define PROBE_DUP_S -1
#define PROBE_DUP_S2 -1
#endif

constexpr int T = 16896, TL = 16384, NLAT = 8192, NCTX = 256, D = 1024, DFF = 2816;
constexpr int KSP = 8448;
constexpr float EPS = 1e-6f;
constexpr int WIN_LD = 8400;
constexpr int NWIN = 5504;

constexpr size_t SZ(size_t cols, size_t b) { return (size_t)T * cols * b; }
constexpr size_t OFF_BAR = 0, BAR_BYTES = 16384;
constexpr size_t OFF_MODP = BAR_BYTES;
constexpr size_t OFF_MOD  = OFF_MODP + 4ull * 2 * 3 * 9216 * 4;
constexpr size_t OFF_HCTX = OFF_MOD + 2ull * 3 * 9216 * 4;
constexpr size_t OFF_WT   = OFF_HCTX + 512ull * 1024 * 4;
constexpr size_t WT_BYTES = 24ull << 20;
constexpr size_t OFF_A    = OFF_WT + WT_BYTES;
constexpr size_t OFF_U    = OFF_A + SZ(1024, 2);
constexpr size_t U_GQR  = 0;
constexpr size_t U_MQA  = U_GQR + SZ(1536, 2);
constexpr size_t U_MKVA = U_MQA + SZ(384, 2);
constexpr size_t U_GG   = U_MKVA + SZ(256, 2);
constexpr size_t U_GAB  = U_GG + SZ(512, 2);
constexpr size_t U_MKR  = U_GAB + SZ(16, 4);
constexpr size_t U_HQ   = U_MKR + SZ(64, 2);
constexpr size_t U_HK   = U_HQ + SZ(512, 2);
constexpr size_t U_HI   = U_HK + SZ(1024, 2);
constexpr size_t U_HG   = U_HI + SZ(512, 2);
constexpr size_t U_GQ2  = U_HG + SZ(512, 2);
constexpr size_t U_MQ   = U_GQ2 + SZ(1536, 2);
constexpr size_t U_MKN  = U_MQ + SZ(768, 2);
constexpr size_t U_MVT  = U_MKN + SZ(512, 2);
constexpr size_t U_END  = U_MVT + SZ(512, 2);
constexpr size_t U_OGF = U_GQR, U_OGB = U_GQR + SZ(512, 2), U_OHF = U_GQR + SZ(1024, 2), U_OHB = U_MQA;
constexpr size_t OFF_YB = OFF_U + U_END;
constexpr size_t U_ARE = U_HK, U_YA = U_GQ2, U_YC = U_GQ2 + SZ(512, 2), U_M = U_MQ;
constexpr size_t U_HFF = 0;
constexpr size_t U_Y   = SZ(2816, 2);
constexpr size_t WS_NEED = OFF_YB + SZ(512, 2);
static_assert(U_Y + SZ(1024, 4) <= U_M, "Y overlaps M");
constexpr size_t WT_WI = 0, WT_WO = 5632ull * 1024 * 2;
constexpr size_t WT_WIN = 0, WT_WG = (size_t)NWIN * 1024 * 2, WT_WQB = WT_WG + 3072ull * 1024 * 2, WT_WKVB = WT_WQB + 768ull * 384 * 2,
                 WT_WBR = WT_WKVB + 1024ull * 256 * 2, WT_WOUT = WT_WBR + 3ull * 1024 * 512 * 2, WT_MIX_END = WT_WOUT + 1024ull * 1024 * 2;
static_assert(WT_MIX_END <= WT_BYTES, "WT too small");
static_assert(WT_WO + 1024ull * 2816 * 2 <= WT_BYTES, "WT too small");

struct P {
  const float *x, *c, *ctx, *c_ctx, *w_ada, *b_ada, *norm_w, *ffn_w_in, *ffn_w_out, *w_in, *gdn_conv, *gdn_a_log, *gdn_dt_bias, *gdn_norm,
      *mla_q_norm, *mla_kv_norm, *mla_w_q_b, *mla_w_kv_b, *hg_lb, *hg_norm, *w_branch, *w_out;
  float* out; char* ws;
};

DEV unsigned pk2(float lo, float hi) {
  typedef __bf16 bf2 __attribute__((ext_vector_type(2)));
  f32x2 v = {lo, hi};
  bf2 b = __builtin_convertvector(v, bf2);
  return __builtin_bit_cast(unsigned, b);
}
DEV bf16_t f2bf(float x) { return (bf16_t)(pk2(x, 0.f) & 0xffffu); }
DEV float bflo(unsigned w) { return __uint_as_float(w << 16); }
DEV float bfhi(unsigned w) { return __uint_as_float(w & 0xffff0000u); }
DEV float bf2f(bf16_t h) { return __uint_as_float((unsigned)h << 16); }
DEV void st4bf(bf16_t* dst, float a, float b, float c, float d) { u32x2 w = {pk2(a, b), pk2(c, d)}; *(u32x2*)dst = w; }
DEV float sigmoidf_(float x) { return 1.f / (1.f + __expf(-x)); }
DEV float siluf_(float x) { return x / (1.f + __expf(-x)); }
DEV float wave_sum(float v) {
#pragma unroll
  for (int o = 32; o > 0; o >>= 1) v += __shfl_xor(v, o);
  return v;
}
DEV float sum16(float v) {
#pragma unroll
  for (int o = 8; o > 0; o >>= 1) v += __shfl_xor(v, o);
  return v;
}
DEV float rowsum16(float x) {
  x += __int_as_float(__builtin_amdgcn_update_dpp(0, __float_as_int(x), 0xB1, 0xf, 0xf, true));
  x += __int_as_float(__builtin_amdgcn_update_dpp(0, __float_as_int(x), 0x4E, 0xf, 0xf, true));
  x += __int_as_float(__builtin_amdgcn_update_dpp(0, __float_as_int(x), 0x141, 0xf, 0xf, true));
  x += __int_as_float(__builtin_amdgcn_update_dpp(0, __float_as_int(x), 0x140, 0xf, 0xf, true));
  return x;
}
DEV int TIDX() { int t = __builtin_amdgcn_workitem_id_x(); asm volatile("" : "+v"(t)); return t; }
DEV int sel_of(int r) { return r < TL ? (r >> 13) : 2; }
DEV int kx_of(int r) { return r < TL ? (r & 8191) : 8192 + ((r - TL) & 255); }
DEV int batch_of(int r) { return r < TL ? (r >> 13) : ((r - TL) >> 8); }
DEV int swz(int row, int ch) { return row * 128 + (((ch ^ (row >> 1)) & 7) << 4); }


DEV int vblock() { const int G = gridDim.x, j = blockIdx.x; return (G & 7) ? j : (j & 7) * (G >> 3) + (j >> 3); }
DEV void tile_map(int idx, int MT, int NT, int& mt, int& nt) {
  const int nig = 8 * NT, g = idx / nig, fm = g * 8, gsz = (MT - fm) < 8 ? (MT - fm) : 8, r = idx - g * nig;
  mt = fm + r % gsz; nt = r / gsz;
}


#define XB_TMO      128
#define XB_XCNT(j)  (256  + 64 * (j))
#define XB_XSUB(j)  (1280 + 64 * (j))
#define XB_XGEN(j)  (2304 + 64 * (j))
#define XB_TOP      3328
#define XB_TOPGEN   3392
#define XCD_BAR_WORDS 3456
#define XB_SPIN_CAP (1u << 22)
#define LAS __attribute__((address_space(3)))
static_assert(XCD_BAR_WORDS * 4 <= BAR_BYTES, "barrier words");
DEV unsigned xb_ld(unsigned* p) { return __hip_atomic_load(p, __ATOMIC_RELAXED, __HIP_MEMORY_SCOPE_AGENT); }
DEV unsigned xb_add(unsigned* p, unsigned v) { return __hip_atomic_fetch_add(p, v, __ATOMIC_RELAXED, __HIP_MEMORY_SCOPE_AGENT); }
DEV unsigned xb_xcc_id() { return (unsigned)__builtin_amdgcn_s_getreg((3 << 11) | 20) & 0xFu; }
#define XB_SPIN(cond, bar) do { unsigned _sp = 0; while (cond) { __builtin_amdgcn_s_sleep(1); \
    if ((++_sp & 255u) == 0u) { if (xb_ld(&(bar)[XB_TMO])) break; if (_sp > XB_SPIN_CAP) { atomicAdd(&(bar)[XB_TMO], 1u); break; } } } } while (0)
struct XcdBarrier { unsigned* bar; unsigned x; volatile LAS unsigned* st; };
DEV XcdBarrier xcd_barrier_post(unsigned* bar, volatile LAS unsigned* st) {
  XcdBarrier b; b.bar = bar; b.x = xb_xcc_id(); b.st = st;
  if (__builtin_amdgcn_workitem_id_x() == 0) (void)xb_add(&bar[XB_XCNT(b.x)], 1u);
  return b;
}
DEV void xcd_barrier_complete(unsigned* bar, unsigned x, unsigned& nloc, unsigned& nx) {
  const unsigned G = gridDim.x;
  unsigned sum, cnt, mine, sp = 0u;
  for (;;) {
    sum = 0u; cnt = 0u; mine = 0u;
#pragma unroll
    for (unsigned j = 0; j < 16; ++j) { const unsigned c = xb_ld(&bar[XB_XCNT(j)]); sum += c; cnt += (c > 0u) ? 1u : 0u; mine = (j == x) ? c : mine; }
    if (sum == G) break;
    __builtin_amdgcn_s_sleep(1);
    if ((++sp & 255u) == 0u) { if (xb_ld(&bar[XB_TMO])) break; if (sp > XB_SPIN_CAP) { atomicAdd(&bar[XB_TMO], 1u); break; } }
  }
  nloc = mine > 0u ? mine : 1u; nx = cnt > 0u ? cnt : 1u;
}
DEV void xcd_barrier(const XcdBarrier& b) {
  asm volatile("s_waitcnt vmcnt(0)" ::: "memory");
  __syncthreads();
  if (__builtin_amdgcn_workitem_id_x() == 0) {
    unsigned* bar = b.bar;
    __builtin_amdgcn_s_waitcnt(0);
    unsigned nloc = b.st[0], nx = b.st[1];
    if (nloc == 0u) { xcd_barrier_complete(bar, b.x, nloc, nx); b.st[0] = nloc; b.st[1] = nx; }
    const unsigned old = xb_add(&bar[XB_XSUB(b.x)], 1u);
    const unsigned gen = old / nloc;
    if (old + 1u == (gen + 1u) * nloc) {
      __builtin_amdgcn_fence(__ATOMIC_RELEASE, "agent");
      asm volatile("s_waitcnt vmcnt(0)" ::: "memory");
      const unsigned og = xb_add(&bar[XB_TOP], 1u);
      const unsigned tg = og / nx;
      if (og + 1u == (tg + 1u) * nx) xb_add(&bar[XB_TOPGEN], 1u);
      else XB_SPIN(xb_ld(&bar[XB_TOPGEN]) == tg, bar);
      __builtin_amdgcn_fence(__ATOMIC_ACQUIRE, "agent");
      xb_add(&bar[XB_XGEN(b.x)], 1u);
      asm volatile("s_waitcnt vmcnt(0)" ::: "memory");
    } else {
      XB_SPIN(xb_ld(&bar[XB_XGEN(b.x)]) == gen, bar);
      __builtin_amdgcn_fence(__ATOMIC_ACQUIRE, "agent");
      asm volatile("s_waitcnt vmcnt(0)" ::: "memory");
    }
  }
  __syncthreads();
}

#if COOP
#define GRID_SYNC() xcd_barrier(xb)
#else
#define GRID_SYNC()
#endif

template <int BN>
DEV void gemm_core_reg(const bf16_t* __restrict__ A, int lda, const bf16_t* __restrict__ B, int ldb, int K, f32x16 (&acc)[2][BN / 64], char* lds) {
  constexpr int NB = BN / 64, NBL = BN / 32;
  constexpr int A_BYTES = 128 * 128, ST = A_BYTES + BN * 128;
  const int tid = TIDX(), lane = tid & 63, wid = tid >> 6, wr = wid >> 1, wc = wid & 1;
  const int lrow = tid >> 3, lch = tid & 7;
  u32x4 ra[2][4], rb[2][NBL];
  const bf16_t* ap = A + (size_t)lrow * lda + lch * 8;
  const bf16_t* bp = B + (size_t)lrow * ldb + lch * 8;
  const int nk = K >> 6;
#define GC_LOAD(set, k0) do { _Pragma("unroll") for (int i = 0; i < 4; ++i) ra[set][i] = *(const u32x4*)(ap + (size_t)(32 * i) * lda + (k0)); \
    _Pragma("unroll") for (int i = 0; i < NBL; ++i) rb[set][i] = *(const u32x4*)(bp + (size_t)(32 * i) * ldb + (k0)); } while (0)
#define GC_STORE(stage, set) do { char* st_ = lds + (stage) * ST; _Pragma("unroll") for (int i = 0; i < 4; ++i) *(u32x4*)(st_ + swz(lrow + 32 * i, lch)) = ra[set][i]; \
    _Pragma("unroll") for (int i = 0; i < NBL; ++i) *(u32x4*)(st_ + A_BYTES + swz(lrow + 32 * i, lch)) = rb[set][i]; } while (0)
#define GC_COMPUTE(stage) do { const char* cur = lds + (stage) * ST; _Pragma("unroll") for (int ks = 0; ks < 4; ++ks) { const int ch = ks * 2 + (lane >> 5); bf16x8 af[2], bfr[NB]; \
    _Pragma("unroll") for (int mi = 0; mi < 2; ++mi) af[mi] = *(const bf16x8*)(cur + swz(wr * 64 + mi * 32 + (lane & 31), ch)); \
    _Pragma("unroll") for (int ni = 0; ni < NB; ++ni) bfr[ni] = *(const bf16x8*)(cur + A_BYTES + swz(wc * (BN / 2) + ni * 32 + (lane & 31), ch)); \
    _Pragma("unroll") for (int mi = 0; mi < 2; ++mi) _Pragma("unroll") for (int ni = 0; ni < NB; ++ni) acc[mi][ni] = __builtin_amdgcn_mfma_f32_32x32x16_bf16(bfr[ni], af[mi], acc[mi][ni], 0, 0, 0); } } while (0)
  GC_LOAD(0, 0);
  GC_STORE(0, 0);
  if (nk > 1) GC_LOAD(1, 64);
  __syncthreads();
  for (int kt = 0; kt < nk; kt += 2) {
    if (kt + 2 < nk) GC_LOAD(0, (kt + 2) * 64);
    __builtin_amdgcn_sched_barrier(0);
    GC_COMPUTE(0);
    __builtin_amdgcn_sched_barrier(0);
    if (kt + 1 < nk) GC_STORE(1, 1);
    __syncthreads();
    if (kt + 1 >= nk) break;
    if (kt + 3 < nk) GC_LOAD(1, (kt + 3) * 64);
    __builtin_amdgcn_sched_barrier(0);
    GC_COMPUTE(1);
    __builtin_amdgcn_sched_barrier(0);
    if (kt + 2 < nk) GC_STORE(0, 0);
    __syncthreads();
  }
#undef GC_LOAD
#undef GC_STORE
#undef GC_COMPUTE
}
#define LDSAS __attribute__((address_space(3)))
template <int N> DEV void wait_vmcnt() { asm volatile("s_waitcnt vmcnt(%0)" ::"n"(N) : "memory"); }
template <int BN>
DEV void gemm_core(const bf16_t* __restrict__ A, int lda, const bf16_t* __restrict__ B, int ldb, int K, f32x16 (&acc)[2][BN / 64], char* lds) {
  constexpr int NB = BN / 64, NPB = BN / 32;
  constexpr int NP = 4 + NPB;
  constexpr int A_BYTES = 128 * 128, ST = A_BYTES + BN * 128;
  const int tid = TIDX(), lane = tid & 63, wid = __builtin_amdgcn_readfirstlane(tid >> 6), wr = wid >> 1, wc = wid & 1;
  LDSAS char* l3 = (LDSAS char*)lds;
  unsigned offA[4], offB[NPB];
#pragma unroll
  for (int i = 0; i < 4; ++i) { const int row = (wid * 4 + i) * 8 + (lane >> 3); offA[i] = (unsigned)(row * lda + (((lane & 7) ^ ((row >> 1) & 7)) << 3)) * 2u; }
#pragma unroll
  for (int i = 0; i < NPB; ++i) { const int row = (wid * NPB + i) * 8 + (lane >> 3); offB[i] = (unsigned)(row * ldb + (((lane & 7) ^ ((row >> 1) & 7)) << 3)) * 2u; }
  const int nk = K >> 6;
#define GD_ISSUE(stage, kt_) do { const char* ga_ = (const char*)A + (size_t)(kt_) * 128; const char* gb_ = (const char*)B + (size_t)(kt_) * 128; \
    _Pragma("unroll") for (int i = 0; i < 4; ++i) __builtin_amdgcn_global_load_lds((const unsigned*)(ga_ + offA[i]), (LDSAS unsigned*)(l3 + (stage) * ST + (wid * 4 + i) * 1024), 16, 0, 0); \
    _Pragma("unroll") for (int i = 0; i < NPB; ++i) __builtin_amdgcn_global_load_lds((const unsigned*)(gb_ + offB[i]), (LDSAS unsigned*)(l3 + (stage) * ST + A_BYTES + (wid * NPB + i) * 1024), 16, 0, 0); } while (0)
  wait_vmcnt<0>();
  GD_ISSUE(0, 0);
  if (nk > 1) { GD_ISSUE(1, 1); wait_vmcnt<NP>(); } else wait_vmcnt<0>();
  __builtin_amdgcn_s_barrier(); asm volatile("" ::: "memory");
  for (int kt = 0; kt < nk; ++kt) {
    const char* cur = lds + (kt & 1) * ST;
#pragma unroll
    for (int ks = 0; ks < 4; ++ks) {
      const int ch = ks * 2 + (lane >> 5);
      bf16x8 af[2], bfr[NB];
#pragma unroll
      for (int mi = 0; mi < 2; ++mi) af[mi] = *(const bf16x8*)(cur + swz(wr * 64 + mi * 32 + (lane & 31), ch));
#pragma unroll
      for (int ni = 0; ni < NB; ++ni) bfr[ni] = *(const bf16x8*)(cur + A_BYTES + swz(wc * (BN / 2) + ni * 32 + (lane & 31), ch));
#pragma unroll
      for (int mi = 0; mi < 2; ++mi)
#pragma unroll
        for (int ni = 0; ni < NB; ++ni) acc[mi][ni] = __builtin_amdgcn_mfma_f32_32x32x16_bf16(bfr[ni], af[mi], acc[mi][ni], 0, 0, 0);
    }
    asm volatile("s_waitcnt lgkmcnt(0)" ::: "memory");
    __builtin_amdgcn_s_barrier(); asm volatile("" ::: "memory");
    if (kt + 2 < nk) { GD_ISSUE(kt & 1, kt + 2); wait_vmcnt<NP>(); }
    else wait_vmcnt<0>();
    __builtin_amdgcn_s_barrier(); asm volatile("" ::: "memory");
  }
#undef GD_ISSUE
}
template <int NB>
DEV void zero_acc(f32x16 (&acc)[2][NB]) {
#pragma unroll
  for (int a = 0; a < 2; ++a)
#pragma unroll
    for (int b = 0; b < NB; ++b)
#pragma unroll
      for (int i = 0; i < 16; ++i) acc[a][b][i] = 0.f;
}

struct Cv { const float* src; int ld; int K; int Np; int kind; const float* ks; bf16_t* dst; };
DEV int cv_map(int kind, int n) {
  if (kind == 0) return n;
  if (kind == 1) { const int g = n >> 6, r = n & 63; return r < 32 ? g * 32 + r : 2816 + g * 32 + (r - 32); }
  if (kind == 2) {
    if (n < 2064) return n;
    if (n < 2176) return -1;
    if (n < 2880) return 2064 + (n - 2176);
    if (n < 2944) return -1;
    return 2768 + (n - 2944);
  }
  return 5328 + n;
}
DEV void cv_run(const Cv c, char* lds) {
  float* tile = (float*)lds;
  const int tid = TIDX();
  const int nkt = c.K >> 6, ntile = nkt * (c.Np >> 6);
  for (int t = blockIdx.x; t < ntile; t += gridDim.x) {
    const int k0 = (t % nkt) * 64, n0 = (t / nkt) * 64;
    const int nn = tid & 63, src_n = cv_map(c.kind, n0 + nn);
#pragma unroll
    for (int i = 0; i < 16; ++i) {
      const int k = i * 4 + (tid >> 6);
      float v = 0.f;
      if (src_n >= 0) { v = c.src[(size_t)(k0 + k) * c.ld + src_n]; if (c.ks) v *= c.ks[k0 + k]; }
      tile[k * 65 + nn] = v;
    }
    __syncthreads();
#pragma unroll
    for (int i = 0; i < 16; ++i) {
      const int n = i * 4 + (tid >> 6), k = tid & 63;
      c.dst[(size_t)(n0 + n) * c.K + k0 + k] = f2bf(tile[k * 65 + n]);
    }
    __syncthreads();
  }
}
DEV void conv_ffn(const P& p, int l, int f, char* lds) {
  bf16_t* wt = (bf16_t*)(p.ws + OFF_WT);
  Cv a = {p.ffn_w_in + (size_t)(l * 2 + f) * 1024 * 5632, 5632, 1024, 5632, 1, nullptr, (bf16_t*)((char*)wt + WT_WI)};
  cv_run(a, lds);
  Cv b = {p.ffn_w_out + (size_t)(l * 2 + f) * 2816 * 1024, 1024, 2816, 1024, 0, nullptr, (bf16_t*)((char*)wt + WT_WO)};
  cv_run(b, lds);
}
DEV void conv_mixer(const P& p, int l, char* lds) {
  char* wt = p.ws + OFF_WT;
  const float* win = p.w_in + (size_t)l * 1024 * WIN_LD;
  Cv a = {win, WIN_LD, 1024, NWIN, 2, nullptr, (bf16_t*)(wt + WT_WIN)}; cv_run(a, lds);
  Cv b = {win, WIN_LD, 1024, 3072, 3, nullptr, (bf16_t*)(wt + WT_WG)}; cv_run(b, lds);
  Cv c = {p.mla_w_q_b + (size_t)l * 384 * 768, 768, 384, 768, 0, p.mla_q_norm + l * 384, (bf16_t*)(wt + WT_WQB)}; cv_run(c, lds);
  Cv d = {p.mla_w_kv_b + (size_t)l * 256 * 1024, 1024, 256, 1024, 0, p.mla_kv_norm + l * 256, (bf16_t*)(wt + WT_WKVB)}; cv_run(d, lds);
#pragma unroll 1
  for (int j = 0; j < 3; ++j) {
    Cv e = {p.w_branch + (size_t)(l * 3 + j) * 512 * 1024, 1024, 512, 1024, 0, nullptr, (bf16_t*)(wt + WT_WBR) + (size_t)j * 1024 * 512};
    cv_run(e, lds);
  }
  Cv f = {p.w_out + (size_t)l * 1024 * 1024, 1024, 1024, 1024, 0, nullptr, (bf16_t*)(wt + WT_WOUT)}; cv_run(f, lds);
}

DEV void phase0(const P& p, char* lds) {
  const int tid = TIDX();
  {
    const f32x4* s = (const f32x4*)p.x; f32x4* d = (f32x4*)p.out;
    const size_t n = (size_t)TL * D / 4;
    for (size_t i = (size_t)blockIdx.x * 256 + tid; i < n; i += (size_t)gridDim.x * 256) d[i] = s[i];
    const f32x4* s2 = (const f32x4*)p.ctx; f32x4* d2 = (f32x4*)(p.ws + OFF_HCTX);
    const size_t n2 = 512ull * D / 4;
    for (size_t i = (size_t)blockIdx.x * 256 + tid; i < n2; i += (size_t)gridDim.x * 256) d2[i] = s2[i];
  }
  {
    float* sv = (float*)lds;
    float* modp = (float*)(p.ws + OFF_MODP);
    for (int t = blockIdx.x; t < 2 * 36 * 4; t += gridDim.x) {
      const int ks = t & 3, cb = (t >> 2) % 36, l = t / 144;
      __syncthreads();
      {
        const int k = ks * 256 + tid;
        sv[tid] = siluf_(p.c[k]); sv[256 + tid] = siluf_(p.c[1024 + k]); sv[512 + tid] = siluf_(p.c_ctx[k]);
      }
      __syncthreads();
      const int col = cb * 256 + tid;
      const float* w = p.w_ada + ((size_t)l * 1024 + ks * 256) * 9216 + col;
      float a0 = 0.f, a1 = 0.f, a2 = 0.f;
#pragma unroll 8
      for (int k = 0; k < 256; ++k) { const float wv = w[(size_t)k * 9216]; a0 += sv[k] * wv; a1 += sv[256 + k] * wv; a2 += sv[512 + k] * wv; }
      float* o = modp + ((size_t)(ks * 2 + l) * 3) * 9216 + col;
      o[0] = a0; o[9216] = a1; o[2 * 9216] = a2;
    }
    __syncthreads();
  }
  conv_ffn(p, 0, 0, lds);
}
DEV void phase0b(const P& p) {
  const float* modp = (const float*)(p.ws + OFF_MODP);
  float* mod = (float*)(p.ws + OFF_MOD);
  for (int i = blockIdx.x * 256 + TIDX(); i < 2 * 3 * 9216; i += gridDim.x * 256) {
    const int col = i % 9216, l = i / (3 * 9216);
    float v = p.b_ada[l * 9216 + col];
#pragma unroll
    for (int ks = 0; ks < 4; ++ks) v += modp[(size_t)ks * 2 * 3 * 9216 + i];
    mod[i] = v;
  }
}

DEV void row_phase(const P& p, bool do_post, int l_post, const bf16_t* __restrict__ Y, int gate_idx, float gate_mul, int postw_idx,
                   bool do_pre, int l_pre, int prew_idx, int shift_idx, bf16_t* __restrict__ Aout, int nrows = T) {
  const float* mod = (const float*)(p.ws + OFF_MOD);
  float* hctx = (float*)(p.ws + OFF_HCTX);
  const int lane = TIDX() & 63, wid = TIDX() >> 6;
  const int NW = gridDim.x * 4, g = blockIdx.x * 4 + wid;
  f32x4 pwv[4], gtv[4], nwv[4], shv[4], scv[4];
  int cursel = -1;
  const int latrows = nrows < TL ? nrows : TL;
  const int rpw = (latrows + NW - 1) / NW;
  const int lat_lo = g * rpw, lat_hi = (lat_lo + rpw) < latrows ? (lat_lo + rpw) : latrows;
  const int nlat = lat_hi > lat_lo ? lat_hi - lat_lo : 0;
  const int nctx = (nrows > TL && TL + g < nrows) ? (nrows - TL - g + NW - 1) / NW : 0;
  const int total = nlat + nctx;
  for (int it = 0; it < total; it += 2) {
    int rr[2]; bool ok[2];
#pragma unroll
    for (int k = 0; k < 2; ++k) { const int i = it + k; ok[k] = i < total; rr[k] = i < nlat ? lat_lo + i : TL + g + (i - nlat) * NW; }
    f32x4 h[2][4]; u32x2 yw[2][4];
#pragma unroll
    for (int k = 0; k < 2; ++k) {
      if (!ok[k]) break;
      const int r = rr[k];
      const float* hrow = r < TL ? p.out + (size_t)r * D : hctx + (size_t)(r - TL) * D;
#pragma unroll
      for (int i = 0; i < 4; ++i) h[k][i] = *(const f32x4*)(hrow + i * 256 + lane * 4);
      if (do_post) {
#pragma unroll
        for (int i = 0; i < 4; ++i) yw[k][i] = *(const u32x2*)(Y + (size_t)r * D + i * 256 + lane * 4);
      }
    }
#pragma unroll
    for (int k = 0; k < 2; ++k) {
      if (!ok[k]) break;
      const int r = rr[k];
      float* hrow = r < TL ? p.out + (size_t)r * D : hctx + (size_t)(r - TL) * D;
      const int sel = sel_of(r);
      if (sel != cursel) {
        cursel = sel;
        if (do_post) {
          const float* pw = p.norm_w + (size_t)(l_post * 6 + postw_idx) * 1024;
          const float* gt = mod + ((size_t)(l_post * 3 + sel) * 9 + gate_idx) * 1024;
#pragma unroll
          for (int i = 0; i < 4; ++i) { pwv[i] = *(const f32x4*)(pw + i * 256 + lane * 4); gtv[i] = *(const f32x4*)(gt + i * 256 + lane * 4) * gate_mul; }
        }
        if (do_pre) {
          const float* nw = p.norm_w + (size_t)(l_pre * 6 + prew_idx) * 1024;
          const float* sh = mod + ((size_t)(l_pre * 3 + sel) * 9 + shift_idx) * 1024;
#pragma unroll
          for (int i = 0; i < 4; ++i) { nwv[i] = *(const f32x4*)(nw + i * 256 + lane * 4); shv[i] = *(const f32x4*)(sh + i * 256 + lane * 4); scv[i] = 1.f + *(const f32x4*)(sh + 1024 + i * 256 + lane * 4); }
        }
      }
      if (do_post) {
        f32x4 y[4]; float ss = 0.f;
#pragma unroll
        for (int i = 0; i < 4; ++i) { y[i] = (f32x4){bflo(yw[k][i][0]), bfhi(yw[k][i][0]), bflo(yw[k][i][1]), bfhi(yw[k][i][1])}; ss += y[i][0] * y[i][0] + y[i][1] * y[i][1] + y[i][2] * y[i][2] + y[i][3] * y[i][3]; }
        ss = wave_sum(ss);
        const float rs = rsqrtf(ss * (1.f / 1024.f) + EPS);
#pragma unroll
        for (int i = 0; i < 4; ++i) {
          h[k][i] += gtv[i] * (y[i] * rs * pwv[i]);
          *(f32x4*)(hrow + i * 256 + lane * 4) = h[k][i];
        }
      }
      if (do_pre) {
        float ss = 0.f;
#pragma unroll
        for (int i = 0; i < 4; ++i) ss += h[k][i][0] * h[k][i][0] + h[k][i][1] * h[k][i][1] + h[k][i][2] * h[k][i][2] + h[k][i][3] * h[k][i][3];
        ss = wave_sum(ss);
        const float rs = rsqrtf(ss * (1.f / 1024.f) + EPS);
#pragma unroll
        for (int i = 0; i < 4; ++i) {
          const f32x4 v = (h[k][i] * rs * nwv[i]) * scv[i] + shv[i];
          st4bf(Aout + (size_t)r * D + i * 256 + lane * 4, v[0], v[1], v[2], v[3]);
        }
      }
    }
  }
}

DEV void ffn_gemm1(const P& p, char* lds, int MT) {
  const bf16_t* A = (const bf16_t*)(p.ws + OFF_A);
  const bf16_t* W = (const bf16_t*)(p.ws + OFF_WT + WT_WI);
  bf16_t* H = (bf16_t*)(p.ws + OFF_U + U_HFF);
  const int lane = TIDX() & 63, wid = TIDX() >> 6, wr = wid >> 1, wc = wid & 1, h2 = lane >> 5;
  constexpr int NT = 5632 / 128;
  for (int t = vblock(); t < MT * NT; t += gridDim.x) {
    int mt, nt; tile_map(t, MT, NT, mt, nt);
    f32x16 acc[2][2]; zero_acc<2>(acc);
    gemm_core<128>(A + (size_t)mt * 128 * 1024, 1024, W + (size_t)nt * 128 * 1024, 1024, 1024, acc, lds);
#pragma unroll
    for (int mi = 0; mi < 2; ++mi) {
      const int row = mt * 128 + wr * 64 + mi * 32 + (lane & 31);
      bf16_t* dst = H + (size_t)row * DFF + (nt * 2 + wc) * 32 + 4 * h2;
#pragma unroll
      for (int q = 0; q < 4; ++q) {
        float v[4];
#pragma unroll
        for (int j = 0; j < 4; ++j) v[j] = siluf_(acc[mi][0][q * 4 + j]) * acc[mi][1][q * 4 + j];
        st4bf(dst + 8 * q, v[0], v[1], v[2], v[3]);
      }
    }
  }
}
DEV void gemm_f32out(const bf16_t* A, int K, const bf16_t* W, bf16_t* Y, char* lds, int MT) {
  const int lane = TIDX() & 63, wid = TIDX() >> 6, wr = wid >> 1, wc = wid & 1, h2 = lane >> 5;
  constexpr int NT = 1024 / 128;
  for (int t = vblock(); t < MT * NT; t += gridDim.x) {
    int mt, nt; tile_map(t, MT, NT, mt, nt);
    f32x16 acc[2][2]; zero_acc<2>(acc);
    gemm_core<128>(A + (size_t)mt * 128 * K, K, W + (size_t)nt * 128 * K, K, K, acc, lds);
#pragma unroll
    for (int mi = 0; mi < 2; ++mi) {
      const int row = mt * 128 + wr * 64 + mi * 32 + (lane & 31);
#pragma unroll
      for (int ni = 0; ni < 2; ++ni) {
        bf16_t* dst = Y + (size_t)row * D + nt * 128 + wc * 64 + ni * 32 + 4 * h2;
#pragma unroll
        for (int q = 0; q < 4; ++q) st4bf(dst + 8 * q, acc[mi][ni][q * 4], acc[mi][ni][q * 4 + 1], acc[mi][ni][q * 4 + 2], acc[mi][ni][q * 4 + 3]);
      }
    }
  }
}

DEV void rope32(f32x16& v, int a, int r, int h2) {
  if (r >= TL) return;
  const int n = r & 8191;
  const float pos = (float)(a == 0 ? (n >> 6) : (n & 63));
#pragma unroll
  for (int reg = 0; reg < 8; ++reg) {
    const int f = (reg & 3) + 8 * (reg >> 2) + 4 * h2;
    const float inv = __builtin_amdgcn_exp2f(-(float)f * (13.287712379549449f / 16.f));
    const float ang = pos * inv;
    const float c = __cosf(ang), s = __sinf(ang);
    const float x1 = v[reg], x2 = v[reg + 8];
    v[reg] = x1 * c - x2 * s;
    v[reg + 8] = x2 * c + x1 * s;
  }
}

DEV void win_gemm(const P& p, int l, char* lds) {
  const bf16_t* A = (const bf16_t*)(p.ws + OFF_A);
  const bf16_t* W = (const bf16_t*)(p.ws + OFF_WT + WT_WIN);
  char* U = p.ws + OFF_U;
  bf16_t *GQR = (bf16_t*)(U + U_GQR), *GG = (bf16_t*)(U + U_GG), *MQA = (bf16_t*)(U + U_MQA), *MKVA = (bf16_t*)(U + U_MKVA), *MKR = (bf16_t*)(U + U_MKR),
         *HQ = (bf16_t*)(U + U_HQ), *HK = (bf16_t*)(U + U_HK), *HI = (bf16_t*)(U + U_HI), *HG = (bf16_t*)(U + U_HG);
  float* GAB = (float*)(U + U_GAB);
  const int lane = TIDX() & 63, wid = TIDX() >> 6, wr = wid >> 1, wc = wid & 1, h2 = lane >> 5;
  constexpr int MT = T / 128, NT = NWIN / 128;
  for (int t = vblock(); t < MT * NT; t += gridDim.x) {
    int mt, nt; tile_map(t, MT, NT, mt, nt);
    f32x16 acc[2][2]; zero_acc<2>(acc);
    gemm_core<128>(A + (size_t)mt * 128 * 1024, 1024, W + (size_t)nt * 128 * 1024, 1024, 1024, acc, lds);
#pragma unroll
    for (int ni = 0; ni < 2; ++ni) {
      const int nb = nt * 128 + wc * 64 + ni * 32;
#pragma unroll
      for (int mi = 0; mi < 2; ++mi) {
        const int row = mt * 128 + wr * 64 + mi * 32 + (lane & 31);
        f32x16 v = acc[mi][ni];
        bf16_t* dst = nullptr;
        if (nb < 1536) dst = GQR + (size_t)row * 1536 + nb;
        else if (nb < 2048) dst = GG + (size_t)row * 512 + (nb - 1536);
        else if (nb == 2048) {
#pragma unroll
          for (int reg = 0; reg < 16; ++reg) {
            const int c = (reg & 3) + 8 * (reg >> 2) + 4 * h2;
            if (c < 8) {
              const float al = p.gdn_a_log[l * 8 + c], dtb = p.gdn_dt_bias[l * 8 + c];
              const float xx = v[reg] + dtb;
              const float sp = xx > 20.f ? xx : log1pf(__expf(xx));
              GAB[(size_t)row * 16 + c] = -__expf(al) * sp;
            } else if (c < 16) {
              GAB[(size_t)row * 16 + c] = sigmoidf_(v[reg]);
            }
          }
        }
        else if (nb < 2176) {}
        else if (nb < 2560) dst = MQA + (size_t)row * 384 + (nb - 2176);
        else if (nb < 2816) dst = MKVA + (size_t)row * 256 + (nb - 2560);
        else if (nb < 2880) { rope32(v, (nb - 2816) >> 5, row, h2); dst = MKR + (size_t)row * 64 + (nb - 2816); }
        else if (nb < 2944) {}
        else if (nb < 3456) { v = v * 0.08838834764831845f; dst = HQ + (size_t)row * 512 + (nb - 2944); }
        else if (nb < 4480) {
          const int cb = nb - 3456;
#pragma unroll
          for (int reg = 0; reg < 16; ++reg) {
            const int c = cb + (reg & 3) + 8 * (reg >> 2) + 4 * h2;
            float lb = 0.f;
            if (l == 1) lb = sigmoidf_(p.hg_lb[1024 + c] - p.hg_lb[c]);
            v[reg] = (1.f - lb) * sigmoidf_(-v[reg]);
          }
          dst = HK + (size_t)row * 1024 + cb;
        }
        else if (nb < 4992) dst = HI + (size_t)row * 512 + (nb - 4480);
        else dst = HG + (size_t)row * 512 + (nb - 4992);
        if (dst) {
          dst += 4 * h2;
#pragma unroll
          for (int q = 0; q < 4; ++q) st4bf(dst + 8 * q, v[q * 4], v[q * 4 + 1], v[q * 4 + 2], v[q * 4 + 3]);
        }
      }
    }
  }
}

DEV void gdn_prep_rows(const P& p, int l) {
  char* U = p.ws + OFF_U;
  const bf16_t* GQR = (const bf16_t*)(U + U_GQR);
  bf16_t* GQ2 = (bf16_t*)(U + U_GQ2);
  const float* cw = p.gdn_conv + (size_t)l * 3 * 1536;
  const int lane = TIDX() & 63, wid = TIDX() >> 6;
  const int stride = gridDim.x * 4;
  float cwr[3][3][8];
#pragma unroll
  for (int j = 0; j < 3; ++j)
#pragma unroll
    for (int tp = 0; tp < 3; ++tp)
#pragma unroll
      for (int i = 0; i < 8; ++i) cwr[j][tp][i] = cw[tp * 1536 + j * 512 + lane * 8 + i];
  for (int r0 = blockIdx.x * 4 + wid; r0 < T; r0 += 2 * stride) {
    const bool two = r0 + stride < T;
    u32x4 xc[2][3], xp[2][3], xn[2][3];
#pragma unroll
    for (int k = 0; k < 2; ++k) {
      if (k == 1 && !two) break;
      const int r = r0 + k * stride;
      bool hp, hn;
      if (r < TL) { const int n = r & 8191; hp = n > 0; hn = n < 8191; } else { const int tt = (r - TL) & 255; hp = tt > 0; hn = tt < 255; }
      const u32x4 z = {0u, 0u, 0u, 0u};
#pragma unroll
      for (int j = 0; j < 3; ++j) {
        const int c0 = j * 512 + lane * 8;
        xc[k][j] = *(const u32x4*)(GQR + (size_t)r * 1536 + c0);
        xp[k][j] = hp ? *(const u32x4*)(GQR + (size_t)(r - 1) * 1536 + c0) : z;
        xn[k][j] = hn ? *(const u32x4*)(GQR + (size_t)(r + 1) * 1536 + c0) : z;
      }
    }
#pragma unroll
    for (int k = 0; k < 2; ++k) {
      if (k == 1 && !two) break;
      const int r = r0 + k * stride;
#pragma unroll
      for (int j = 0; j < 3; ++j) {
        const int c0 = j * 512 + lane * 8;
        float val[8]; float ss = 0.f;
#pragma unroll
        for (int i = 0; i < 8; ++i) {
          const unsigned wp = xp[k][j][i >> 1], wcur = xc[k][j][i >> 1], wn = xn[k][j][i >> 1];
          const float fp = (i & 1) ? bfhi(wp) : bflo(wp), fc = (i & 1) ? bfhi(wcur) : bflo(wcur), fn = (i & 1) ? bfhi(wn) : bflo(wn);
          const float sv = fp * cwr[j][0][i] + fc * cwr[j][1][i] + fn * cwr[j][2][i];
          val[i] = siluf_(sv); ss += val[i] * val[i];
        }
        if (j < 2) {
          ss = sum16(ss);
          float sc = rsqrtf(ss + EPS);
          if (j == 0) sc *= 0.08838834764831845f;
#pragma unroll
          for (int i = 0; i < 8; ++i) val[i] *= sc;
        }
        u32x4 o = {pk2(val[0], val[1]), pk2(val[2], val[3]), pk2(val[4], val[5]), pk2(val[6], val[7])};
        *(u32x4*)(GQ2 + (size_t)r * 1536 + c0) = o;
      }
    }
  }
}
DEV void row_scales(const bf16_t* A, int K, float* rs) {
  const int tid = TIDX(), row = tid >> 1, half = tid & 1;
  const bf16_t* a = A + (size_t)row * K + half * (K / 2);
  float ss = 0.f;
  for (int k = 0; k < K / 2; k += 8) {
    const u32x4 w = *(const u32x4*)(a + k);
#pragma unroll
    for (int i = 0; i < 4; ++i) { const float lo = bflo(w[i]), hi = bfhi(w[i]); ss += lo * lo + hi * hi; }
  }
  ss += __shfl_xor(ss, 1);
  if (half == 0) rs[row] = rsqrtf(ss / (float)K + EPS);
}
DEV void mla_prep_gemms(const P& p, char* lds) {
  char* U = p.ws + OFF_U;
  const bf16_t *MQA = (const bf16_t*)(U + U_MQA), *MKVA = (const bf16_t*)(U + U_MKVA);
  const bf16_t *WQ = (const bf16_t*)(p.ws + OFF_WT + WT_WQB), *WKV = (const bf16_t*)(p.ws + OFF_WT + WT_WKVB);
  bf16_t *MQ = (bf16_t*)(U + U_MQ), *MKN = (bf16_t*)(U + U_MKN), *MVT = (bf16_t*)(U + U_MVT);
  const int lane = TIDX() & 63, wid = TIDX() >> 6, wr = wid >> 1, wc = wid & 1, h2 = lane >> 5;
  constexpr int MT = T / 128;
  constexpr float QSCALE = 0.07216878364870322f * 1.4426950408889634f;
  for (int t = vblock(); t < MT * 14; t += gridDim.x) {
    int mt, nt; tile_map(t, MT, 14, mt, nt);
    const bool isq = nt < 6;
    const bf16_t* Ab = isq ? MQA + (size_t)mt * 128 * 384 : MKVA + (size_t)mt * 128 * 256;
    const int K = isq ? 384 : 256;
    float* rsl = (float*)lds;
    __syncthreads();
    row_scales(Ab, K, rsl);
    __syncthreads();
    float rsv[2];
#pragma unroll
    for (int mi = 0; mi < 2; ++mi) rsv[mi] = rsl[wr * 64 + mi * 32 + (lane & 31)];
    __syncthreads();
    f32x16 acc[2][2]; zero_acc<2>(acc);
    if (isq) gemm_core<128>(Ab, 384, WQ + (size_t)nt * 128 * 384, 384, 384, acc, lds);
    else gemm_core<128>(Ab, 256, WKV + (size_t)(nt - 6) * 128 * 256, 256, 256, acc, lds);
#pragma unroll
    for (int mi = 0; mi < 2; ++mi) {
      const int row = mt * 128 + wr * 64 + mi * 32 + (lane & 31);
#pragma unroll
      for (int ni = 0; ni < 2; ++ni) {
        f32x16 v = acc[mi][ni] * rsv[mi];
        if (isq) {
          const int nb = nt * 128 + wc * 64 + ni * 32, jb = nb % 192;
          if (jb >= 128) rope32(v, (jb - 128) >> 5, row, h2);
          v = v * QSCALE;
          bf16_t* dst = MQ + (size_t)row * 768 + nb + 4 * h2;
#pragma unroll
          for (int q = 0; q < 4; ++q) st4bf(dst + 8 * q, v[q * 4], v[q * 4 + 1], v[q * 4 + 2], v[q * 4 + 3]);
        } else {
          const int nb = (nt - 6) * 128 + wc * 64 + ni * 32, head = nb >> 8, jb = nb & 255;
          if (jb < 128) {
            bf16_t* dst = MKN + (size_t)row * 512 + head * 128 + jb + 4 * h2;
#pragma unroll
            for (int q = 0; q < 4; ++q) st4bf(dst + 8 * q, v[q * 4], v[q * 4 + 1], v[q * 4 + 2], v[q * 4 + 3]);
          } else {
            const int b = batch_of(row), kx = kx_of(row);
            bf16_t* dst = MVT + ((size_t)(b * 4 + head) * 128 + (jb - 128) + 4 * h2) * KSP + kx;
#pragma unroll
            for (int reg = 0; reg < 16; ++reg) dst[(size_t)((reg & 3) + 8 * (reg >> 2)) * KSP] = f2bf(v[reg]);
          }
        }
      }
    }
  }
}

template <int BR>
DEV void scan_task(const P& p, int b, int h, int dir, int cgp, char* lds) {
  char* U = p.ws + OFF_U;
  const int tid = TIDX(), lane = tid & 63, w = tid >> 6, kg = lane & 15, ci = lane >> 4;
  const bf16_t *Qs, *Ks, *Vs; int ldq, ldk, ldv;
  if (BR == 0) { const bf16_t* g = (const bf16_t*)(U + U_GQ2); Qs = g + h * 128; Ks = g + 512 + h * 128; Vs = g + 1024 + h * 128 + cgp * 16; ldq = ldk = ldv = 1536; }
  else { Qs = (const bf16_t*)(U + U_HQ) + h * 128; ldq = 512; Ks = (const bf16_t*)(U + U_HK) + dir * 512 + h * 128; ldk = 1024; Vs = (const bf16_t*)(U + U_HI) + h * 128 + cgp * 16; ldv = 512; }
  const float* AB = (const float*)(U + U_GAB);
  bf16_t* O = (bf16_t*)(U + (BR == 0 ? (dir ? U_OGB : U_OGF) : (dir ? U_OHB : U_OHF))) + h * 128 + cgp * 16 + w * 4 + ci;
  constexpr int BUF = 16384 + 1024 + 128 + 128;
  const int sg = 1 - 2 * dir;
  auto rowbase = [&](int s0) -> int {
    const int rb = s0 < 256 ? TL + b * 256 + (dir ? 255 - s0 : s0) : b * 8192 + (dir ? 8191 - (s0 - 256) : (s0 - 256));
    return __builtin_amdgcn_readfirstlane(rb);
  };
  f32x2 S2[4];
#pragma unroll
  for (int i = 0; i < 4; ++i) S2[i] = (f32x2){0.f, 0.f};
  u32x4 g0, g1; bf16_t gv; float gs = 0.f;
  const int st0 = tid >> 5, cc0 = tid & 31;
  auto gload = [&](int bt) {
    const int rb = rowbase(bt * 16);
    const int r0 = rb + sg * st0, r1 = rb + sg * (st0 + 8);
    g0 = cc0 < 16 ? *(const u32x4*)(Ks + (size_t)r0 * ldk + cc0 * 8) : *(const u32x4*)(Qs + (size_t)r0 * ldq + (cc0 - 16) * 8);
    g1 = cc0 < 16 ? *(const u32x4*)(Ks + (size_t)r1 * ldk + cc0 * 8) : *(const u32x4*)(Qs + (size_t)r1 * ldq + (cc0 - 16) * 8);
    gv = Vs[(size_t)(rb + sg * (tid >> 4)) * ldv + (tid & 15)];
    if (BR == 0 && tid < 32) {
      const int rr = rb + sg * (tid & 15);
      gs = AB[(size_t)rr * 16 + (tid < 16 ? 0 : 8) + dir * 4 + h];
    }
  };
  auto lwrite = [&](char* buf) {
    float* kq = (float*)buf;
    f32x4 a = {bflo(g0[0]), bfhi(g0[0]), bflo(g0[1]), bfhi(g0[1])}, bq = {bflo(g0[2]), bfhi(g0[2]), bflo(g0[3]), bfhi(g0[3])};
    *(f32x4*)(kq + st0 * 256 + cc0 * 8) = a; *(f32x4*)(kq + st0 * 256 + cc0 * 8 + 4) = bq;
    f32x4 c = {bflo(g1[0]), bfhi(g1[0]), bflo(g1[1]), bfhi(g1[1])}, d = {bflo(g1[2]), bfhi(g1[2]), bflo(g1[3]), bfhi(g1[3])};
    *(f32x4*)(kq + (st0 + 8) * 256 + cc0 * 8) = c; *(f32x4*)(kq + (st0 + 8) * 256 + cc0 * 8 + 4) = d;
    ((float*)(buf + 16384))[tid] = bf2f(gv);
    if (BR == 0 && tid < 32) ((float*)(buf + 16384 + 1024))[(tid & 15) * 2 + (tid >> 4)] = tid < 16 ? __expf(gs) : gs;
  };
  auto gram = [&](char* buf) {
    const float* kq = (const float*)buf;
    const int di = tid >> 3, sub = tid & 7, pp = di >> 2, wh = di & 3;
    const float* xv = kq + (2 * pp + (wh == 1 ? 0 : 1)) * 256 + (wh == 0 ? 0 : 128) + sub * 16;
    const float* yv = kq + (2 * pp + (wh == 3 ? 1 : 0)) * 256 + sub * 16;
    float acc = 0.f;
#pragma unroll
    for (int i = 0; i < 4; ++i) { const f32x4 x = *(const f32x4*)(xv + 4 * i), y = *(const f32x4*)(yv + 4 * i); acc += (x[0] * y[0] + x[1] * y[1]) + (x[2] * y[2] + x[3] * y[3]); }
    acc += __int_as_float(__builtin_amdgcn_update_dpp(0, __float_as_int(acc), 0xB1, 0xf, 0xf, true));
    acc += __int_as_float(__builtin_amdgcn_update_dpp(0, __float_as_int(acc), 0x4E, 0xf, 0xf, true));
    acc += __int_as_float(__builtin_amdgcn_update_dpp(0, __float_as_int(acc), 0x141, 0xf, 0xf, true));
    if (sub == 0) ((float*)(buf + 16384 + 1024 + 128))[di] = acc;
  };
  constexpr int NBT = KSP / 16;
  __syncthreads();
  gload(0); lwrite(lds);
  gload(1);
  __syncthreads();
  if (BR == 0) gram(lds);
  lwrite(lds + BUF);
  gload(2);
  __syncthreads();
  int ic = 0;
  for (int bt = 0; bt < NBT; ++bt) {
    char* cur = lds + ic * BUF;
    const int i1 = ic == 2 ? 0 : ic + 1, i2 = i1 == 2 ? 0 : i1 + 1;
    if (bt + 2 < NBT) lwrite(lds + i2 * BUF);
    if (bt + 3 < NBT) gload(bt + 3);
    const float* kq = (const float*)cur;
    const float* vv = (const float*)(cur + 16384);
    const float* ab = (const float*)(cur + 16384 + 1024);
    const float* gm = (const float*)(cur + 16384 + 1024 + 128);
    float osel = 0.f;
    if (BR == 0) {
      f32x4 nk00 = *(const f32x4*)(kq + kg * 4), nk01 = *(const f32x4*)(kq + 64 + kg * 4), nq00 = *(const f32x4*)(kq + 128 + kg * 4), nq01 = *(const f32x4*)(kq + 192 + kg * 4);
      f32x4 nk10 = *(const f32x4*)(kq + 256 + kg * 4), nk11 = *(const f32x4*)(kq + 320 + kg * 4), nq10 = *(const f32x4*)(kq + 384 + kg * 4), nq11 = *(const f32x4*)(kq + 448 + kg * 4);
      float nv0 = vv[w * 4 + ci], nv1 = vv[16 + w * 4 + ci];
      f32x4 nabv = *(const f32x4*)(ab), ngr = *(const f32x4*)(gm);
#pragma unroll
      for (int pp = 0; pp < 8; ++pp) {
        const f32x4 k00 = nk00, k01 = nk01, q00 = nq00, q01 = nq01, k10 = nk10, k11 = nk11, q10 = nq10, q11 = nq11;
        const float v0 = nv0, v1 = nv1;
        const f32x4 abv = nabv;
        const f32x4 gr = ngr;
        if (pp + 1 < 8) {
          const float* kq0 = kq + (2 * pp + 2) * 256; const float* kq1 = kq0 + 256;
          nk00 = *(const f32x4*)(kq0 + kg * 4); nk01 = *(const f32x4*)(kq0 + 64 + kg * 4); nq00 = *(const f32x4*)(kq0 + 128 + kg * 4); nq01 = *(const f32x4*)(kq0 + 192 + kg * 4);
          nk10 = *(const f32x4*)(kq1 + kg * 4); nk11 = *(const f32x4*)(kq1 + 64 + kg * 4); nq10 = *(const f32x4*)(kq1 + 128 + kg * 4); nq11 = *(const f32x4*)(kq1 + 192 + kg * 4);
          nv0 = vv[(2 * pp + 2) * 16 + w * 4 + ci]; nv1 = vv[(2 * pp + 3) * 16 + w * 4 + ci];
          nabv = *(const f32x4*)(ab + (pp + 1) * 4); ngr = *(const f32x4*)(gm + (pp + 1) * 4);
        }
        __builtin_amdgcn_sched_barrier(0);
        const f32x2 k0a = {k00[0], k00[1]}, k0b = {k00[2], k00[3]}, k0c = {k01[0], k01[1]}, k0d = {k01[2], k01[3]};
        const f32x2 k1a = {k10[0], k10[1]}, k1b = {k10[2], k10[3]}, k1c = {k11[0], k11[1]}, k1d = {k11[2], k11[3]};
        const f32x2 q0a = {q00[0], q00[1]}, q0b = {q00[2], q00[3]}, q0c = {q01[0], q01[1]}, q0d = {q01[2], q01[3]};
        const f32x2 q1a = {q10[0], q10[1]}, q1b = {q10[2], q10[3]}, q1c = {q11[0], q11[1]}, q1d = {q11[2], q11[3]};
        const f32x2 t0 = (k0a * S2[0] + k0b * S2[1]) + (k0c * S2[2] + k0d * S2[3]);
        const f32x2 t1 = (k1a * S2[0] + k1b * S2[1]) + (k1c * S2[2] + k1d * S2[3]);
        const f32x2 t2 = (q0a * S2[0] + q0b * S2[1]) + (q0c * S2[2] + q0d * S2[3]);
        const f32x2 t3 = (q1a * S2[0] + q1b * S2[1]) + (q1c * S2[2] + q1d * S2[3]);
        const float kS0 = rowsum16(t0[0] + t0[1]), kS1 = rowsum16(t1[0] + t1[1]), qS0 = rowsum16(t2[0] + t2[1]), qS1 = rowsum16(t3[0] + t3[1]);
        const float a0 = abv[0], b0 = abv[1], a1 = abv[2], b1 = abv[3];
        const float c0 = b0 * (v0 - a0 * kS0);
        const float d1 = a0 * kS1 + gr[0] * c0;
        const float c1 = b1 * (v1 - a1 * d1);
        const float o0 = a0 * qS0 + gr[1] * c0;
        const float o1 = a1 * (a0 * qS1 + gr[2] * c0) + gr[3] * c1;
        const float aa = a1 * a0, e0 = a1 * c0;
        const f32x2 aav = {aa, aa}, e0v = {e0, e0}, c1v = {c1, c1};
        S2[0] = (aav * S2[0] + k0a * e0v) + k1a * c1v; S2[1] = (aav * S2[1] + k0b * e0v) + k1b * c1v;
        S2[2] = (aav * S2[2] + k0c * e0v) + k1c * c1v; S2[3] = (aav * S2[3] + k0d * e0v) + k1d * c1v;
        osel = (kg == 2 * pp) ? o0 : osel;
        osel = (kg == 2 * pp + 1) ? o1 : osel;
      }
    } else {
      f32x4 nk0 = *(const f32x4*)(kq + kg * 4), nk1 = *(const f32x4*)(kq + 64 + kg * 4), nq0 = *(const f32x4*)(kq + 128 + kg * 4), nq1 = *(const f32x4*)(kq + 192 + kg * 4);
      float nv = vv[w * 4 + ci];
#pragma unroll
      for (int st = 0; st < 16; ++st) {
        const f32x4 k0 = nk0, k1 = nk1, q0 = nq0, q1 = nq1;
        const float v = nv;
        if (st + 1 < 16) {
          nk0 = *(const f32x4*)(kq + (st + 1) * 256 + kg * 4); nk1 = *(const f32x4*)(kq + (st + 1) * 256 + 64 + kg * 4);
          nq0 = *(const f32x4*)(kq + (st + 1) * 256 + 128 + kg * 4); nq1 = *(const f32x4*)(kq + (st + 1) * 256 + 192 + kg * 4);
          nv = vv[(st + 1) * 16 + w * 4 + ci];
        }
        __builtin_amdgcn_sched_barrier(0);
        const f32x2 ka = {k0[0], k0[1]}, kb = {k0[2], k0[3]}, kc = {k1[0], k1[1]}, kd = {k1[2], k1[3]};
        const f32x2 qa = {q0[0], q0[1]}, qb = {q0[2], q0[3]}, qc = {q1[0], q1[1]}, qd = {q1[2], q1[3]};
        const f32x2 v2 = {v, v};
        S2[0] = S2[0] + ka * (v2 - S2[0]); S2[1] = S2[1] + kb * (v2 - S2[1]); S2[2] = S2[2] + kc * (v2 - S2[2]); S2[3] = S2[3] + kd * (v2 - S2[3]);
        const f32x2 u = (qa * S2[0] + qb * S2[1]) + (qc * S2[2] + qd * S2[3]);
        const float o = rowsum16(u[0] + u[1]);
        osel = (kg == st) ? o : osel;
      }
    }
    O[(size_t)(rowbase(bt * 16) + sg * kg) * 512] = f2bf(osel);
    if (BR == 0 && bt + 1 < NBT) gram(lds + i1 * BUF);
    __syncthreads();
    ic = i1;
  }
}

DEV void attn_task(const P& p, int b, int h, int r0, int kx_begin, int nkt, char* lds) {
  char* U = p.ws + OFF_U;
  const bf16_t *MQ = (const bf16_t*)(U + U_MQ), *MKN = (const bf16_t*)(U + U_MKN), *MKR = (const bf16_t*)(U + U_MKR), *MVT = (const bf16_t*)(U + U_MVT);
  bf16_t* YB = (bf16_t*)(p.ws + OFF_YB);
  const int tid = TIDX(), lane = tid & 63, w = tid >> 6, h2 = lane >> 5, l31 = lane & 31;
  const int qrow = r0 + w * 32 + l31;
  bf16x8 qf[12];
#pragma unroll
  for (int s = 0; s < 12; ++s) qf[s] = *(const bf16x8*)(MQ + (size_t)qrow * 768 + h * 192 + s * 16 + h2 * 8);
  f32x16 oacc[4];
#pragma unroll
  for (int d = 0; d < 4; ++d)
#pragma unroll
    for (int i = 0; i < 16; ++i) oacc[d][i] = 0.f;
  float m = -1e30f, lsum = 0.f;
  char* Kl = lds;
  char* Vl = lds + 64 * 384;
  const int pi = (l31 & 19) | ((l31 & 4) << 1) | ((l31 & 8) >> 1);
  const bf16_t* vbase = MVT + (size_t)(b * 4 + h) * 128 * KSP;
  for (int kt = 0; kt < nkt; ++kt) {
    const int kx0 = kx_begin + kt * 64;
    const int rb = kx0 < 8192 ? b * 8192 + kx0 : TL + b * 256 + (kx0 - 8192);
    u32x4 kr[6], vr[4];
#pragma unroll
    for (int i = 0; i < 6; ++i) {
      const int c = tid + 256 * i, row = c / 24, ch = c % 24;
      kr[i] = ch < 16 ? *(const u32x4*)(MKN + (size_t)(rb + row) * 512 + h * 128 + ch * 8) : *(const u32x4*)(MKR + (size_t)(rb + row) * 64 + (ch - 16) * 8);
    }
#pragma unroll
    for (int i = 0; i < 4; ++i) {
      const int c = tid + 256 * i, row = c >> 3, ch = c & 7;
      vr[i] = *(const u32x4*)(vbase + (size_t)row * KSP + kx0 + ch * 8);
    }
    __syncthreads();
#pragma unroll
    for (int i = 0; i < 6; ++i) {
      const int c = tid + 256 * i, row = c / 24, ch = c % 24;
      *(u32x4*)(Kl + row * 384 + (((ch & 24) | ((ch ^ (row >> 1)) & 7)) << 4)) = kr[i];
    }
#pragma unroll
    for (int i = 0; i < 4; ++i) {
      const int c = tid + 256 * i, row = c >> 3, ch = c & 7;
      *(u32x4*)(Vl + swz(row, ch)) = vr[i];
    }
    __syncthreads();
    f32x16 sacc[2];
#pragma unroll
    for (int i = 0; i < 16; ++i) { sacc[0][i] = 0.f; sacc[1][i] = 0.f; }
#pragma unroll
    for (int s = 0; s < 12; ++s) {
      const int ch = s * 2 + h2;
#pragma unroll
      for (int kb = 0; kb < 2; ++kb) {
        const int row = kb * 32 + pi;
        const bf16x8 kf = *(const bf16x8*)(Kl + row * 384 + (((ch & 24) | ((ch ^ (row >> 1)) & 7)) << 4));
        sacc[kb] = __builtin_amdgcn_mfma_f32_32x32x16_bf16(kf, qf[s], sacc[kb], 0, 0, 0);
      }
      if (s & 1) __builtin_amdgcn_sched_barrier(0);
    }
    float mx = sacc[0][0];
#pragma unroll
    for (int i = 1; i < 16; ++i) mx = fmaxf(mx, sacc[0][i]);
#pragma unroll
    for (int i = 0; i < 16; ++i) mx = fmaxf(mx, sacc[1][i]);
    mx = fmaxf(mx, __shfl_xor(mx, 32));
    const float mn = fmaxf(m, mx);
    const float alpha = __builtin_amdgcn_exp2f(m - mn);
    m = mn;
    float ps = 0.f;
#pragma unroll
    for (int kb = 0; kb < 2; ++kb)
#pragma unroll
      for (int i = 0; i < 16; ++i) { const float e = __builtin_amdgcn_exp2f(sacc[kb][i] - mn); sacc[kb][i] = e; ps += e; }
    lsum = lsum * alpha + ps;
#pragma unroll
    for (int d = 0; d < 4; ++d) oacc[d] = oacc[d] * alpha;
    bf16x8 pf[4];
#pragma unroll
    for (int kb = 0; kb < 2; ++kb)
#pragma unroll
      for (int s2 = 0; s2 < 2; ++s2) {
        u32x4 pw = {pk2(sacc[kb][8 * s2 + 0], sacc[kb][8 * s2 + 1]), pk2(sacc[kb][8 * s2 + 2], sacc[kb][8 * s2 + 3]),
                    pk2(sacc[kb][8 * s2 + 4], sacc[kb][8 * s2 + 5]), pk2(sacc[kb][8 * s2 + 6], sacc[kb][8 * s2 + 7])};
        pf[kb * 2 + s2] = __builtin_bit_cast(bf16x8, pw);
      }
    __builtin_amdgcn_sched_barrier(0);
#pragma unroll
    for (int s = 0; s < 4; ++s) {
#pragma unroll
      for (int d = 0; d < 4; ++d) {
        const bf16x8 vf = *(const bf16x8*)(Vl + swz(d * 32 + l31, s * 2 + h2));
        oacc[d] = __builtin_amdgcn_mfma_f32_32x32x16_bf16(vf, pf[s], oacc[d], 0, 0, 0);
      }
      __builtin_amdgcn_sched_barrier(0);
    }
  }
  lsum += __shfl_xor(lsum, 32);
  const float inv = 1.f / lsum;
  bf16_t* dst = YB + (size_t)qrow * 512 + h * 128 + 4 * h2;
#pragma unroll
  for (int d = 0; d < 4; ++d)
#pragma unroll
    for (int q = 0; q < 4; ++q) st4bf(dst + d * 32 + 8 * q, oacc[d][q * 4] * inv, oacc[d][q * 4 + 1] * inv, oacc[d][q * 4 + 2] * inv, oacc[d][q * 4 + 3] * inv);
  __syncthreads();
}

DEV void mixer_item(const P& p, int it, char* lds) {
  if (it < 256) {
    const int br = it >> 7, rem = it & 127, cgp = rem & 7, dir = (rem >> 3) & 1, h = (rem >> 4) & 3, b = rem >> 6;
    if (br == 0) scan_task<0>(p, b, h, dir, cgp, lds); else scan_task<1>(p, b, h, dir, cgp, lds);
  } else {
    const int a = it - 256;
    if (a < 512) { const int qt = a & 63, h = (a >> 6) & 3, b = a >> 8; attn_task(p, b, h, b * 8192 + qt * 128, 0, 132, lds); }
    else { const int c = a - 512, qt = c & 1, h = (c >> 1) & 3, b = c >> 3; attn_task(p, b, h, TL + b * 256 + qt * 128, 8192, 4, lds); }
  }
}
DEV void mixer_phase(const P& p, int l, char* lds) {
  __shared__ int sh_task;
  unsigned* ctr = (unsigned*)(p.ws + OFF_BAR) + 3600 + l * 64;
  const int G = gridDim.x;
  for (int it = blockIdx.x; it < 256; it += G) mixer_item(p, it, lds);
  for (;;) {
    __syncthreads();
    if (TIDX() == 0) sh_task = (int)atomicAdd(ctr, 1u);
    __syncthreads();
    const int a = sh_task;
    if (a >= 528) break;
    mixer_item(p, 256 + a, lds);
  }
}

DEV void readout_phase(const P& p, int l) {
  char* U = p.ws + OFF_U;
  const bf16_t *OGF = (const bf16_t*)(U + U_OGF), *OGB = (const bf16_t*)(U + U_OGB), *OHF = (const bf16_t*)(U + U_OHF), *OHB = (const bf16_t*)(U + U_OHB);
  const bf16_t *GG = (const bf16_t*)(U + U_GG), *HG = (const bf16_t*)(U + U_HG);
  bf16_t *YA = (bf16_t*)(U + U_YA), *YC = (bf16_t*)(U + U_YC);
  const int lane = TIDX() & 63, wid = TIDX() >> 6;
  const int stride = gridDim.x * 4;
  float nwv[2][8];
#pragma unroll
  for (int br = 0; br < 2; ++br)
#pragma unroll
    for (int i = 0; i < 8; ++i) nwv[br][i] = ((br ? p.hg_norm : p.gdn_norm) + l * 128 + (lane & 15) * 8)[i];
  for (int r0 = blockIdx.x * 4 + wid; r0 < T; r0 += 2 * stride) {
    const bool two = r0 + stride < T;
    u32x4 a[2][2], b2[2][2], g[2][2];
#pragma unroll
    for (int k = 0; k < 2; ++k) {
      if (k == 1 && !two) break;
      const size_t off = (size_t)(r0 + k * stride) * 512 + lane * 8;
      a[k][0] = *(const u32x4*)(OGF + off); b2[k][0] = *(const u32x4*)(OGB + off); g[k][0] = *(const u32x4*)(GG + off);
      a[k][1] = *(const u32x4*)(OHF + off); b2[k][1] = *(const u32x4*)(OHB + off); g[k][1] = *(const u32x4*)(HG + off);
    }
#pragma unroll
    for (int k = 0; k < 2; ++k) {
      if (k == 1 && !two) break;
      const size_t off = (size_t)(r0 + k * stride) * 512 + lane * 8;
#pragma unroll
      for (int br = 0; br < 2; ++br) {
        float o[8]; float ss = 0.f;
#pragma unroll
        for (int i = 0; i < 4; ++i) { o[2 * i] = bflo(a[k][br][i]) + bflo(b2[k][br][i]); o[2 * i + 1] = bfhi(a[k][br][i]) + bfhi(b2[k][br][i]); }
#pragma unroll
        for (int i = 0; i < 8; ++i) ss += o[i] * o[i];
        ss = sum16(ss);
        const float rs = rsqrtf(ss * (1.f / 128.f) + EPS);
        float y[8];
#pragma unroll
        for (int i = 0; i < 8; ++i) { const float gv = (i & 1) ? bfhi(g[k][br][i >> 1]) : bflo(g[k][br][i >> 1]); y[i] = o[i] * rs * nwv[br][i] * siluf_(gv); }
        u32x4 w = {pk2(y[0], y[1]), pk2(y[2], y[3]), pk2(y[4], y[5]), pk2(y[6], y[7])};
        *(u32x4*)((br ? YC : YA) + off) = w;
      }
    }
  }
}

DEV void merge_gemm(const P& p, char* lds, int MT) {
  char* U = p.ws + OFF_U;
  const bf16_t* ARE = (const bf16_t*)(p.ws + OFF_A);
  const bf16_t* WG = (const bf16_t*)(p.ws + OFF_WT + WT_WG);
  const bf16_t* WBR = (const bf16_t*)(p.ws + OFF_WT + WT_WBR);
  bf16_t* M = (bf16_t*)(U + U_M);
  const int lane = TIDX() & 63, wid = TIDX() >> 6, wr = wid >> 1, wc = wid & 1, h2 = lane >> 5;
  constexpr int NT = 1024 / 128;
  for (int t = vblock(); t < MT * NT; t += gridDim.x) {
    int mt, nt; tile_map(t, MT, NT, mt, nt);
    f32x16 macc[2][2]; zero_acc<2>(macc);
#pragma unroll 1
    for (int j = 0; j < 3; ++j) {
      const bf16_t* Yj = j == 0 ? (const bf16_t*)(U + U_YA) : (j == 1 ? (const bf16_t*)(p.ws + OFF_YB) : (const bf16_t*)(U + U_YC));
      f32x16 ag[2][2]; zero_acc<2>(ag);
      gemm_core<128>(ARE + (size_t)mt * 128 * 1024, 1024, WG + ((size_t)j * 1024 + nt * 128) * 1024, 1024, 1024, ag, lds);
#pragma unroll
      for (int mi = 0; mi < 2; ++mi)
#pragma unroll
        for (int ni = 0; ni < 2; ++ni)
#pragma unroll
          for (int i = 0; i < 16; ++i) ag[mi][ni][i] = sigmoidf_(ag[mi][ni][i]);
      f32x16 ab[2][2]; zero_acc<2>(ab);
      gemm_core<128>(Yj + (size_t)mt * 128 * 512, 512, WBR + ((size_t)j * 1024 + nt * 128) * 512, 512, 512, ab, lds);
#pragma unroll
      for (int mi = 0; mi < 2; ++mi)
#pragma unroll
        for (int ni = 0; ni < 2; ++ni)
#pragma unroll
          for (int i = 0; i < 16; ++i) macc[mi][ni][i] += ag[mi][ni][i] * ab[mi][ni][i];
    }
#pragma unroll
    for (int mi = 0; mi < 2; ++mi) {
      const int row = mt * 128 + wr * 64 + mi * 32 + (lane & 31);
#pragma unroll
      for (int ni = 0; ni < 2; ++ni) {
        bf16_t* dst = M + (size_t)row * D + nt * 128 + wc * 64 + ni * 32 + 4 * h2;
#pragma unroll
        for (int q = 0; q < 4; ++q) st4bf(dst + 8 * q, macc[mi][ni][q * 4], macc[mi][ni][q * 4 + 1], macc[mi][ni][q * 4 + 2], macc[mi][ni][q * 4 + 3]);
      }
    }
  }
}

DEV void run_phase(const P& p, int ph, char* lds) {
  char* U = p.ws + OFF_U;
  bf16_t* Abuf = (bf16_t*)(p.ws + OFF_A);
  bf16_t* Y = (bf16_t*)(U + U_Y);
  if (ph == 0) { phase0(p, lds); return; }
  if (ph == 1) { phase0b(p); return; }
  if (ph == 2) { row_phase(p, false, 0, nullptr, 0, 0.f, 0, true, 0, 0, 0, Abuf); return; }
  const int l = (ph - 3) / 13, s = (ph - 3) % 13;
  const int MTall = T / 128, MTpost = (l == 1) ? TL / 128 : T / 128, rows_post = (l == 1) ? TL : T;
  switch (s) {
    case 0: ffn_gemm1(p, lds, MTall); break;
    case 1: gemm_f32out((const bf16_t*)(U + U_HFF), DFF, (const bf16_t*)(p.ws + OFF_WT + WT_WO), Y, lds, MTall); break;
    case 2: row_phase(p, true, l, Y, 2, 0.5f, 1, true, l, 2, 3, Abuf); conv_mixer(p, l, lds); break;
    case 3: win_gemm(p, l, lds); break;
    case 4: gdn_prep_rows(p, l); mla_prep_gemms(p, lds); break;
    case 5: mixer_phase(p, l, lds); break;
    case 6: readout_phase(p, l); break;
    case 7: merge_gemm(p, lds, MTpost); break;
    case 8: gemm_f32out((const bf16_t*)(U + U_M), 1024, (const bf16_t*)(p.ws + OFF_WT + WT_WOUT), Y, lds, MTpost); break;
    case 9: row_phase(p, true, l, Y, 5, 1.0f, 3, true, l, 4, 6, Abuf, rows_post); conv_ffn(p, l, 1, lds); break;
    case 10: ffn_gemm1(p, lds, MTpost); break;
    case 11: gemm_f32out((const bf16_t*)(U + U_HFF), DFF, (const bf16_t*)(p.ws + OFF_WT + WT_WO), Y, lds, MTpost); break;
    case 12:
      if (l == 0) { row_phase(p, true, 0, Y, 8, 0.5f, 5, true, 1, 0, 0, Abuf); conv_ffn(p, 1, 0, lds); }
      else row_phase(p, true, 1, Y, 8, 0.5f, 5, false, 0, 0, 0, Abuf, TL);
      break;
    default: break;
  }
}
constexpr int NPHASE = 3 + 2 * 13;

template <int PH>
DEV void run_all(const P& p, char* lds, const XcdBarrier& xb) {
  run_phase(p, PH, lds);
  if constexpr (PROBE_SCAN_ONLY != 0 && PH >= 3 && (PH - 3) % 13 == 5) { GRID_SYNC(); if (PROBE_SCAN_ONLY == 1) { if (blockIdx.x < 256) mixer_item(p, blockIdx.x, lds); } else { for (int a = (int)blockIdx.x - 256; a >= 0 && a < 528; a += gridDim.x - 256) mixer_item(p, 256 + a, lds); } }
  if constexpr (PROBE_DUP_S >= 0 && PH >= 3 && ((PH - 3) % 13 == PROBE_DUP_S || (PH - 3) % 13 == PROBE_DUP_S2)) { GRID_SYNC(); run_phase(p, PH, lds); }
  if constexpr (PH + 1 < NPHASE) { GRID_SYNC(); run_all<PH + 1>(p, lds, xb); }
}
#if COOP
__global__ void __launch_bounds__(256, 2) mega(P p) {
  __shared__ __attribute__((aligned(16))) char lds[65536];
  __shared__ uint4 xb_words;
  if (__builtin_amdgcn_workitem_id_x() == 0) xb_words = make_uint4(0u, 0u, 0u, 0u);
  __syncthreads();
  XcdBarrier xb = xcd_barrier_post((unsigned*)(p.ws + OFF_BAR), (volatile LAS unsigned*)&xb_words);
  if (p.ws == nullptr) cg::this_grid().sync();
  run_all<0>(p, lds, xb);
}
#else
template <int PH>
__global__ void __launch_bounds__(256, 2) mega(P p) {
  __shared__ __attribute__((aligned(16))) char lds[65536];
  run_phase(p, PH, lds);
}
template <int PH> void launch_all(const P& p, int grid, hipStream_t stream) {
  hipLaunchKernelGGL(mega<PH>, dim3(grid), dim3(256), 0, stream, p);
  if constexpr (PH + 1 < NPHASE) launch_all<PH + 1>(p, grid, stream);
}
#endif

extern "C" void kernel_launch(void* const* d_in, const int* in_sizes, int n_in, void* d_out, int out_size, void* d_ws, size_t ws_size, hipStream_t stream) {
  if (ws_size < WS_NEED) { fprintf(stderr, "workspace too small: %zu < %zu\n", ws_size, (size_t)WS_NEED); return; }
  P p{};
  const float** pp = (const float**)&p;
  for (int i = 0; i < 22; ++i) pp[i] = (const float*)d_in[i];
  p.out = (float*)d_out; p.ws = (char*)d_ws;
  static int grid_blocks = 0;
  if (!grid_blocks) {
    int dev = 0, cus = 0, per_cu = 0;
    (void)hipGetDevice(&dev);
    (void)hipDeviceGetAttribute(&cus, hipDeviceAttributeMultiprocessorCount, dev);
#if COOP
    (void)hipOccupancyMaxActiveBlocksPerMultiprocessor(&per_cu, mega, 256, 0);
#else
    per_cu = 2;
#endif
    if (per_cu > 2) per_cu = 2;
    if (per_cu < 1) per_cu = 1;
    grid_blocks = cus * per_cu;
  }
#if COOP
  (void)hipMemsetAsync((char*)d_ws + OFF_BAR, 0, BAR_BYTES, stream);
  void* args[] = {&p};
  hipError_t e = hipLaunchCooperativeKernel((void*)mega, dim3(grid_blocks), dim3(256), args, 0, stream);
  if (e != hipSuccess) fprintf(stderr, "cooperative launch failed: %s (grid %d)\n", hipGetErrorString(e), grid_blocks);
#else
  launch_all<0>(p, grid_blocks, stream);
#endif
}
```
